# Optimizing an MI355X kernel written in HIP

```python
import math
import jax
import jax.numpy as jnp
from jax import lax
import numpy as np

D_MODEL = 2048
BATCH = 4
SEQ = 4096
DEPTH = 2

GRID_W = 64
CTX_LEN = 256
N_EVEN = (DEPTH + 1) // 2
N_ODD = DEPTH // 2
N_MOD = 6
Q_BLOCK = 128
ROPE_THETA = 10000.0
EPS = 1e-6

MLA_HEADS = 8
MLA_Q_RANK = 512
MLA_KV_RANK = 512
MLA_NOPE = 128
MLA_ROPE = 64
MLA_V = 128
MLA_QK = MLA_NOPE + MLA_ROPE
GDN_HEADS = 8
GDN_DK = 128
GDN_DV = 128
GDN_CONV = 5
GDN_CHUNK = 64
GDN_QKV = GDN_HEADS * (2 * GDN_DK + GDN_DV)
DIFF_HEADS = 8
DIFF_D = 64
DIFF_DV = 2 * DIFF_D
GLA_HEADS = 4
GLA_DK = 128
GLA_DV = 256
GLA_GATE_RANK = 16
GLA_GATE_NORM = 16.0
GLA_CHUNK = 64
GLA_SUB = 16
FFN_HIDDEN = -(-8 * D_MODEL // (3 * 256)) * 256

AB_SPLITS = (MLA_Q_RANK, MLA_KV_RANK, MLA_ROPE, GDN_QKV, GDN_HEADS * GDN_DV, 2 * GDN_HEADS, 2 * GDN_HEADS)
CD_SPLITS = (DIFF_HEADS * 2 * DIFF_D, DIFF_HEADS * 2 * DIFF_D, DIFF_HEADS * DIFF_DV,
             GLA_HEADS * GLA_DK, GLA_HEADS * GLA_DK, GLA_HEADS * GLA_DV, GLA_HEADS * GLA_DV, 2 * GLA_GATE_RANK)
AB_IN = sum(AB_SPLITS)
CD_IN = sum(CD_SPLITS)
AB_OUT = MLA_HEADS * MLA_V + GDN_HEADS * GDN_DV
CD_OUT = DIFF_HEADS * DIFF_DV + GLA_HEADS * GLA_DV

kernel_name = 'hybrid_mla_gdn_diff_gla_dit'


def rms_norm(x, g):
    xf = x.astype(jnp.float32)
    y = xf * lax.rsqrt(jnp.mean(xf * xf, axis=-1, keepdims=True) + EPS)
    return (y * g.astype(jnp.float32)).astype(x.dtype)


def l2_norm(x):
    xf = x.astype(jnp.float32)
    return (xf * lax.rsqrt(jnp.sum(xf * xf, axis=-1, keepdims=True) + EPS)).astype(x.dtype)


def split_cols(z, sizes):
    return jnp.split(z, np.cumsum(sizes)[:-1].tolist(), axis=-1)


def to_heads(a, n, d):
    return a.reshape(a.shape[:2] + (n, d))


def flat_heads(a):
    return a.reshape(a.shape[:2] + (-1,))


def modulate(x, g, shift, scale):
    return rms_norm(x, g) * (1 + scale) + shift


def swiglu(h, w_gate, w_up, w_down):
    return (jax.nn.silu(h @ w_gate) * (h @ w_up)) @ w_down


def axial_rope_tables(n_tokens, rot_dim):
    rows = n_tokens // GRID_W
    row = jnp.repeat(jnp.arange(rows, dtype=jnp.float32), GRID_W)
    col = jnp.tile(jnp.arange(GRID_W, dtype=jnp.float32), rows)
    axis_dim = rot_dim // 2
    inv_freq = ROPE_THETA ** (-jnp.arange(0, axis_dim, 2, dtype=jnp.float32) / axis_dim)
    ang_r = row[:, None] * inv_freq[None, :]
    ang_c = col[:, None] * inv_freq[None, :]
    return jnp.cos(ang_r), jnp.sin(ang_r), jnp.cos(ang_c), jnp.sin(ang_c)


def _rotate_half(x, cos, sin):
    x1, x2 = jnp.split(x, 2, axis=-1)
    return jnp.concatenate([x1 * cos - x2 * sin, x2 * cos + x1 * sin], axis=-1)


def apply_axial_rope(x, tabs):
    cos_r, sin_r, cos_c, sin_c = tabs
    shape = (1, x.shape[1]) + (1,) * (x.ndim - 3) + (cos_r.shape[-1],)
    xr, xc = jnp.split(x, 2, axis=-1)
    return jnp.concatenate([
        _rotate_half(xr, cos_r.reshape(shape).astype(x.dtype), sin_r.reshape(shape).astype(x.dtype)),
        _rotate_half(xc, cos_c.reshape(shape).astype(x.dtype), sin_c.reshape(shape).astype(x.dtype))], axis=-1)


def sweep_query_blocks(fn, *qs):
    bsz, t = qs[0].shape[:2]
    nb = t // Q_BLOCK
    blocks = tuple(jnp.moveaxis(q.reshape((bsz, nb, Q_BLOCK) + q.shape[2:]), 1, 0) for q in qs)
    out = lax.map(lambda blk: fn(*blk), blocks)
    out = jnp.moveaxis(out, 0, 1)
    return out.reshape((bsz, t) + out.shape[3:])


def softmax_attention(q, k, v, scale):
    def block(qb):
        s = jnp.einsum('bqhd,bkhd->bhqk', qb, k).astype(jnp.float32) * scale
        p = jax.nn.softmax(s, axis=-1).astype(v.dtype)
        return jnp.einsum('bhqk,bkhd->bqhd', p, v)
    return sweep_query_blocks(block, q)


def differential_attention(q, k, v, lam, scale):
    def block(qb):
        s = jnp.einsum('bqhmd,bkhmd->bhmqk', qb, k).astype(jnp.float32) * scale
        p = jax.nn.softmax(s, axis=-1)
        a = (p[:, :, 0] - lam * p[:, :, 1]).astype(v.dtype)
        return jnp.einsum('bhqk,bkhd->bqhd', a, v)
    return sweep_query_blocks(block, q)


def depthwise_conv_centred(x, w):
    taps, ch = w.shape
    pad = taps // 2
    return lax.conv_general_dilated(x, w[:, None, :].astype(x.dtype), window_strides=(1,), padding=[(pad, pad)],
                                    dimension_numbers=('NWC', 'WIO', 'NWC'), feature_group_count=ch)


def gated_delta_chunked(q, k, v, g, beta, s0, with_output):
    bsz, t, h, dk = k.shape
    dv = v.shape[-1]
    c = GDN_CHUNK
    n = t // c
    f32 = jnp.float32

    def chunks(a):
        a = a.astype(f32).reshape((bsz, n, c, h) + a.shape[3:])
        return jnp.moveaxis(a, 3, 1)

    kc, vc, gc, bc = chunks(k), chunks(v), chunks(g), chunks(beta)
    gcum = jnp.cumsum(gc, axis=-1)
    idx = jnp.arange(c)
    incl = idx[:, None] >= idx[None, :]
    strict = idx[:, None] > idx[None, :]
    decay = jnp.where(incl, jnp.exp(jnp.where(incl, gcum[..., :, None] - gcum[..., None, :], 0.0)), 0.0)
    kb = kc * bc[..., None]
    lower = jnp.where(strict, jnp.einsum('bhnid,bhnjd->bhnij', kb, kc) * decay, 0.0)
    rhs = jnp.concatenate([vc * bc[..., None], kb * jnp.exp(gcum)[..., None]], axis=-1)
    sol = lax.linalg.triangular_solve(lower + jnp.eye(c, dtype=f32), rhs, left_side=True, lower=True,
                                      unit_diagonal=True)
    u, w = sol[..., :dv], sol[..., dv:]
    g_last = gcum[..., -1]
    k_end = kc * jnp.exp(g_last[..., None] - gcum)[..., None]
    xs = (u, w, k_end, jnp.exp(g_last))
    if with_output:
        qc = chunks(q)
        qk = jnp.where(incl, jnp.einsum('bhnid,bhnjd->bhnij', qc, kc) * decay, 0.0)
        xs = xs + (qc * jnp.exp(gcum)[..., None], qk)
    xs = tuple(jnp.moveaxis(a, 2, 0) for a in xs)

    def step(state, inp):
        u_n, w_n, kend_n, dl_n = inp[:4]
        v_new = u_n - jnp.einsum('bhcd,bhde->bhce', w_n, state)
        new_state = state * dl_n[..., None, None] + jnp.einsum('bhcd,bhce->bhde', kend_n, v_new)
        if not with_output:
            return new_state, None
        qd_n, qk_n = inp[4:]
        out = jnp.einsum('bhcd,bhde->bhce', qd_n, state) + jnp.einsum('bhij,bhje->bhie', qk_n, v_new)
        return new_state, out

    final, out = lax.scan(step, s0, xs)
    if not with_output:
        return None, final
    out = jnp.moveaxis(jnp.moveaxis(out, 0, 2), 1, 3).reshape(bsz, t, h, dv)
    return out, final


def gla_chunked(q, k, v, glog, s0, with_output):
    bsz, t, h, dk = k.shape
    dv = v.shape[-1]
    c, sub = GLA_CHUNK, GLA_SUB
    n, ns = t // c, c // sub
    f32 = jnp.float32

    def chunks(a):
        return a.astype(f32).reshape(bsz, n, c, h, a.shape[-1]).transpose(1, 0, 3, 2, 4)

    earlier = jnp.arange(c)[None, :] < (jnp.arange(ns) * sub)[:, None]
    tril = jnp.arange(sub)[:, None] >= jnp.arange(sub)[None, :]
    xs = (chunks(k), chunks(v), chunks(glog)) + ((chunks(q),) if with_output else ())

    def step(state, inp):
        k_n, v_n, g_n = inp[:3]
        cum = jnp.cumsum(g_n, axis=-2)
        last = cum[:, :, -1, :]
        new_state = state * jnp.exp(last)[..., None] + jnp.einsum(
            'bhcd,bhce->bhde', k_n * jnp.exp(last[:, :, None, :] - cum), v_n)
        if not with_output:
            return new_state, None
        q_n = inp[3]
        out = jnp.einsum('bhcd,bhde->bhce', q_n * jnp.exp(cum), state)
        cs = cum.reshape(bsz, h, ns, sub, dk)
        qs = q_n.reshape(bsz, h, ns, sub, dk)
        ks = k_n.reshape(bsz, h, ns, sub, dk)
        vs = v_n.reshape(bsz, h, ns, sub, dv)
        ref = jnp.concatenate([jnp.zeros_like(cs[:, :, :1, 0]), cs[:, :, :-1, -1]], axis=2)
        q_ref = qs * jnp.exp(cs - ref[:, :, :, None, :])
        k_ref = jnp.where(earlier[..., None],
                          jnp.exp(jnp.minimum(ref[:, :, :, None, :] - cum[:, :, None, :, :], 0.0)), 0.0) * k_n[:, :, None]
        a_cross = jnp.einsum('bhsid,bhsjd->bhsij', q_ref, k_ref)
        dec = jnp.where(tril[..., None], jnp.exp(jnp.minimum(cs[..., :, None, :] - cs[..., None, :, :], 0.0)), 0.0)
        a_local = jnp.einsum('bhsid,bhsjd,bhsijd->bhsij', qs, ks, dec)
        local = jnp.einsum('bhsij,bhje->bhsie', a_cross, v_n) + jnp.einsum('bhsij,bhsje->bhsie', a_local, vs)
        return new_state, out + local.reshape(bsz, h, c, dv)

    final, out = lax.scan(step, s0, xs)
    if not with_output:
        return None, final
    return out.transpose(1, 0, 3, 2, 4).reshape(bsz, t, h, dv), final


def _direction_inputs(stream, d):
    shared, per_dir = stream
    seq = tuple(shared) + tuple(p[:, :, d] for p in per_dir)
    return seq if d == 0 else tuple(jnp.flip(a, axis=1) for a in seq)


def bidirectional_scan(scan_fn, lat, ctx, state_shape, need_ctx):
    outs_l, outs_c = [], []
    for d in range(2):
        out_c, state_c = scan_fn(*_direction_inputs(ctx, d), jnp.zeros(state_shape, jnp.float32), need_ctx)
        out_l, _ = scan_fn(*_direction_inputs(lat, d), state_c, True)
        if d == 1:
            out_l = jnp.flip(out_l, axis=1)
            out_c = jnp.flip(out_c, axis=1) if need_ctx else None
        outs_l.append(out_l)
        outs_c.append(out_c)
    return outs_l[0] + outs_l[1], (outs_c[0] + outs_c[1] if need_ctx else None)


def mla_queries(q_a, q_a_norm, w_uq, q_norm, tabs):
    q = to_heads(rms_norm(q_a, q_a_norm) @ w_uq, MLA_HEADS, MLA_QK)
    q = rms_norm(q, q_norm)
    if tabs is None:
        return q
    return jnp.concatenate([q[..., :MLA_NOPE], apply_axial_rope(q[..., MLA_NOPE:], tabs)], axis=-1)


def mla_keys_values(kv_a, k_rope, kv_a_norm, w_ukv, k_norm, tabs):
    bsz, t, _ = kv_a.shape
    kv = to_heads(rms_norm(kv_a, kv_a_norm) @ w_ukv, MLA_HEADS, MLA_NOPE + MLA_V)
    k_nope, v = kv[..., :MLA_NOPE], kv[..., MLA_NOPE:]
    k = jnp.concatenate([k_nope, jnp.broadcast_to(k_rope[:, :, None, :], (bsz, t, MLA_HEADS, MLA_ROPE))], axis=-1)
    k = rms_norm(k, k_norm)
    if tabs is not None:
        k = jnp.concatenate([k[..., :MLA_NOPE], apply_axial_rope(k[..., MLA_NOPE:], tabs)], axis=-1)
    return k, v


def gdn_inputs(qkv, a_raw, b_raw, conv_w, a_log, dt_bias):
    bsz, t, _ = qkv.shape
    qkv = jax.nn.silu(depthwise_conv_centred(qkv, conv_w))
    q, k, v = split_cols(qkv, (GDN_HEADS * GDN_DK, GDN_HEADS * GDN_DK, GDN_HEADS * GDN_DV))
    q = l2_norm(to_heads(q, GDN_HEADS, GDN_DK)) * (GDN_DK ** -0.5)
    k = l2_norm(to_heads(k, GDN_HEADS, GDN_DK))
    v = to_heads(v, GDN_HEADS, GDN_DV)
    a = a_raw.astype(jnp.float32).reshape(bsz, t, 2, GDN_HEADS)
    g = -jnp.exp(a_log.astype(jnp.float32)) * jax.nn.softplus(a + dt_bias.astype(jnp.float32))
    beta = jax.nn.sigmoid(b_raw.astype(jnp.float32).reshape(bsz, t, 2, GDN_HEADS))
    return (q, k, v), (g, beta)


def gla_inputs(q, k, v, lowrank, gate_w2, gate_b2):
    bsz, t, _ = q.shape
    q = to_heads(q, GLA_HEADS, GLA_DK) * (GLA_DK ** -0.5)
    k = to_heads(k, GLA_HEADS, GLA_DK)
    v = to_heads(v, GLA_HEADS, GLA_DV)
    lr = lowrank.reshape(bsz, t, 2, GLA_GATE_RANK)
    logits = jnp.einsum('btdr,drk->btdk', lr, gate_w2).astype(jnp.float32) + gate_b2.astype(jnp.float32)
    glog = (jax.nn.log_sigmoid(logits) / GLA_GATE_NORM).reshape(bsz, t, 2, GLA_HEADS, GLA_DK)
    return (q, k, v), (glog,)


def mla_gdn_mixer(h, hc, w_in, q_a_norm, w_uq, kv_a_norm, w_ukv, q_norm, k_norm,
                  conv_w, a_log, dt_bias, out_norm, w_out, need_ctx):
    bsz, t, _ = h.shape
    tabs = axial_rope_tables(t, MLA_ROPE)
    q_a, kv_a, k_rope, qkv, z, a_raw, b_raw = split_cols(h @ w_in, AB_SPLITS)
    cq_a, ckv_a, ck_rope, cqkv, cz, ca_raw, cb_raw = split_cols(hc @ w_in, AB_SPLITS)
    k_l, v_l = mla_keys_values(kv_a, k_rope, kv_a_norm, w_ukv, k_norm, tabs)
    k_c, v_c = mla_keys_values(ckv_a, ck_rope, kv_a_norm, w_ukv, k_norm, None)
    q_l = mla_queries(q_a, q_a_norm, w_uq, q_norm, tabs)
    scale = MLA_QK ** -0.5
    att_l = softmax_attention(q_l, jnp.concatenate([k_c, k_l], axis=1), jnp.concatenate([v_c, v_l], axis=1), scale)
    rec_l, rec_c = bidirectional_scan(gated_delta_chunked,
                                      gdn_inputs(qkv, a_raw, b_raw, conv_w, a_log, dt_bias),
                                      gdn_inputs(cqkv, ca_raw, cb_raw, conv_w, a_log, dt_bias),
                                      (bsz, GDN_HEADS, GDN_DK, GDN_DV), need_ctx)
    rec_l = rms_norm(rec_l.astype(h.dtype), out_norm) * jax.nn.silu(to_heads(z, GDN_HEADS, GDN_DV))
    y = jnp.concatenate([flat_heads(att_l), flat_heads(rec_l)], axis=-1) @ w_out
    if not need_ctx:
        return y, None
    q_c = mla_queries(cq_a, q_a_norm, w_uq, q_norm, None)
    att_c = softmax_attention(q_c, k_c, v_c, scale)
    rec_c = rms_norm(rec_c.astype(hc.dtype), out_norm) * jax.nn.silu(to_heads(cz, GDN_HEADS, GDN_DV))
    yc = jnp.concatenate([flat_heads(att_c), flat_heads(rec_c)], axis=-1) @ w_out
    return y, yc


def diff_qk(a, norm_g, tabs):
    t = rms_norm(a.reshape(a.shape[:2] + (DIFF_HEADS, 2, DIFF_D)), norm_g)
    return t if tabs is None else apply_axial_rope(t, tabs)


def diff_gla_mixer(h, hc, w_in, q_norm, k_norm, lambdas, sub_norm, gate_w2, gate_b2, out_norm, w_out,
                   lam_init, need_ctx):
    bsz, t, _ = h.shape
    tabs = axial_rope_tables(t, DIFF_D)
    dq, dk, dv, gq, gk, gv, gg, glr = split_cols(h @ w_in, CD_SPLITS)
    cdq, cdk, cdv, cgq, cgk, cgv, cgg, cglr = split_cols(hc @ w_in, CD_SPLITS)
    lam_p = lambdas.astype(jnp.float32)
    lam = jnp.exp(jnp.sum(lam_p[0] * lam_p[1])) - jnp.exp(jnp.sum(lam_p[2] * lam_p[3])) + lam_init
    scale = DIFF_D ** -0.5
    k_l, k_c = diff_qk(dk, k_norm, tabs), diff_qk(cdk, k_norm, None)
    v_l, v_c = to_heads(dv, DIFF_HEADS, DIFF_DV), to_heads(cdv, DIFF_HEADS, DIFF_DV)
    q_l = diff_qk(dq, q_norm, tabs)
    att_l = differential_attention(q_l, jnp.concatenate([k_c, k_l], axis=1), jnp.concatenate([v_c, v_l], axis=1),
                                   lam, scale)
    att_l = rms_norm(att_l, sub_norm) * (1.0 - lam_init)
    rec_l, rec_c = bidirectional_scan(gla_chunked,
                                      gla_inputs(gq, gk, gv, glr, gate_w2, gate_b2),
                                      gla_inputs(cgq, cgk, cgv, cglr, gate_w2, gate_b2),
                                      (bsz, GLA_HEADS, GLA_DK, GLA_DV), need_ctx)
    rec_l = rms_norm(rec_l.astype(h.dtype), out_norm) * jax.nn.silu(to_heads(gg, GLA_HEADS, GLA_DV))
    y = jnp.concatenate([flat_heads(att_l), flat_heads(rec_l)], axis=-1) @ w_out
    if not need_ctx:
        return y, None
    q_c = diff_qk(cdq, q_norm, None)
    att_c = rms_norm(differential_attention(q_c, k_c, v_c, lam, scale), sub_norm) * (1.0 - lam_init)
    rec_c = rms_norm(rec_c.astype(hc.dtype), out_norm) * jax.nn.silu(to_heads(cgg, GLA_HEADS, GLA_DV))
    yc = jnp.concatenate([flat_heads(att_c), flat_heads(rec_c)], axis=-1) @ w_out
    return y, yc


def setup_inputs(seed: int = 0) -> dict:
    key = jax.random.key(seed)
    keys = iter(jax.random.split(key, 40))
    f32 = jnp.float32

    def normal(shape, scale):
        return jax.random.normal(next(keys), shape, f32) * scale

    def gain(shape):
        return 1.0 + normal(shape, 0.02)

    d = D_MODEL
    dt = jnp.exp(jax.random.uniform(next(keys), (N_EVEN, 2, GDN_HEADS), f32, math.log(1e-3), math.log(1e-1)))
    return {
        'x': normal((BATCH, SEQ, d), 1.0),
        'c': normal((BATCH, d), 1.0),
        'ctx': normal((BATCH, CTX_LEN, d), 1.0),
        'c_ctx': normal((d,), 1.0),
        'ada_w': normal((DEPTH, d, N_MOD * d), 0.5 * d ** -0.5),
        'ada_b': normal((DEPTH, N_MOD * d), 0.02),
        'norm_mix_g': gain((DEPTH, d)),
        'norm_ffn_g': gain((DEPTH, d)),
        'ffn_w_gate': normal((DEPTH, d, FFN_HIDDEN), d ** -0.5),
        'ffn_w_up': normal((DEPTH, d, FFN_HIDDEN), d ** -0.5),
        'ffn_w_down': normal((DEPTH, FFN_HIDDEN, d), FFN_HIDDEN ** -0.5),
        'ab_w_in': normal((N_EVEN, d, AB_IN), d ** -0.5),
        'mla_q_a_norm': gain((N_EVEN, MLA_Q_RANK)),
        'mla_w_uq': normal((N_EVEN, MLA_Q_RANK, MLA_HEADS * MLA_QK), MLA_Q_RANK ** -0.5),
        'mla_kv_a_norm': gain((N_EVEN, MLA_KV_RANK)),
        'mla_w_ukv': normal((N_EVEN, MLA_KV_RANK, MLA_HEADS * (MLA_NOPE + MLA_V)), MLA_KV_RANK ** -0.5),
        'mla_q_norm': gain((N_EVEN, MLA_QK)),
        'mla_k_norm': gain((N_EVEN, MLA_QK)),
        'gdn_conv_w': normal((N_EVEN, GDN_CONV, GDN_QKV), GDN_CONV ** -0.5),
        'gdn_a_log': jnp.log(jax.random.uniform(next(keys), (N_EVEN, 2, GDN_HEADS), f32, 1.0, 16.0)),
        'gdn_dt_bias': dt + jnp.log(-jnp.expm1(-dt)),
        'gdn_out_norm': gain((N_EVEN, GDN_DV)),
        'ab_w_out': normal((N_EVEN, AB_OUT, d), AB_OUT ** -0.5),
        'cd_w_in': normal((N_ODD, d, CD_IN), d ** -0.5),
        'diff_q_norm': gain((N_ODD, 2, DIFF_D)),
        'diff_k_norm': gain((N_ODD, 2, DIFF_D)),
        'diff_lambda': normal((N_ODD, 4, DIFF_D), 0.1),
        'diff_sub_norm': gain((N_ODD, DIFF_DV)),
        'gla_gate_w2': normal((N_ODD, 2, GLA_GATE_RANK, GLA_HEADS * GLA_DK), GLA_GATE_RANK ** -0.5),
        'gla_gate_b2': normal((N_ODD, 2, GLA_HEADS * GLA_DK), 0.1),
        'gla_out_norm': gain((N_ODD, GLA_DV)),
        'cd_w_out': normal((N_ODD, CD_OUT, d), CD_OUT ** -0.5),
    }


def reference(x, c, ctx, c_ctx, ada_w, ada_b, norm_mix_g, norm_ffn_g, ffn_w_gate, ffn_w_up, ffn_w_down,
              ab_w_in, mla_q_a_norm, mla_w_uq, mla_kv_a_norm, mla_w_ukv, mla_q_norm, mla_k_norm,
              gdn_conv_w, gdn_a_log, gdn_dt_bias, gdn_out_norm, ab_w_out,
              cd_w_in, diff_q_norm, diff_k_norm, diff_lambda, diff_sub_norm,
              gla_gate_w2, gla_gate_b2, gla_out_norm, cd_w_out):
    bsz = x.shape[0]
    for layer in range(DEPTH):
        last = layer == DEPTH - 1
        need_ctx = not last
        mod = (jax.nn.silu(c) @ ada_w[layer] + ada_b[layer]).reshape(bsz, N_MOD, 1, D_MODEL)
        mod_c = (jax.nn.silu(c_ctx) @ ada_w[layer] + ada_b[layer]).reshape(N_MOD, 1, D_MODEL)
        shift1, scale1, gate1, shift2, scale2, gate2 = (mod[:, i] for i in range(N_MOD))
        cshift1, cscale1, cgate1, cshift2, cscale2, cgate2 = (mod_c[i] for i in range(N_MOD))
        h = modulate(x, norm_mix_g[layer], shift1, scale1)
        hc = modulate(ctx, norm_mix_g[layer], cshift1, cscale1)
        i = layer // 2
        if layer % 2 == 0:
            y, yc = mla_gdn_mixer(h, hc, ab_w_in[i], mla_q_a_norm[i], mla_w_uq[i], mla_kv_a_norm[i], mla_w_ukv[i],
                                  mla_q_norm[i], mla_k_norm[i], gdn_conv_w[i], gdn_a_log[i], gdn_dt_bias[i],
                                  gdn_out_norm[i], ab_w_out[i], need_ctx)
        else:
            lam_init = 0.8 - 0.6 * math.exp(-0.3 * layer)
            y, yc = diff_gla_mixer(h, hc, cd_w_in[i], diff_q_norm[i], diff_k_norm[i], diff_lambda[i],
                                   diff_sub_norm[i], gla_gate_w2[i], gla_gate_b2[i], gla_out_norm[i], cd_w_out[i],
                                   lam_init, need_ctx)
        x = x + gate1 * y
        x = x + gate2 * swiglu(modulate(x, norm_ffn_g[layer], shift2, scale2),
                               ffn_w_gate[layer], ffn_w_up[layer], ffn_w_down[layer])
        if need_ctx:
            ctx = ctx + cgate1 * yc
            ctx = ctx + cgate2 * swiglu(modulate(ctx, norm_ffn_g[layer], cshift2, cscale2),
                                        ffn_w_gate[layer], ffn_w_up[layer], ffn_w_down[layer])
    return x
```

```cpp
#include <hip/hip_runtime.h>
#include <hip/hip_cooperative_groups.h>
#include <cstdio>
#include <cstdint>
namespace cg = cooperative_groups;

#define DEVI __device__ __forceinline__
typedef unsigned short bf16_t;
typedef short bf16x8 __attribute__((ext_vector_type(8)));
typedef short bf16x4 __attribute__((ext_vector_type(4)));
typedef float f32x4 __attribute__((ext_vector_type(4)));
typedef float f32x2 __attribute__((ext_vector_type(2)));
typedef unsigned u32x4 __attribute__((ext_vector_type(4)));
typedef unsigned u32x2 __attribute__((ext_vector_type(2)));
typedef __bf16 bfv2 __attribute__((ext_vector_type(2)));

constexpr int D = 2048, NB = 4, SEQ = 4096, CTX = 256, TPB = SEQ + CTX  , NT = NB * TPB  ;
constexpr int NCH = TPB / 64;
constexpr int FFN = 5632;
constexpr int AB_IN = 5216, AB_INP = 5376, CD_IN = 6176, CD_INP = 6400;
constexpr int MODN = 6 * D;
constexpr int LDH = 2112, LDZ0 = 5440, LDZ1 = 6464, LDG = 5696, LDW = 2112, LDW5 = 576, LDWF = 5696, LDK = 1600, LDQA = 576, TPS = 4416;
constexpr float EPS = 1e-6f;
constexpr float LOG2E = 1.4426950408889634f;

constexpr size_t OFF_CTR = 0;
constexpr size_t OFF_MOD = 4096;
constexpr size_t OFF_CTXRES = OFF_MOD + (size_t)2 * 5 * MODN * 4;
constexpr size_t OFF_WMIX = OFF_CTXRES + (size_t)NB * CTX * D * 4;
constexpr size_t OFF_H = OFF_WMIX + (size_t)41943040;
constexpr size_t OFF_MIX = OFF_H + (size_t)NT * LDH * 2;
constexpr size_t OFF_Z = OFF_MIX + (size_t)NT * LDH * 2;
constexpr size_t OFF_R2 = OFF_Z + (size_t)NT * LDZ1 * 2;
constexpr size_t SZ_T = (size_t)4096 * TPS * 2;
constexpr size_t SZ_TOK1024 = (size_t)NT * 1024 * 2;
constexpr size_t WM_IN = 0;
constexpr size_t WM_OUT = (size_t)CD_INP * LDW;
constexpr size_t WM_UQ = WM_OUT + (size_t)D * LDW;
constexpr size_t WM_UKV = WM_UQ + (size_t)1536 * LDW5;
static_assert((WM_UKV + (size_t)2048 * LDW5) * 2 <= 41943040, "wmix");
constexpr size_t R_QUP = 0;
constexpr size_t R_K = R_QUP + (size_t)NT * 1536 * 2;
constexpr size_t R_VT = R_K + (size_t)NT * LDK * 2;
constexpr size_t R_GQ = R_VT + SZ_T;
constexpr size_t R_GK = R_GQ + SZ_TOK1024;
constexpr size_t R_GKT = R_GK + SZ_TOK1024;
constexpr size_t R_GVT = R_GKT + SZ_T;
constexpr size_t R_TM = R_GVT + SZ_T;
constexpr size_t R_QKM = R_TM + SZ_TOK1024;
constexpr size_t R_GC = R_QKM + SZ_TOK1024;
constexpr size_t R_BETA = R_GC + (size_t)NT * 16 * 4;
constexpr size_t R_GATES = R_BETA + (size_t)NT * 16 * 4;
constexpr size_t R_END0 = R_GATES + (size_t)NT * 32 * 4;
constexpr size_t R1_VT = 0;
constexpr size_t R1_QG = R1_VT + SZ_T;
constexpr size_t R1_KGT = R1_QG + SZ_TOK1024;
constexpr size_t R1_VTG = R1_KGT + SZ_T;
constexpr size_t R1_AM = R1_VTG + SZ_T;
constexpr size_t R1_EL = R1_AM + (size_t)2176 * 4096 * 2;
constexpr size_t R1_GATES = R1_EL + (size_t)2176 * 128 * 4;
constexpr size_t R1_REC = R1_GATES + (size_t)NT * 32 * 4;
constexpr size_t R1_END = R1_REC + 2 * SZ_TOK1024;
constexpr size_t RF_GU = 0;
constexpr size_t RF_D = RF_GU + (size_t)2 * FFN * LDW * 2;
static_assert(RF_D + (size_t)D * LDWF * 2 <= R1_KGT, "ffn overlay L1");
static_assert(RF_D + (size_t)D * LDWF * 2 <= R_VT, "ffn overlay L0");
static_assert(NT * (size_t)LDG * 2 <= NT * (size_t)LDZ1 * 2, "G fits Z");
constexpr size_t R_PART = (size_t)128 << 20;
constexpr size_t WS_NEED = OFF_R2 + (R_END0 > R1_END ? R_END0 : R1_END);
static_assert(WS_NEED <= (size_t)805306368, "ws");

struct P {
  const float *x, *c, *ctx, *c_ctx, *ada_w, *ada_b, *norm_mix_g, *norm_ffn_g, *ffn_w_gate, *ffn_w_up, *ffn_w_down;
  const float *ab_w_in, *mla_q_a_norm, *mla_w_uq, *mla_kv_a_norm, *mla_w_ukv, *mla_q_norm, *mla_k_norm;
  const float *gdn_conv_w, *gdn_a_log, *gdn_dt_bias, *gdn_out_norm, *ab_w_out;
  const float *cd_w_in, *diff_q_norm, *diff_k_norm, *diff_lambda, *diff_sub_norm, *gla_gate_w2, *gla_gate_b2, *gla_out_norm, *cd_w_out;
  float* out;
  char* ws;
};

DEVI unsigned pk2(float lo, float hi) { f32x2 v = {lo, hi}; bfv2 b = __builtin_convertvector(v, bfv2); return __builtin_bit_cast(unsigned, b); }
DEVI float bflo(unsigned u) { return __uint_as_float(u << 16); }
DEVI float bfhi(unsigned u) { return __uint_as_float(u & 0xffff0000u); }
DEVI float bf2f(bf16_t h) { return __uint_as_float(((unsigned)h) << 16); }
DEVI bf16_t f2bf(float f) { return (bf16_t)(pk2(f, 0.f) & 0xffffu); }
DEVI f32x4 mfma16(bf16x8 a, bf16x8 b, f32x4 c) { return __builtin_amdgcn_mfma_f32_16x16x32_bf16(a, b, c, 0, 0, 0); }
DEVI bf16x8 pack8(f32x4 a, f32x4 b) { u32x4 u = {pk2(a[0], a[1]), pk2(a[2], a[3]), pk2(b[0], b[1]), pk2(b[2], b[3])}; return __builtin_bit_cast(bf16x8, u); }
DEVI u32x2 pack4(f32x4 a) { u32x2 u = {pk2(a[0], a[1]), pk2(a[2], a[3])}; return u; }
DEVI bf16x8 cat8(u32x2 lo, u32x2 hi) { u32x4 u = {lo[0], lo[1], hi[0], hi[1]}; return __builtin_bit_cast(bf16x8, u); }
DEVI float wave_sum(float v) {
#pragma unroll
  for (int o = 32; o > 0; o >>= 1) v += __shfl_xor(v, o);
  return v;
}
DEVI float silu_f(float v) { return v * __builtin_amdgcn_rcpf(1.f + __expf(-v)); }
DEVI float* xrow(const P& p, int r) {
  int b = r / TPB, q = r - b * TPB;
  return q < CTX ? (float*)(p.ws + OFF_CTXRES) + (size_t)(b * CTX + q) * D : p.out + (size_t)(b * SEQ + q - CTX) * D;
}
DEVI int modidx(int r) { int b = r / TPB; return (r - b * TPB) < CTX ? 4 : b; }
DEVI bf16x8 ldsperm(const bf16_t* base, int row, int stride, int ks, int fq) {
  const bf16_t* p = base + row * stride + ks * 32 + fq * 4;
  u32x2 lo = *(const u32x2*)p, hi = *(const u32x2*)(p + 16);
  return cat8(lo, hi);
}

DEVI int lane_id() { int l; asm volatile("v_mbcnt_lo_u32_b32 %0, -1, 0\n\tv_mbcnt_hi_u32_b32 %0, -1, %0" : "=v"(l)); return l; }
#define VT ((((sw) & 3) << 6) | lane_id())
constexpr int VB_CTR_OFF = 75776 - 32;
DEVI void vbar(const void* vbase) {
  typedef __attribute__((address_space(3))) unsigned lds_u32;
  lds_u32* ctr = (lds_u32*)(size_t)(unsigned)(size_t)(__attribute__((address_space(3))) const char*)((const char*)vbase + VB_CTR_OFF);
  __builtin_amdgcn_fence(__ATOMIC_RELEASE, "workgroup");
  asm volatile("s_waitcnt vmcnt(0) lgkmcnt(0)" ::: "memory");
  unsigned old = 0;
  if (lane_id() == 0) old = __hip_atomic_fetch_add(ctr, 1u, __ATOMIC_RELAXED, __HIP_MEMORY_SCOPE_WORKGROUP);
  const unsigned gen = (unsigned)__builtin_amdgcn_readfirstlane((int)old) >> 2;
  while ((__hip_atomic_load(ctr, __ATOMIC_RELAXED, __HIP_MEMORY_SCOPE_WORKGROUP) >> 2) == gen) __builtin_amdgcn_s_sleep(1);
  __builtin_amdgcn_fence(__ATOMIC_ACQUIRE, "workgroup");
  asm volatile("" ::: "memory");
}
struct EpiStore {
  bf16_t* C; int ldc; float* side; int side_c0;
  DEVI void operator()(const f32x4 (&acc)[8][4], int nb, int mb, int fr, int fq, int pk) const {
#pragma unroll
    for (int ni = 0; ni < 4; ++ni) {
      const int m = mb + ni * 16 + fr;
#pragma unroll
      for (int mi = 0; mi < 8; ++mi) {
        const int n = nb + mi * 16 + fq * 4;
        *(u32x2*)(C + (size_t)m * ldc + n) = pack4(acc[mi][ni]);
        if (side && n >= side_c0 && n < side_c0 + 32) *(f32x4*)(side + (size_t)m * 32 + (n - side_c0)) = acc[mi][ni];
      }
      asm volatile("" ::: "memory");
    }
  }
};
struct EpiResid {
  float* out; float* ctxres; const float* gate; float* part;
  DEVI void operator()(const f32x4 (&acc)[8][4], int nb, int mb, int fr, int fq, int pk) const {
#pragma unroll
    for (int ni = 0; ni < 4; ++ni) {
      const int m = mb + ni * 16 + fr;
      int bb = m / TPB, qq = m - bb * TPB;
      float* xr = qq < CTX ? ctxres + (size_t)(bb * CTX + qq) * D : out + (size_t)(bb * SEQ + qq - CTX) * D;
      const float* g = gate + (size_t)(qq < CTX ? 4 : bb) * MODN;
#pragma unroll
      for (int mi = 0; mi < 8; ++mi) {
        const int n = nb + mi * 16 + fq * 4;
        const f32x4 gv = *(const f32x4*)(g + n);
        if (pk >= 0) {
          *(f32x4*)(part + ((size_t)(pk * (NB * CTX) + bb * CTX + qq)) * D + n) = acc[mi][ni];
        } else {
          f32x4 xv = *(f32x4*)(xr + n);
          xv += gv * acc[mi][ni];
          *(f32x4*)(xr + n) = xv;
        }
        if ((mi & 1) == 1) asm volatile("" ::: "memory");
      }
    }
  }
};
struct EpiProbe {
  float* dump; int flag;
  DEVI void operator()(const f32x4 (&acc)[8][4], int nb, int mb, int fr, int fq, int pk) const {
    if (flag) {
#pragma unroll
      for (int mi = 0; mi < 8; ++mi)
#pragma unroll
        for (int ni = 0; ni < 4; ++ni) *(f32x4*)(dump + (size_t)(mi * 4 + ni) * 4096 + (fr * 4 + fq) * 4) = acc[mi][ni];
    }
  }
};
struct EpiSwiglu {
  bf16_t* G;
  DEVI void operator()(const f32x4 (&acc)[8][4], int nb, int mb, int fr, int fq, int pk) const {
#pragma unroll
    for (int ni = 0; ni < 4; ++ni) {
      const int m = mb + ni * 16 + fr;
#pragma unroll
      for (int mi = 0; mi < 8; mi += 2) {
        const int R = nb + mi * 16;
        const int hc = (R >> 5) * 16 + fq * 4;
        f32x4 g = acc[mi][ni], u = acc[mi + 1][ni], o;
#pragma unroll
        for (int j = 0; j < 4; ++j) o[j] = silu_f(g[j]) * u[j];
        *(u32x2*)(G + (size_t)m * LDG + hc) = pack4(o);
      }
    }
  }
};
DEVI int lds_byte2(int r, int c) { int st = (r >> 4) * 2 + (c >> 5), ob = (r & 15) * 64 + (c & 31) * 2; return st * 1024 + (ob ^ (((ob >> 9) & 1) << 5)); }
DEVI void stage_rc2(int b, int& R, int& C) { int st = b >> 10, sb = b & 1023, swz = sb ^ (((sb >> 9) & 1) << 5); R = (st >> 1) * 16 + swz / 64; C = (st & 1) * 32 + (swz % 64) / 2; }

template <int MODE, class Epi>
DEVI void gemm256_phase(int sw, const bf16_t* __restrict__ W, int ldw, const bf16_t* __restrict__ X, int ldx, int K, int nN, char* shm, const Epi& epi) {
  constexpr int TILE_B = 256 * 64 * 2, STAGE_B = 2 * TILE_B;
  const int wid = sw, lane = lane_id(), wr = wid >> 2, wc = wid & 3, fr = lane & 15, fq = lane >> 4;
  const int lds_lo = (fr * 64 + fq * 16) ^ ((fr >> 3) << 5);
  unsigned offW[4], offX[4];
#pragma unroll
  for (int i = 0; i < 4; ++i) { int R, C; stage_rc2(wid * 1024 + i * 8192 + lane * 16, R, C); offW[i] = (unsigned)(R * ldw + C) * 2u; offX[i] = (unsigned)(R * ldx + C) * 2u; }
  const int ntf = K >> 6;
  const int nM = (MODE == 0 || MODE == 3) ? 68 : 64, nfull = nM * nN, nunits = MODE == 2 ? nfull + 256 : nfull;
  auto decode = [&](int L, int& n0, int& m0, int& kt0, int& ntk) {
    if (MODE == 2 && L >= nfull) {
      const int j = L - nfull, tile = j >> 3, ks = j & 7;
      n0 = (tile & 7) * 256; m0 = (tile >> 3) * 17 * 256; ntk = ntf >> 3; kt0 = ks * ntk;
    } else {
      int wgid = L;
      { const int q = nfull / 8, r = nfull % 8, xcd = wgid % 8, off = wgid / 8; wgid = (xcd < r ? xcd * (q + 1) : r * (q + 1) + (xcd - r) * q) + off; }
      constexpr int WGM = 4;
      const int nig = WGM * nN, gid = wgid / nig, fm = gid * WGM, gsz = (nM - fm) < WGM ? (nM - fm) : WGM;
      const int pm = fm + ((wgid % nig) % gsz), pn = (wgid % nig) / gsz;
      n0 = pn * 256; m0 = (MODE == 0 ? pm : (pm / 16) * 17 + 1 + (pm % 16)) * 256; kt0 = 0; ntk = ntf;
    }
    if (MODE == 3) { n0 = 0; m0 = 0; }
    n0 = __builtin_amdgcn_readfirstlane(n0); m0 = __builtin_amdgcn_readfirstlane(m0);
    kt0 = __builtin_amdgcn_readfirstlane(kt0); ntk = __builtin_amdgcn_readfirstlane(ntk);
  };
  auto stage = [&](int buf, int n0, int m0, int kt) {
    const char* wk = (const char*)(W + (size_t)n0 * ldw) + kt * 128;
    const char* xk = (const char*)(X + (size_t)m0 * ldx) + kt * 128;
#pragma unroll
    for (int i = 0; i < 4; ++i) {
      unsigned ow = offW[i], ox = offX[i];
      asm volatile("" : "+v"(ow), "+v"(ox));
      __builtin_amdgcn_global_load_lds((const unsigned*)(wk + ow), (unsigned*)(shm + buf * STAGE_B + wid * 1024 + i * 8192), 16, 0, 0);
      __builtin_amdgcn_global_load_lds((const unsigned*)(xk + ox), (unsigned*)(shm + buf * STAGE_B + TILE_B + wid * 1024 + i * 8192), 16, 0, 0);
    }
  };
  int L = blockIdx.x;
  if (L >= nunits) return;
  int n0, m0, kt0, ntk;
  decode(L, n0, m0, kt0, ntk);
  int b0 = 0;
  stage(0, n0, m0, kt0);
  asm volatile("s_waitcnt vmcnt(0)" ::: "memory");
  __syncthreads();
  while (true) {
    const int Ln = L + gridDim.x;
    const bool has_next = Ln < nunits;
    int n1 = 0, m1 = 0, kt1 = 0, ntk1 = 0;
    if (has_next) decode(Ln, n1, m1, kt1, ntk1);
    f32x4 acc[8][4];
#pragma unroll
    for (int i = 0; i < 8; ++i)
#pragma unroll
      for (int j = 0; j < 4; ++j) acc[i][j] = (f32x4){0.f, 0.f, 0.f, 0.f};
    for (int t = 0; t < ntk; ++t) {
      const int cur = (b0 + t) & 1;
      const bool st_own = t + 1 < ntk, st_next = !st_own && has_next;
      if (wid < 4) {
        if (st_own) stage(cur ^ 1, n0, m0, kt0 + t + 1);
        else if (st_next) stage(cur ^ 1, n1, m1, kt1);
      }
      const char* SAp = shm + cur * STAGE_B + wr * (16 * 1024) + lds_lo;
      const char* SBp = shm + cur * STAGE_B + TILE_B + wc * (8 * 1024) + lds_lo;
#pragma unroll
      for (int ks = 0; ks < 2; ++ks) {
        const int kx = (wid >> 2) ? (1 - 2 * ks) * 1024 : 0;
        bf16x8 At[8], Bf[4];
#pragma unroll
        for (int m = 0; m < 8; ++m) At[m] = *(const bf16x8*)(SAp + (2 * m + ks) * 1024 + kx);
#pragma unroll
        for (int n = 0; n < 4; ++n) Bf[n] = *(const bf16x8*)(SBp + (2 * n + ks) * 1024 + kx);
#pragma unroll
        for (int m = 0; m < 8; ++m)
#pragma unroll
          for (int n = 0; n < 4; ++n) acc[m][n] = mfma16(At[m], Bf[n], acc[m][n]);
        __builtin_amdgcn_sched_barrier(0);
        if (ks == 0 && wid >= 4) {
          if (st_own) stage(cur ^ 1, n0, m0, kt0 + t + 1);
          else if (st_next) stage(cur ^ 1, n1, m1, kt1);
        }
      }
      asm volatile("s_waitcnt vmcnt(0)" ::: "memory");
      __syncthreads();
    }
    epi(acc, n0 + wr * 128, m0 + wc * 64, fr, fq, (MODE == 2 && L >= nfull) ? ((L - nfull) & 7) : -1);
    if (!has_next) break;
    b0 = (b0 + ntk) & 1; L = Ln; n0 = n1; m0 = m1; kt0 = kt1; ntk = ntk1;
  }
}

DEVI void cvt_tile(int sw, const float* __restrict__ src, int ldn, int Nvalid, bf16_t* __restrict__ dst, int ldk, int kt, int nt, int rmul, int roff, float* sm) {
  const int tid = VT;
  const int k0 = kt * 64, n0 = nt * 64;
  vbar(sm);
  {
    const int n4 = (tid & 15) * 4, n = n0 + n4;
    f32x4 v[4];
#pragma unroll
    for (int i = 0; i < 4; ++i) {
      const int kk = (tid >> 4) + 16 * i;
      v[i] = (n < Nvalid) ? *(const f32x4*)(src + (size_t)(k0 + kk) * ldn + n) : (f32x4){0.f, 0.f, 0.f, 0.f};
    }
#pragma unroll
    for (int i = 0; i < 4; ++i) {
      const int kk = (tid >> 4) + 16 * i;
#pragma unroll
      for (int jj = 0; jj < 4; ++jj) sm[(n4 + jj) * 65 + kk] = v[i][jj];
    }
  }
  vbar(sm);
  {
    int nn = tid >> 2, kq = tid & 3, n = n0 + nn;
    int drow = (n >> 4) * rmul + roff + (n & 15);
    const float* s = sm + nn * 65 + kq * 16;
    u32x4 a = {pk2(s[0], s[1]), pk2(s[2], s[3]), pk2(s[4], s[5]), pk2(s[6], s[7])};
    u32x4 b = {pk2(s[8], s[9]), pk2(s[10], s[11]), pk2(s[12], s[13]), pk2(s[14], s[15])};
    bf16_t* d = dst + (size_t)drow * ldk + k0 + kq * 16;
    *(u32x4*)d = a; *(u32x4*)(d + 8) = b;
  }
}
DEVI bool cvt_try(int sw, int& idx, const float* src, int N, int Npad, bf16_t* dst, int K, int ldk, int rmul, int roff, float* sm) {
  int kts = K >> 6, n = kts * (Npad >> 6);
  if (idx < n) { cvt_tile(sw, src, N, N, dst, ldk, idx % kts, idx / kts, rmul, roff, sm); return true; }
  idx -= n; return false;
}
DEVI void cvt_ffn(int sw, const P& p, int layer, int idx, float* sm) {
  bf16_t* gu = (bf16_t*)(p.ws + OFF_R2 + RF_GU); bf16_t* dn = (bf16_t*)(p.ws + OFF_R2 + RF_D);
  if (cvt_try(sw, idx, p.ffn_w_gate + (size_t)layer * D * FFN, FFN, FFN, gu, D, LDW, 32, 0, sm)) return;
  if (cvt_try(sw, idx, p.ffn_w_up + (size_t)layer * D * FFN, FFN, FFN, gu, D, LDW, 32, 16, sm)) return;
  cvt_try(sw, idx, p.ffn_w_down + (size_t)layer * FFN * D, D, D, dn, FFN, LDWF, 16, 0, sm);
}
constexpr int CVT_FFN_ITEMS = 3 * (D / 64) * (FFN / 64);
constexpr int CVT_MIX0_ITEMS = 32 * 84 + 8 * 24 + 8 * 32 + 32 * 32;
constexpr int CVT_MIX1_ITEMS = 32 * 100 + 32 * 32;
DEVI void cvt_mix0(int sw, const P& p, int idx, float* sm) {
  bf16_t* w = (bf16_t*)(p.ws + OFF_WMIX);
  if (cvt_try(sw, idx, p.ab_w_in, AB_IN, AB_INP, w + WM_IN, D, LDW, 16, 0, sm)) return;
  if (cvt_try(sw, idx, p.mla_w_uq, 1536, 1536, w + WM_UQ, 512, LDW5, 16, 0, sm)) return;
  if (cvt_try(sw, idx, p.mla_w_ukv, 2048, 2048, w + WM_UKV, 512, LDW5, 16, 0, sm)) return;
  cvt_try(sw, idx, p.ab_w_out, D, D, w + WM_OUT, D, LDW, 16, 0, sm);
}
DEVI void cvt_mix1(int sw, const P& p, int idx, float* sm) {
  bf16_t* w = (bf16_t*)(p.ws + OFF_WMIX);
  if (cvt_try(sw, idx, p.cd_w_in, CD_IN, CD_INP, w + WM_IN, D, LDW, 16, 0, sm)) return;
  cvt_try(sw, idx, p.cd_w_out, D, D, w + WM_OUT, D, LDW, 16, 0, sm);
}

DEVI void ada_item(int sw, const P& p, int item, float* sm) {
  const int tid = VT;
  const int l = item / 96, cb = item % 96;
  float* sc = sm;
  float* red = sm + 5 * 2048;
  vbar(sm);
  for (int i = tid; i < 5 * 2048; i += 256) {
    int s5 = i >> 11, k = i & 2047;
    float v = s5 < 4 ? p.c[s5 * D + k] : p.c_ctx[k];
    sc[i] = silu_f(v);
  }
  vbar(sm);
  const int ct = tid & 31, kg = tid >> 5;
  const float* w = p.ada_w + ((size_t)l * D + kg * 256) * MODN + cb * 128 + ct * 4;
  f32x4 a0 = {0.f, 0.f, 0.f, 0.f}, a1 = a0, a2 = a0, a3 = a0, a4 = a0;
#pragma unroll 16
  for (int k = 0; k < 256; ++k) {
    const f32x4 wv = *(const f32x4*)(w + (size_t)k * MODN);
    const int kk = kg * 256 + k;
    a0 += sc[kk] * wv; a1 += sc[2048 + kk] * wv; a2 += sc[4096 + kk] * wv; a3 += sc[6144 + kk] * wv; a4 += sc[8192 + kk] * wv;
  }
  *(f32x4*)(red + (kg * 5 + 0) * 128 + ct * 4) = a0; *(f32x4*)(red + (kg * 5 + 1) * 128 + ct * 4) = a1; *(f32x4*)(red + (kg * 5 + 2) * 128 + ct * 4) = a2;
  *(f32x4*)(red + (kg * 5 + 3) * 128 + ct * 4) = a3; *(f32x4*)(red + (kg * 5 + 4) * 128 + ct * 4) = a4;
  vbar(sm);
  for (int i = tid; i < 5 * 128; i += 256) {
    int s5 = i >> 7, cc = i & 127;
    float v = 0.f;
#pragma unroll
    for (int g = 0; g < 8; ++g) v += red[(g * 5 + s5) * 128 + cc];
    int n = cb * 128 + cc;
    ((float*)(p.ws + OFF_MOD))[((size_t)l * 5 + s5) * MODN + n] = v + p.ada_b[(size_t)l * MODN + n];
  }
}

DEVI void modulate_phase(int sw, const P& p, const float* g, const float* modl, int shift_i, int scale_i, bf16_t* H, const float* part = nullptr, const float* gate_ctx = nullptr, bool from_input = false, bool skip_ctx = false) {
  const int lane = VT & 63;
  const int gw = (blockIdx.x * 2 + (sw >> 2)) * 4 + (sw & 3), nw = gridDim.x * 8;
  for (int r = gw; r < NT; r += nw) {
    if (skip_ctx && (r % TPB) < CTX) continue;
    const float* xr = xrow(p, r);
    if (from_input) { const int bb = r / TPB, qq = r - bb * TPB; xr = qq < CTX ? p.ctx + (size_t)(bb * CTX + qq) * D : p.x + (size_t)(bb * SEQ + qq - CTX) * D; }
    const float* mb = modl + (size_t)modidx(r) * MODN;
    f32x4 v[8]; float ss = 0.f;
#pragma unroll
    for (int i = 0; i < 8; ++i) v[i] = *(const f32x4*)(xr + i * 256 + lane * 4);
    if (part && modidx(r) == 4) {
      const int cr = (r / TPB) * CTX + (r % TPB);
#pragma unroll
      for (int i = 0; i < 8; ++i) {
        f32x4 sacc = {0.f, 0.f, 0.f, 0.f};
#pragma unroll
        for (int ks = 0; ks < 8; ++ks) sacc += *(const f32x4*)(part + ((size_t)(ks * (NB * CTX) + cr)) * D + i * 256 + lane * 4);
        v[i] += *(const f32x4*)(gate_ctx + i * 256 + lane * 4) * sacc;
        *(f32x4*)(xrow(p, r) + i * 256 + lane * 4) = v[i];
      }
    }
    if (from_input) {
      float* xw = xrow(p, r);
#pragma unroll
      for (int i = 0; i < 8; ++i) *(f32x4*)(xw + i * 256 + lane * 4) = v[i];
    }
#pragma unroll
    for (int i = 0; i < 8; ++i) ss += v[i][0] * v[i][0] + v[i][1] * v[i][1] + v[i][2] * v[i][2] + v[i][3] * v[i][3];
    ss = wave_sum(ss);
    float rs = rsqrtf(ss * (1.f / D) + EPS);
#pragma unroll
    for (int i = 0; i < 8; ++i) {
      int cidx = i * 256 + lane * 4;
      f32x4 gg = *(const f32x4*)(g + cidx), sh = *(const f32x4*)(mb + shift_i * D + cidx), sc = *(const f32x4*)(mb + scale_i * D + cidx);
      f32x4 y;
#pragma unroll
      for (int j = 0; j < 4; ++j) y[j] = v[i][j] * rs * gg[j] * (1.f + sc[j]) + sh[j];
      *(u32x2*)(H + (size_t)r * LDH + cidx) = pack4(y);
    }
  }
}

template <int DQK>
DEVI void attn256_item(int sw, const bf16_t* __restrict__ Q, int ldq, const bf16_t* __restrict__ Kp, int ldk, const bf16_t* __restrict__ Vt,
                       bf16_t* __restrict__ O, int ldo, int nkeys, float negB, char* shm) {
  constexpr int KS = DQK / 32, KCH = DQK / 8, KBYTES = 64 * DQK * 2, STG = KBYTES + 16384, NKI = (64 * KCH) / 512;
  const int wid = sw, lane = lane_id(), fr = lane & 15, fq = lane >> 4, rsw = (fr >> 1) & 7;
  unsigned offK[NKI], offV[2];
#pragma unroll
  for (int i = 0; i < NKI; ++i) {
    const int q = (wid * NKI + i) * 64 + lane, row = q / KCH, cp = q - row * KCH;
    const int c = (cp & ~7) | ((cp & 7) ^ ((row >> 1) & 7));
    offK[i] = (unsigned)(row * ldk + c * 8) * 2u;
  }
#pragma unroll
  for (int i = 0; i < 2; ++i) {
    const int q = (wid * 2 + i) * 64 + lane, row = q >> 3, cp = q & 7;
    const int c = cp ^ ((row >> 1) & 7);
    offV[i] = (unsigned)(row * TPS + c * 8) * 2u;
  }
  auto stage = [&](int buf, int k0) {
    const char* kb = (const char*)(Kp + (size_t)k0 * ldk);
    const char* vb = (const char*)(Vt + k0);
#pragma unroll
    for (int i = 0; i < NKI; ++i) {
      unsigned o = offK[i]; asm volatile("" : "+v"(o));
      __builtin_amdgcn_global_load_lds((const unsigned*)(kb + o), (unsigned*)(shm + buf * STG + (wid * NKI + i) * 1024), 16, 0, 0);
    }
#pragma unroll
    for (int i = 0; i < 2; ++i) {
      unsigned o = offV[i]; asm volatile("" : "+v"(o));
      __builtin_amdgcn_global_load_lds((const unsigned*)(vb + o), (unsigned*)(shm + buf * STG + KBYTES + (wid * 2 + i) * 1024), 16, 0, 0);
    }
  };
  bf16x8 qf[2][KS];
#pragma unroll
  for (int nt = 0; nt < 2; ++nt)
#pragma unroll
    for (int ks = 0; ks < KS; ++ks) qf[nt][ks] = *(const bf16x8*)(Q + (size_t)(wid * 32 + nt * 16 + fr) * ldq + ks * 32 + fq * 8);
  f32x4 o[8][2];
#pragma unroll
  for (int i = 0; i < 8; ++i) { o[i][0] = (f32x4){0.f, 0.f, 0.f, 0.f}; o[i][1] = (f32x4){0.f, 0.f, 0.f, 0.f}; }
  float l_[2] = {0.f, 0.f};
  const int ntile = nkeys >> 6;
  __syncthreads();
  stage(0, 0);
  asm volatile("s_waitcnt vmcnt(0)" ::: "memory");
  __syncthreads();
  for (int t = 0; t < ntile; ++t) {
    const int cur = t & 1;
    if (wid < 4 && t + 1 < ntile) stage(cur ^ 1, (t + 1) * 64);
    const bf16_t* Ks = (const bf16_t*)(shm + cur * STG);
    const char* Vs = shm + cur * STG + KBYTES;
#pragma unroll
    for (int half = 0; half < 2; ++half) {
      f32x4 s[2][2];
#pragma unroll
      for (int i = 0; i < 2; ++i) { s[i][0] = (f32x4){negB, negB, negB, negB}; s[i][1] = (f32x4){negB, negB, negB, negB}; }
#pragma unroll
      for (int ks = 0; ks < KS; ++ks)
#pragma unroll
        for (int kt = 0; kt < 2; ++kt) {
          const int krow = half * 32 + 8 * (fr >> 2) + 4 * kt + (fr & 3);
          const int ksw = (krow >> 1) & 7;
          bf16x8 kf = *(const bf16x8*)(Ks + krow * DQK + ((((ks * 4 + fq) & ~7) | (((ks * 4 + fq) & 7) ^ ksw)) * 8));
          s[kt][0] = mfma16(kf, qf[0][ks], s[kt][0]);
          s[kt][1] = mfma16(kf, qf[1][ks], s[kt][1]);
        }
      bf16x8 pf[2];
#pragma unroll
      for (int nt = 0; nt < 2; ++nt) {
        float rs = 0.f;
#pragma unroll
        for (int kt = 0; kt < 2; ++kt)
#pragma unroll
          for (int j = 0; j < 4; ++j) { float pv = __builtin_amdgcn_exp2f(s[kt][nt][j]); s[kt][nt][j] = pv; rs += pv; }
        l_[nt] += rs;
        pf[nt] = pack8(s[0][nt], s[1][nt]);
      }
#pragma unroll
      for (int dt = 0; dt < 8; ++dt) {
        bf16x8 vf = *(const bf16x8*)(Vs + (dt * 16 + fr) * 128 + (((half * 4 + fq) ^ rsw) * 16));
        o[dt][0] = mfma16(vf, pf[0], o[dt][0]);
        o[dt][1] = mfma16(vf, pf[1], o[dt][1]);
      }
      if (half == 0 && wid >= 4 && t + 1 < ntile) stage(cur ^ 1, (t + 1) * 64);
    }
    asm volatile("s_waitcnt vmcnt(0)" ::: "memory");
    __syncthreads();
  }
#pragma unroll
  for (int nt = 0; nt < 2; ++nt) {
    float l = l_[nt];
    l += __shfl_xor(l, 16); l += __shfl_xor(l, 32);
    float inv = 1.f / l;
#pragma unroll
    for (int dt = 0; dt < 8; ++dt) {
      f32x4 v = o[dt][nt] * inv;
      *(u32x2*)(O + (size_t)(wid * 32 + nt * 16 + fr) * ldo + dt * 16 + fq * 4) = pack4(v);
    }
  }
}

DEVI void prep0_norm512(int sw, const P& p, int item) {
  const int lane = lane_id();
  const int w0 = (item * 4 + (sw & 3)) * 8;
  u32x4 u[8];
#pragma unroll
  for (int q = 0; q < 8; ++q) { int w = w0 + q, r = w >> 1, which = w & 1; u[q] = *(const u32x4*)((const bf16_t*)(p.ws + OFF_Z) + (size_t)r * LDZ0 + which * 512 + lane * 8); }
#pragma unroll
  for (int q = 0; q < 8; ++q) {
    int w = w0 + q, r = w >> 1, which = w & 1;
    float v[8] = {bflo(u[q][0]), bfhi(u[q][0]), bflo(u[q][1]), bfhi(u[q][1]), bflo(u[q][2]), bfhi(u[q][2]), bflo(u[q][3]), bfhi(u[q][3])};
    float ss = 0.f;
#pragma unroll
    for (int j = 0; j < 8; ++j) ss += v[j] * v[j];
    ss = wave_sum(ss);
    float rs = rsqrtf(ss * (1.f / 512.f) + EPS);
    const float* g = (which ? p.mla_kv_a_norm : p.mla_q_a_norm) + lane * 8;
    u32x4 o = {pk2(v[0] * rs * g[0], v[1] * rs * g[1]), pk2(v[2] * rs * g[2], v[3] * rs * g[3]), pk2(v[4] * rs * g[4], v[5] * rs * g[5]), pk2(v[6] * rs * g[6], v[7] * rs * g[7])};
    *(u32x4*)((bf16_t*)(p.ws + OFF_H) + (size_t)which * NT * LDQA + (size_t)r * LDQA + lane * 8) = o;
  }
}
DEVI void store_T(int sw, const bf16_t* T, bf16_t* __restrict__ dst) {
  const int tid = VT;
#pragma unroll
  for (int i = 0; i < 4; ++i) {
    const int c = tid + 256 * i, row = c >> 3, ch = c & 7;
    *(u32x4*)(dst + (size_t)row * TPS + ch * 8) = *(const u32x4*)(T + row * 72 + ch * 8);
  }
}
DEVI void put_T(bf16_t* T, int d, int half, const float (&y)[32]) {
#pragma unroll
  for (int i = 0; i < 4; ++i) {
    u32x4 u = {pk2(y[8 * i], y[8 * i + 1]), pk2(y[8 * i + 2], y[8 * i + 3]), pk2(y[8 * i + 4], y[8 * i + 5]), pk2(y[8 * i + 6], y[8 * i + 7])};
    *(u32x4*)(T + d * 72 + half * 32 + 8 * i) = u;
  }
}
DEVI void prep0_gdn(int sw, const P& p, int item, float* sm) {
  const int tid = VT;
  const int which = item & 3; int t = item >> 2;
  const int mc = t % NCH; t /= NCH;
  const int h = t & 7, b = t >> 3;
  const int p0 = mc * 64;
  const int bh = b * 8 + h;
  char* R2 = p.ws + OFF_R2;
  if (which == 3) {
    if (tid < 128) {
      const int dir = tid >> 6, ln = tid & 63;
      const int c = dir ? 63 - ln : ln;
      const float* gr = (const float*)(R2 + R_GATES) + (size_t)(b * TPB + p0 + c) * 32;
      const float A = __expf(p.gdn_a_log[dir * 8 + h]), dtb = p.gdn_dt_bias[dir * 8 + h];
      const float a = gr[dir * 8 + h] + dtb, bb = gr[16 + dir * 8 + h];
      const float sp = fmaxf(a, 0.f) + log1pf(__expf(-fabsf(a)));
      float v = -A * sp;
#pragma unroll
      for (int off = 1; off < 64; off <<= 1) { float t2 = __shfl_up(v, off); if (ln >= off) v += t2; }
      ((float*)(R2 + R_GC))[(size_t)(bh * 2 + dir) * TPB + p0 + c] = v;
      ((float*)(R2 + R_BETA))[(size_t)(bh * 2 + dir) * TPB + p0 + c] = 1.f / (1.f + __expf(-bb));
    }
    vbar(sm);
    return;
  }
  const int d = tid & 127, half = tid >> 7;
  const int col0 = 1088 + which * 1024 + h * 128;
  const int col = col0 + d;
  const int lo = p0 < CTX ? 0 : CTX, hi = p0 < CTX ? CTX : TPB;
  bf16_t* xin = (bf16_t*)sm;
  float* sq = (float*)(xin + 72 * 128);
  float* nrm = sq + 64 * 129;
  bf16_t* yb = (bf16_t*)(nrm + 64);
  vbar(sm);
  {
    const bf16_t* zb = (const bf16_t*)(p.ws + OFF_Z) + (size_t)(b * TPB) * LDZ0 + col0;
    for (int c = tid; c < 68 * 16; c += 256) {
      const int row = c >> 4, ch = c & 15, pp = p0 - 2 + row;
      u32x4 v = {0u, 0u, 0u, 0u};
      if (pp >= lo && pp < hi) v = *(const u32x4*)(zb + (size_t)pp * LDZ0 + ch * 8);
      *(u32x4*)(xin + row * 128 + ch * 8) = v;
    }
  }
  vbar(sm);
  const float w0 = p.gdn_conv_w[0 * 3072 + col - 1088], w1 = p.gdn_conv_w[1 * 3072 + col - 1088], w2 = p.gdn_conv_w[2 * 3072 + col - 1088],
              w3 = p.gdn_conv_w[3 * 3072 + col - 1088], w4 = p.gdn_conv_w[4 * 3072 + col - 1088];
  const int ps = p0 + half * 32;
  const bf16_t* xc = xin + (half * 32) * 128 + d;
  float xm2 = bf2f(xc[0]), xm1 = bf2f(xc[128]), x0 = bf2f(xc[256]), xp1 = bf2f(xc[384]);
  float y[32];
#pragma unroll
  for (int i = 0; i < 32; ++i) {
    float xp2 = bf2f(xc[(i + 4) * 128]);
    float a = w0 * xm2 + w1 * xm1 + w2 * x0 + w3 * xp1 + w4 * xp2;
    y[i] = silu_f(a);
    xm2 = xm1; xm1 = x0; x0 = xp1; xp1 = xp2;
  }
  if (which == 2) {
    vbar(sm);
    put_T(xin, d, half, y);
    vbar(sm);
    store_T(sw, xin, (bf16_t*)(R2 + R_GVT) + ((size_t)bh * 128) * TPS + p0);
    return;
  }
#pragma unroll
  for (int i = 0; i < 32; ++i) sq[(half * 32 + i) * 129 + d] = y[i] * y[i];
  vbar(sm);
  {
    int c = tid >> 2, part = tid & 3;
    float sacc = 0.f;
    for (int i = 0; i < 32; ++i) sacc += sq[c * 129 + part * 32 + i];
    sacc += __shfl_xor(sacc, 1); sacc += __shfl_xor(sacc, 2);
    if (part == 0) nrm[c] = rsqrtf(sacc + EPS) * (which == 0 ? 0.08838834764831845f : 1.f);
  }
  vbar(sm);
#pragma unroll
  for (int i = 0; i < 32; ++i) { y[i] *= nrm[half * 32 + i]; yb[(half * 32 + i) * 136 + d] = f2bf(y[i]); }
  if (which == 1) put_T(xin, d, half, y);
  vbar(sm);
  if (which == 1) store_T(sw, xin, (bf16_t*)(R2 + R_GKT) + ((size_t)bh * 128) * TPS + p0);
  {
    bf16_t* dq = (bf16_t*)(R2 + (which == 0 ? R_GQ : R_GK)) + ((size_t)bh * TPB + p0) * 128;
#pragma unroll
    for (int i = 0; i < 4; ++i) {
      const int c = tid + 256 * i, row = c >> 4, ch = c & 15;
      *(u32x4*)(dq + row * 128 + ch * 8) = *(const u32x4*)(yb + row * 136 + ch * 8);
    }
  }
}

DEVI float rope64(float val, int lane, int t) {
  int i = lane & 15, hf = (lane >> 4) & 1, axis = lane >> 5;
  float pos = (float)(axis ? (t & 63) : (t >> 6));
  float invf = exp2f(-(float)(2 * i) * (13.287712379549449f / 32.f));
  float ang = pos * invf;
  float cs = __cosf(ang), sn = __sinf(ang);
  float partner = __shfl_xor(val, 16);
  return hf ? (val * cs + partner * sn) : (val * cs - partner * sn);
}

DEVI void prep0_q(int sw, const P& p, int item) {
  const int lane = lane_id();
  const int w0 = (item * 4 + (sw & 3)) * 8;
  const int r = w0 >> 3;
  bf16_t* qb = (bf16_t*)(p.ws + OFF_R2 + R_QUP) + (size_t)r * 1536;
  float a[8], b[8], c[8];
#pragma unroll
  for (int h = 0; h < 8; ++h) { a[h] = bf2f(qb[h * 192 + lane]); b[h] = bf2f(qb[h * 192 + 64 + lane]); c[h] = bf2f(qb[h * 192 + 128 + lane]); }
  const float g0 = p.mla_q_norm[lane], g1 = p.mla_q_norm[64 + lane], g2 = p.mla_q_norm[128 + lane];
  const int pp = r % TPB;
  const float sc = 0.07216878364870322f * LOG2E;
#pragma unroll
  for (int h = 0; h < 8; ++h) {
    float ss = wave_sum(a[h] * a[h] + b[h] * b[h] + c[h] * c[h]);
    float rs = rsqrtf(ss * (1.f / 192.f) + EPS);
    float x = a[h] * rs * g0, y = b[h] * rs * g1, z = c[h] * rs * g2;
    if (pp >= CTX) z = rope64(z, lane, pp - CTX);
    qb[h * 192 + lane] = f2bf(x * sc); qb[h * 192 + 64 + lane] = f2bf(y * sc); qb[h * 192 + 128 + lane] = f2bf(z * sc);
  }
}
DEVI void prep0_k(int sw, const P& p, int item) {
  const int lane = lane_id();
  const int w0 = (item * 4 + (sw & 3)) * 8;
  const int r = w0 >> 3;
  const bf16_t* kv = (const bf16_t*)(p.ws + OFF_MIX) + (size_t)r * LDH;
  const float c0 = bf2f(((const bf16_t*)(p.ws + OFF_Z) + (size_t)r * LDZ0 + 1024)[lane]);
  float a[8], b[8];
#pragma unroll
  for (int h = 0; h < 8; ++h) { a[h] = bf2f(kv[h * 256 + lane]); b[h] = bf2f(kv[h * 256 + 64 + lane]); }
  const float g0 = p.mla_k_norm[lane], g1 = p.mla_k_norm[64 + lane], g2 = p.mla_k_norm[128 + lane];
  const int pp = r % TPB;
  bf16_t* k = (bf16_t*)(p.ws + OFF_R2 + R_K) + (size_t)r * LDK;
#pragma unroll
  for (int h = 0; h < 8; ++h) {
    float ss = wave_sum(a[h] * a[h] + b[h] * b[h] + c0 * c0);
    float rs = rsqrtf(ss * (1.f / 192.f) + EPS);
    float x = a[h] * rs * g0, y = b[h] * rs * g1, z = c0 * rs * g2;
    if (pp >= CTX) z = rope64(z, lane, pp - CTX);
    k[h * 192 + lane] = f2bf(x); k[h * 192 + 64 + lane] = f2bf(y); k[h * 192 + 128 + lane] = f2bf(z);
  }
}
DEVI void transpose64x128(int sw, const bf16_t* __restrict__ src, int ld, bf16_t* __restrict__ dst  , char* smb) {
  const int tid = VT, d = tid & 127, half = tid >> 7;
  float y[32];
#pragma unroll
  for (int i = 0; i < 32; ++i) y[i] = bf2f(src[(size_t)(half * 32 + i) * ld + d]);
  bf16_t* T = (bf16_t*)smb;
  vbar(smb);
  put_T(T, d, half, y);
  vbar(smb);
  store_T(sw, T, dst);
}
DEVI void gdn_pre(int sw, const P& p, int item, char* smraw) {
  const int tid = VT, lane = tid & 63, wid = tid >> 6, fr = lane & 15, fq = lane >> 4;
  const int mc = item % NCH; int t = item / NCH;
  const int dir = t & 1, bh = t >> 1;
  const int p0 = mc * 64;
  char* R2 = p.ws + OFF_R2;
  bf16_t* qs = (bf16_t*)smraw;
  bf16_t* ks = qs + 64 * 136;
  float* Ls = (float*)(ks + 64 * 136);
  float* gcs = Ls + 4096;
  float* bes = gcs + 64;
  vbar(smraw);
  {
    const bf16_t* gq = (const bf16_t*)(R2 + R_GQ) + ((size_t)bh * TPB + p0) * 128;
    const bf16_t* gk = (const bf16_t*)(R2 + R_GK) + ((size_t)bh * TPB + p0) * 128;
#pragma unroll
    for (int i = 0; i < 4; ++i) {
      int c = tid + 256 * i, row = c >> 4, kc = c & 15;
      *(u32x4*)(qs + row * 136 + kc * 8) = *(const u32x4*)(gq + row * 128 + kc * 8);
      *(u32x4*)(ks + row * 136 + kc * 8) = *(const u32x4*)(gk + row * 128 + kc * 8);
    }
    if (tid < 64) {
      gcs[tid] = ((const float*)(R2 + R_GC))[(size_t)(bh * 2 + dir) * TPB + p0 + tid];
      bes[tid] = ((const float*)(R2 + R_BETA))[(size_t)(bh * 2 + dir) * TPB + p0 + tid];
    }
  }
  vbar(smraw);
  {
    const int it = wid;
    const int i = it * 16 + fr;
    const float gi = gcs[i], bi = bes[i];
    bf16x8 bq[4], bk[4];
#pragma unroll
    for (int s = 0; s < 4; ++s) {
      bq[s] = *(const bf16x8*)(qs + i * 136 + s * 32 + fq * 8);
      bk[s] = *(const bf16x8*)(ks + i * 136 + s * 32 + fq * 8);
    }
    bf16_t* qkm = (bf16_t*)(R2 + R_QKM) + (size_t)item * 4096;
#pragma unroll
    for (int jt = 0; jt < 4; ++jt) {
      f32x4 akk = {0.f, 0.f, 0.f, 0.f}, aqk = {0.f, 0.f, 0.f, 0.f};
#pragma unroll
      for (int s = 0; s < 4; ++s) {
        bf16x8 a = *(const bf16x8*)(ks + (jt * 16 + fr) * 136 + s * 32 + fq * 8);
        akk = mfma16(a, bk[s], akk);
        aqk = mfma16(a, bq[s], aqk);
      }
      f32x4 qo;
#pragma unroll
      for (int jj = 0; jj < 4; ++jj) {
        int j = jt * 16 + fq * 4 + jj;
        float gj = gcs[j];
        bool before = dir ? (j > i) : (j < i);
        bool incl = before || (j == i);
        float e = incl ? __expf(gi - gj) : 0.f;
        qo[jj] = aqk[jj] * e;
        float lv = before ? bi * akk[jj] * e : 0.f;
        int ti = dir ? 63 - i : i, tj = dir ? 63 - j : j;
        Ls[tj * 64 + ti] = lv;
      }
      *(u32x2*)(qkm + i * 64 + jt * 16 + fq * 4) = pack4(qo);
    }
  }
  vbar(smraw);
  if (wid == 0) {
    const int j = lane;
    const int sj = dir ? 63 - j : j;
    float x[64];
#pragma unroll
    for (int t2 = 0; t2 < 64; ++t2) x[t2] = (t2 == sj) ? 1.f : 0.f;
    typedef __attribute__((address_space(3))) const f32x4 lds_f32x4;
    unsigned lofs = (unsigned)(size_t)(__attribute__((address_space(3))) const float*)Ls;
    asm volatile("" : "+v"(lofs));
    lds_f32x4* L4 = (lds_f32x4*)(size_t)lofs;
    f32x4 rowv[16];
#pragma unroll
    for (int g = 0; g < 16; ++g) rowv[g] = L4[g];
#pragma unroll
    for (int t2 = 0; t2 < 63; ++t2) {
      f32x4 nxt[16];
#pragma unroll
      for (int g = 0; g < 16; ++g) nxt[g] = (t2 + 1 < 63 && g >= (t2 + 2) / 4) ? L4[(t2 + 1) * 16 + g] : (f32x4){0.f, 0.f, 0.f, 0.f};
      const float xt = x[t2];
#pragma unroll
      for (int i = t2 + 1; i < 64; ++i) x[i] -= rowv[i >> 2][i & 3] * xt;
#pragma unroll
      for (int g = 0; g < 16; ++g) rowv[g] = nxt[g];
    }
    bf16_t* tm = (bf16_t*)(R2 + R_TM) + (size_t)item * 4096;
#pragma unroll
    for (int t2 = 0; t2 < 64; ++t2) {
      int i = dir ? 63 - t2 : t2;
      tm[i * 64 + j] = f2bf(x[t2]);
    }
  }
}

template <bool GDN>
DEVI void scan_chain(int sw, const P& p, int item, char* smraw) {
  const int tid = VT, lane = tid & 63, wid = tid >> 6, fr = lane & 15, fq = lane >> 4;
  int slice, dir, h, b, NH, DV;
  if (GDN) { slice = item & 1; dir = (item >> 1) & 1; h = (item >> 2) & 7; b = item >> 5; NH = 8; DV = 128; }
  else { slice = item & 3; dir = (item >> 2) & 1; h = (item >> 3) & 3; b = item >> 5; NH = 4; DV = 256; }
  const int bh = b * NH + h, bhd = bh * 2 + dir;
  char* R2 = p.ws + OFF_R2;
  bf16_t* kbg = (bf16_t*)smraw;
  bf16_t* qd = kbg + 64 * 136;
  bf16_t* kend = qd + 64 * 136;
  bf16_t* Tm = kend + 128 * 72;
  bf16_t* QK = Tm + 64 * 72;
  float* f_e = (float*)(QK + 64 * 72);
  float* f_b = f_e + 64;
  float* f_k = f_b + 64;
  float* el = f_k + 64;
  float* f_last = el + 128;
  const int e0 = slice * 64 + wid * 16;
  f32x4 S[8];
#pragma unroll
  for (int i = 0; i < 8; ++i) S[i] = (f32x4){0.f, 0.f, 0.f, 0.f};
  bf16_t* rec = (bf16_t*)(GDN ? (p.ws + OFF_H) : (R2 + R1_REC)) + (size_t)dir * NT * 1024;
  for (int n = 0; n < NCH; ++n) {
    const int mc = dir == 0 ? n : (n < 4 ? 3 - n : 71 - n);
    const int p0 = mc * 64;
    const int itc = bhd * NCH + mc;
    __syncthreads();
    if (GDN) {
      if (tid < 64) {
        const float* gc = (const float*)(R2 + R_GC) + (size_t)bhd * TPB + p0;
        float gcv = gc[tid], gl = gc[dir ? 0 : 63];
        f_e[tid] = __expf(gcv);
        f_b[tid] = ((const float*)(R2 + R_BETA))[(size_t)bhd * TPB + p0 + tid];
        f_k[tid] = __expf(gl - gcv);
        if (tid == 0) f_last[0] = __expf(gl);
      }
    } else {
      if (tid < 128) el[tid] = ((const float*)(R2 + R1_EL))[(size_t)itc * 128 + tid];
    }
    __syncthreads();
    if (GDN) {
      const bf16_t* gq = (const bf16_t*)(R2 + R_GQ) + ((size_t)bh * TPB + p0) * 128;
      const bf16_t* gk = (const bf16_t*)(R2 + R_GK) + ((size_t)bh * TPB + p0) * 128;
      const bf16_t* gkt = (const bf16_t*)(R2 + R_GKT) + ((size_t)bh * 128) * TPS + p0;
      const bf16_t* tm = (const bf16_t*)(R2 + R_TM) + (size_t)itc * 4096;
      const bf16_t* qkm = (const bf16_t*)(R2 + R_QKM) + (size_t)itc * 4096;
#pragma unroll
      for (int i = 0; i < 4; ++i) {
        int c = tid + 256 * i, row = c >> 4, kc = c & 15;
        u32x4 uq = *(const u32x4*)(gq + row * 128 + kc * 8), uk = *(const u32x4*)(gk + row * 128 + kc * 8);
        float fe = f_e[row], fk = f_b[row] * fe;
        u32x4 oq, ok;
#pragma unroll
        for (int j = 0; j < 4; ++j) { oq[j] = pk2(bflo(uq[j]) * fe, bfhi(uq[j]) * fe); ok[j] = pk2(bflo(uk[j]) * fk, bfhi(uk[j]) * fk); }
        *(u32x4*)(qd + row * 136 + kc * 8) = oq;
        *(u32x4*)(kbg + row * 136 + kc * 8) = ok;
      }
#pragma unroll
      for (int i = 0; i < 4; ++i) {
        int c = tid + 256 * i, row = c >> 3, cc = c & 7;
        u32x4 u = *(const u32x4*)(gkt + (size_t)row * TPS + cc * 8), o;
#pragma unroll
        for (int j = 0; j < 4; ++j) o[j] = pk2(bflo(u[j]) * f_k[cc * 8 + 2 * j], bfhi(u[j]) * f_k[cc * 8 + 2 * j + 1]);
        *(u32x4*)(kend + row * 72 + cc * 8) = o;
      }
#pragma unroll
      for (int i = 0; i < 2; ++i) {
        int c = tid + 256 * i, row = c >> 3, cc = c & 7;
        *(u32x4*)(Tm + row * 72 + cc * 8) = *(const u32x4*)(tm + row * 64 + cc * 8);
        *(u32x4*)(QK + row * 72 + cc * 8) = *(const u32x4*)(qkm + row * 64 + cc * 8);
      }
    } else {
      const bf16_t* gq = (const bf16_t*)(R2 + R1_QG) + ((size_t)bhd * TPB + p0) * 128;
      const bf16_t* gkt = (const bf16_t*)(R2 + R1_KGT) + ((size_t)bhd * 128) * TPS + p0;
      const bf16_t* am = (const bf16_t*)(R2 + R1_AM) + (size_t)itc * 4096;
#pragma unroll
      for (int i = 0; i < 4; ++i) {
        int c = tid + 256 * i, row = c >> 4, kc = c & 15;
        *(u32x4*)(qd + row * 136 + kc * 8) = *(const u32x4*)(gq + row * 128 + kc * 8);
      }
#pragma unroll
      for (int i = 0; i < 4; ++i) {
        int c = tid + 256 * i, row = c >> 3, cc = c & 7;
        *(u32x4*)(kend + row * 72 + cc * 8) = *(const u32x4*)(gkt + (size_t)row * TPS + cc * 8);
      }
#pragma unroll
      for (int i = 0; i < 2; ++i) {
        int c = tid + 256 * i, row = c >> 3, cc = c & 7;
        *(u32x4*)(QK + row * 72 + cc * 8) = *(const u32x4*)(am + row * 64 + cc * 8);
      }
    }
    __syncthreads();
    bf16x8 Sop[4];
#pragma unroll
    for (int ks = 0; ks < 4; ++ks) Sop[ks] = pack8(S[2 * ks], S[2 * ks + 1]);
    bf16x8 vop[2];
    if (GDN) {
      const bf16_t* gvt = (const bf16_t*)(R2 + R_GVT) + ((size_t)bh * 128 + e0 + fr) * TPS + p0;
      f32x4 X[4];
#pragma unroll
      for (int ct = 0; ct < 4; ++ct) {
        u32x2 u = *(const u32x2*)(gvt + ct * 16 + fq * 4);
        const float* fb = f_b + ct * 16 + fq * 4;
        f32x4 vb = {bflo(u[0]) * fb[0], bfhi(u[0]) * fb[1], bflo(u[1]) * fb[2], bfhi(u[1]) * fb[3]};
        f32x4 acc = {0.f, 0.f, 0.f, 0.f};
#pragma unroll
        for (int ks = 0; ks < 4; ++ks) acc = mfma16(ldsperm(kbg, ct * 16 + fr, 136, ks, fq), Sop[ks], acc);
        X[ct] = vb - acc;
      }
      bf16x8 Xop[2] = {pack8(X[0], X[1]), pack8(X[2], X[3])};
      f32x4 vn[4];
#pragma unroll
      for (int ct = 0; ct < 4; ++ct) {
        f32x4 acc = {0.f, 0.f, 0.f, 0.f};
#pragma unroll
        for (int kk = 0; kk < 2; ++kk) acc = mfma16(ldsperm(Tm, ct * 16 + fr, 72, kk, fq), Xop[kk], acc);
        vn[ct] = acc;
      }
      vop[0] = pack8(vn[0], vn[1]); vop[1] = pack8(vn[2], vn[3]);
    } else {
      const bf16_t* gvt = (const bf16_t*)(R2 + R1_VTG) + ((size_t)bh * 256 + e0 + fr) * TPS + p0;
#pragma unroll
      for (int kk = 0; kk < 2; ++kk) {
        u32x2 lo = *(const u32x2*)(gvt + kk * 32 + fq * 4), hi = *(const u32x2*)(gvt + kk * 32 + 16 + fq * 4);
        vop[kk] = cat8(lo, hi);
      }
    }
#pragma unroll
    for (int ct = 0; ct < 4; ++ct) {
      f32x4 acc = {0.f, 0.f, 0.f, 0.f};
#pragma unroll
      for (int ks = 0; ks < 4; ++ks) acc = mfma16(Sop[ks], ldsperm(qd, ct * 16 + fr, 136, ks, fq), acc);
#pragma unroll
      for (int kk = 0; kk < 2; ++kk) acc = mfma16(vop[kk], ldsperm(QK, ct * 16 + fr, 72, kk, fq), acc);
      *(u32x2*)(rec + (size_t)(b * TPB + p0 + ct * 16 + fr) * 1024 + h * DV + e0 + fq * 4) = pack4(acc);
    }
#pragma unroll
    for (int dt = 0; dt < 8; ++dt) {
      if (GDN) S[dt] *= f_last[0];
      else S[dt] *= *(const f32x4*)(el + dt * 16 + fq * 4);
#pragma unroll
      for (int kk = 0; kk < 2; ++kk) S[dt] = mfma16(ldsperm(kend, dt * 16 + fr, 72, kk, fq), vop[kk], S[dt]);
    }
  }
}

DEVI void fin0_rec(int sw, const P& p, int item) {
  const int lane = lane_id();
  const int w0 = (item * 4 + (sw & 3)) * 8;
  const int r = w0 >> 3;
  const bf16_t* r0 = (const bf16_t*)(p.ws + OFF_H) + (size_t)r * 1024 + lane * 2;
  const bf16_t* zz = (const bf16_t*)(p.ws + OFF_Z) + (size_t)r * LDZ0 + 4160 + lane * 2;
  unsigned u0[8], u1[8], uz[8];
#pragma unroll
  for (int h = 0; h < 8; ++h) { u0[h] = *(const unsigned*)(r0 + h * 128); u1[h] = *(const unsigned*)(r0 + (size_t)NT * 1024 + h * 128); uz[h] = *(const unsigned*)(zz + h * 128); }
  const float n0 = p.gdn_out_norm[lane * 2], n1 = p.gdn_out_norm[lane * 2 + 1];
#pragma unroll
  for (int h = 0; h < 8; ++h) {
    float a = bflo(u0[h]) + bflo(u1[h]), b = bfhi(u0[h]) + bfhi(u1[h]);
    float ss = wave_sum(a * a + b * b);
    float rs = rsqrtf(ss * (1.f / 128.f) + EPS);
    float oa = a * rs * n0 * silu_f(bflo(uz[h])), ob = b * rs * n1 * silu_f(bfhi(uz[h]));
    *(unsigned*)((bf16_t*)(p.ws + OFF_MIX) + (size_t)r * LDH + 1024 + h * 128 + lane * 2) = pk2(oa, ob);
  }
}

DEVI void prep1_qk(int sw, const P& p, int item) {
  const int lane = lane_id();
  const int w = item * 4 + (sw & 3);
  const int which = w & 1, r = w >> 1;
  bf16_t* q = (bf16_t*)(p.ws + OFF_Z) + (size_t)r * LDZ1 + which * 1024;
  float a[16];
#pragma unroll
  for (int hm = 0; hm < 16; ++hm) a[hm] = bf2f(q[hm * 64 + lane]);
  const float* gn = which ? p.diff_k_norm : p.diff_q_norm;
  const float g0 = gn[lane], g1 = gn[64 + lane];
  const int pp = r % TPB;
#pragma unroll
  for (int hm = 0; hm < 16; ++hm) {
    float ss = wave_sum(a[hm] * a[hm]);
    float rs = rsqrtf(ss * (1.f / 64.f) + EPS);
    float x = a[hm] * rs * ((hm & 1) ? g1 : g0);
    if (pp >= CTX) x = rope64(x, lane, pp - CTX);
    if (which == 0) x *= 0.125f * LOG2E;
    q[hm * 64 + lane] = f2bf(x);
  }
}
DEVI void gla_pre(int sw, const P& p, int item, char* smraw) {
  const int tid = VT, lane = tid & 63, wid = tid >> 6, fr = lane & 15, fq = lane >> 4;
  const int mc = item % NCH; int t = item / NCH;
  const int dir = t & 1, bh = t >> 1, h = bh & 3, b = bh >> 2;
  const int p0 = mc * 64;
  char* R2 = p.ws + OFF_R2;
  float* cum = (float*)smraw;
  float* lr = cum + 64 * 129;
  float* last = lr + 64 * 16;
  bf16_t* QS = (bf16_t*)(last + 128);
  bf16_t* KS = QS + 64 * 136;
  const bf16_t* z = (const bf16_t*)(p.ws + OFF_Z) + (size_t)(b * TPB + p0) * LDZ1;
  vbar(smraw);
#pragma unroll
  for (int i = tid; i < 64 * 16; i += 256) lr[i] = ((const float*)(R2 + R1_GATES))[(size_t)(b * TPB + p0 + (i >> 4)) * 32 + dir * 16 + (i & 15)];
  vbar(smraw);
  {
    const int d = tid & 127, half = tid >> 7;
    float w2[16];
#pragma unroll
    for (int rr = 0; rr < 16; ++rr) w2[rr] = p.gla_gate_w2[((size_t)dir * 16 + rr) * 512 + h * 128 + d];
    const float b2 = p.gla_gate_b2[dir * 512 + h * 128 + d];
#pragma unroll 4
    for (int i = 0; i < 32; ++i) {
      int c = half * 32 + i;
      float lg = b2;
#pragma unroll
      for (int rr = 0; rr < 16; ++rr) lg += lr[c * 16 + rr] * w2[rr];
      float ls = fminf(lg, 0.f) - __logf(1.f + __expf(-fabsf(lg)));
      cum[c * 129 + d] = ls * (1.f / 16.f);
    }
  }
  vbar(smraw);
  if (tid < 128) {
    float cv[64];
#pragma unroll
    for (int i = 0; i < 64; ++i) cv[i] = cum[(dir ? 63 - i : i) * 129 + tid];
    float run = 0.f;
#pragma unroll
    for (int i = 0; i < 64; ++i) { run += cv[i]; cum[(dir ? 63 - i : i) * 129 + tid] = run; }
    last[tid] = run;
    ((float*)(R2 + R1_EL))[(size_t)item * 128 + tid] = __expf(run);
  }
  vbar(smraw);
  {
    bf16_t* qg = (bf16_t*)(R2 + R1_QG) + ((size_t)(bh * 2 + dir) * TPB + p0) * 128;
#pragma unroll
    for (int i = tid; i < 64 * 64; i += 256) {
      int c = i >> 6, d = (i & 63) * 2;
      unsigned uq = *(const unsigned*)(z + (size_t)c * LDZ1 + 3072 + h * 128 + d);
      unsigned uk = *(const unsigned*)(z + (size_t)c * LDZ1 + 3584 + h * 128 + d);
      float c0 = cum[c * 129 + d], c1 = cum[c * 129 + d + 1];
      unsigned oq = pk2(bflo(uq) * 0.08838834764831845f * __expf(c0), bfhi(uq) * 0.08838834764831845f * __expf(c1));
      unsigned ok = pk2(bflo(uk) * __expf(-c0), bfhi(uk) * __expf(-c1));
      *(unsigned*)(QS + c * 136 + d) = oq;
      *(unsigned*)(KS + c * 136 + d) = ok;
      *(unsigned*)(qg + (size_t)c * 128 + d) = oq;
    }
    {
      const int d = tid >> 1, half = tid & 1;
      const float ld = last[d];
      float y[32];
#pragma unroll
      for (int i = 0; i < 32; ++i) {
        int c = half * 32 + i;
        y[i] = bf2f(z[(size_t)c * LDZ1 + 3584 + h * 128 + d]) * __expf(ld - cum[c * 129 + d]);
      }
      vbar(smraw);
      put_T((bf16_t*)smraw, d, half, y);
      vbar(smraw);
      store_T(sw, (const bf16_t*)smraw, (bf16_t*)(R2 + R1_KGT) + ((size_t)(bh * 2 + dir) * 128) * TPS + p0);
    }
  }
  {
    const int it = wid, i = it * 16 + fr;
    bf16x8 bq[4];
#pragma unroll
    for (int s = 0; s < 4; ++s) bq[s] = *(const bf16x8*)(QS + i * 136 + s * 32 + fq * 8);
    bf16_t* am = (bf16_t*)(R2 + R1_AM) + (size_t)item * 4096;
#pragma unroll
    for (int jt = 0; jt < 4; ++jt) {
      f32x4 a = {0.f, 0.f, 0.f, 0.f};
#pragma unroll
      for (int s = 0; s < 4; ++s) a = mfma16(*(const bf16x8*)(KS + (jt * 16 + fr) * 136 + s * 32 + fq * 8), bq[s], a);
#pragma unroll
      for (int jj = 0; jj < 4; ++jj) {
        int j = jt * 16 + fq * 4 + jj;
        bool incl = dir ? (j >= i) : (j <= i);
        a[jj] = incl ? a[jj] : 0.f;
      }
      *(u32x2*)(am + i * 64 + jt * 16 + fq * 4) = pack4(a);
    }
  }
  if (dir == 0) {
    const bf16_t* src = z + 4096 + h * 256;
    bf16_t* dst = (bf16_t*)(R2 + R1_VTG) + ((size_t)bh * 256) * TPS + p0;
    transpose64x128(sw, src, LDZ1, dst, smraw);
    transpose64x128(sw, src + 128, LDZ1, dst + (size_t)128 * TPS, smraw);
  }
}
constexpr float LAM_INIT = 0.35550906759096927f;
DEVI void fin1(int sw, const P& p, int item) {
  const int lane = lane_id();
  const int r = item * 4 + (sw & 3);
  if ((r % TPB) < CTX) return;
  bf16_t* mix = (bf16_t*)(p.ws + OFF_MIX) + (size_t)r * LDH;
  const bf16_t* o = (const bf16_t*)(p.ws + OFF_H) + (size_t)r * LDH + lane * 2;
  const bf16_t* r0 = (const bf16_t*)(p.ws + OFF_R2 + R1_REC) + (size_t)r * 1024 + lane * 4;
  const bf16_t* zg = (const bf16_t*)(p.ws + OFF_Z) + (size_t)r * LDZ1 + 5120 + lane * 4;
  unsigned u1[8], u2[8];
  u32x2 a0[4], a1[4], ag[4];
#pragma unroll
  for (int h = 0; h < 8; ++h) { u1[h] = *(const unsigned*)(o + h * 256); u2[h] = *(const unsigned*)(o + h * 256 + 128); }
#pragma unroll
  for (int h = 0; h < 4; ++h) { a0[h] = *(const u32x2*)(r0 + h * 256); a1[h] = *(const u32x2*)(r0 + (size_t)NT * 1024 + h * 256); ag[h] = *(const u32x2*)(zg + h * 256); }
  float l01 = wave_sum(p.diff_lambda[lane] * p.diff_lambda[64 + lane]);
  float l23 = wave_sum(p.diff_lambda[128 + lane] * p.diff_lambda[192 + lane]);
  const float lam = __expf(l01) - __expf(l23) + LAM_INIT;
  const float s0 = p.diff_sub_norm[lane * 2], s1 = p.diff_sub_norm[lane * 2 + 1];
#pragma unroll
  for (int h = 0; h < 8; ++h) {
    float a = bflo(u1[h]) - lam * bflo(u2[h]), b = bfhi(u1[h]) - lam * bfhi(u2[h]);
    float ss = wave_sum(a * a + b * b);
    float rs = rsqrtf(ss * (1.f / 128.f) + EPS) * (1.f - LAM_INIT);
    *(unsigned*)(mix + h * 128 + lane * 2) = pk2(a * rs * s0, b * rs * s1);
  }
  const f32x4 gn = *(const f32x4*)(p.gla_out_norm + lane * 4);
#pragma unroll
  for (int h = 0; h < 4; ++h) {
    float v[4] = {bflo(a0[h][0]) + bflo(a1[h][0]), bfhi(a0[h][0]) + bfhi(a1[h][0]), bflo(a0[h][1]) + bflo(a1[h][1]), bfhi(a0[h][1]) + bfhi(a1[h][1])};
    float ss = wave_sum(v[0] * v[0] + v[1] * v[1] + v[2] * v[2] + v[3] * v[3]);
    float rs = rsqrtf(ss * (1.f / 256.f) + EPS);
    float g[4] = {bflo(ag[h][0]), bfhi(ag[h][0]), bflo(ag[h][1]), bfhi(ag[h][1])};
    f32x4 ov;
#pragma unroll
    for (int q = 0; q < 4; ++q) ov[q] = v[q] * rs * gn[q] * silu_f(g[q]);
    *(u32x2*)(mix + 1024 + h * 256 + lane * 4) = pack4(ov);
  }
}

DEVI int fetch_item(int sw, int* ctr, char* slot) {
  __syncthreads();
  if (sw == 0 && lane_id() == 0) *(volatile int*)slot = atomicAdd(ctr, 1);
  __syncthreads();
  return __builtin_amdgcn_readfirstlane(*(volatile int*)slot);
}
constexpr int SMEM_HALF = 75776;
constexpr int SMEM_BYTES = 2 * SMEM_HALF;
constexpr int NPHASE = 21;

__global__ void __launch_bounds__(512, 2) mega(P p, int ph0, int ph1) {
  __shared__ __attribute__((aligned(1024))) char smem_all[SMEM_BYTES];
  cg::grid_group grid = cg::this_grid();
#ifdef PH_LO
  ph0 = PH_LO; ph1 = PH_HI;
#endif
  const int sw = __builtin_amdgcn_readfirstlane(threadIdx.x >> 6);
  const int vb = sw >> 2;
  const int G = gridDim.x * 2, bid = blockIdx.x * 2 + vb;
  char* smem = smem_all + vb * SMEM_HALF;
  char* ws = p.ws;
  char* R2 = ws + OFF_R2;
  bf16_t* wmix = (bf16_t*)(ws + OFF_WMIX);
  bf16_t* Hb = (bf16_t*)(ws + OFF_H);
  bf16_t* MIXb = (bf16_t*)(ws + OFF_MIX);
  bf16_t* Zb = (bf16_t*)(ws + OFF_Z);
  const float* mod0 = (const float*)(ws + OFF_MOD);
  const float* mod1 = mod0 + 5 * MODN;

  if (ph0 <= 0 && 0 < ph1) {
    if (lane_id() == 0 && (sw & 3) == 0) *(volatile unsigned*)(smem + VB_CTR_OFF) = 0u;
    __syncthreads();
    {
        for (int it = bid; it < 96 + CVT_MIX0_ITEMS; it += G) {
          if (it < 96) ada_item(sw, p, it, (float*)smem);
          else cvt_mix0(sw, p, it - 96, (float*)smem);
        }
        if (blockIdx.x == 0 && sw == 0 && lane_id() < 16) ((int*)(ws + OFF_CTR))[lane_id()] = 0;
      }
    if (0 + 1 < ph1) grid.sync();
  }
  if (ph0 <= 1 && 1 < ph1) {
    modulate_phase(sw, p, p.norm_mix_g, mod0, 0, 1, Hb, nullptr, nullptr, true);
    if (1 + 1 < ph1) grid.sync();
  }
  if (ph0 <= 2 && 2 < ph1) {
    {
        EpiStore e{Zb, LDZ0, (float*)(R2 + R_GATES), 5184};
        gemm256_phase<0>(sw, wmix + WM_IN, LDW, Hb, LDH, D, AB_INP / 256, smem_all, e);
      }
    if (2 + 1 < ph1) grid.sync();
  }
  if (ph0 <= 3 && 3 < ph1) {
    if (lane_id() == 0 && (sw & 3) == 0) *(volatile unsigned*)(smem + VB_CTR_OFF) = 0u;
    __syncthreads();
    {
        for (int it = bid; it < 8704 + 1088; it += G) {
          if (it < 8704) prep0_gdn(sw, p, (it & ~3) | ((it + (it >> 9)) & 3), (float*)smem);
          else prep0_norm512(sw, p, it - 8704);
        }
      }
    if (3 + 1 < ph1) grid.sync();
  }
  if (ph0 <= 4 && 4 < ph1) {
    {
        EpiStore eq{(bf16_t*)(R2 + R_QUP), 1536, nullptr, 0};
        gemm256_phase<0>(sw, wmix + WM_UQ, LDW5, Hb, LDQA, 512, 6, smem_all, eq);
        EpiStore ek{MIXb, LDH, nullptr, 0};
        gemm256_phase<0>(sw, wmix + WM_UKV, LDW5, Hb + (size_t)NT * LDQA, LDQA, 512, 8, smem_all, ek);
      }
    if (4 + 1 < ph1) grid.sync();
  }
  if (ph0 <= 5 && 5 < ph1) {
    if (lane_id() == 0 && (sw & 3) == 0) *(volatile unsigned*)(smem + VB_CTR_OFF) = 0u;
    __syncthreads();
    {
        const int nq = NT * 8 / 4 / 8;
        for (int it = bid; it < 4352 + 2176 + 2 * nq; it += G) {
          if (it < 4352) gdn_pre(sw, p, it, smem);
          else if (it < 4352 + 2176) {
            int t = it - 4352; int mc = t % NCH; int bh = t / NCH; int b = bh >> 3, h = bh & 7;
            transpose64x128(sw, MIXb + (size_t)(b * TPB + mc * 64) * LDH + h * 256 + 128, LDH,
                            (bf16_t*)(R2 + R_VT) + ((size_t)bh * 128) * TPS + mc * 64, smem);
          } else if (it < 4352 + 2176 + nq) prep0_q(sw, p, it - 4352 - 2176);
          else prep0_k(sw, p, it - 4352 - 2176 - nq);
        }
      }
    if (5 + 1 < ph1) grid.sync();
  }
  if (ph0 <= 6 && 6 < ph1) {
    {
        int* ctr = (int*)(ws + OFF_CTR) + (ph0 == 6 ? 2 : 0);
        char* slot = smem_all + SMEM_BYTES - 16;
        while (true) {
          const int it = fetch_item(sw, ctr, slot);
          if (it >= 608 + 48) break;
          if (it >= 608) {
            if (lane_id() == 0 && (sw & 3) == 0) *(volatile unsigned*)(smem + VB_CTR_OFF) = 0u;
            __syncthreads();
            ada_item(sw, p, 96 + 2 * (it - 608) + vb, (float*)smem);
            continue;
          }
          if (it < 64) scan_chain<true>(sw, p, 2 * it + vb, smem);
          else {
            int bh, prow, nkeys;
            if (it < 576) { const int t = it - 64; bh = t >> 4; prow = CTX + (t & 15) * 256; nkeys = TPB; }
            else { bh = it - 576; prow = 0; nkeys = CTX; }
            const int b = bh >> 3, h = bh & 7;
            const size_t r0 = (size_t)b * TPB + prow;
            float gq = 0.f, gk = 0.f;
            for (int i = lane_id(); i < 192; i += 64) { gq = fmaxf(gq, fabsf(p.mla_q_norm[i])); gk = fmaxf(gk, fabsf(p.mla_k_norm[i])); }
#pragma unroll
            for (int o2 = 32; o2 > 0; o2 >>= 1) { gq = fmaxf(gq, __shfl_xor(gq, o2)); gk = fmaxf(gk, __shfl_xor(gk, o2)); }
            const float negB = -(0.07216878364870322f * LOG2E * 192.f) * gq * gk;
            attn256_item<192>(sw, (const bf16_t*)(R2 + R_QUP) + r0 * 1536 + h * 192, 1536,
                              (const bf16_t*)(R2 + R_K) + (size_t)b * TPB * LDK + h * 192, LDK,
                              (const bf16_t*)(R2 + R_VT) + ((size_t)bh * 128) * TPS,
                              MIXb + r0 * LDH + h * 128, LDH, nkeys, negB, smem_all);
          }
        }
      }
    if (6 + 1 < ph1) grid.sync();
  }
  if (ph0 <= 7 && 7 < ph1) {
    if (lane_id() == 0 && (sw & 3) == 0) *(volatile unsigned*)(smem + VB_CTR_OFF) = 0u;
    __syncthreads();
    {
        const int nf = NT * 8 / 4 / 8;
        for (int it = bid; it < CVT_FFN_ITEMS + nf; it += G) {
          if (it < CVT_FFN_ITEMS) cvt_ffn(sw, p, 0, it, (float*)smem);
          else fin0_rec(sw, p, it - CVT_FFN_ITEMS);
        }
      }
    if (7 + 1 < ph1) grid.sync();
  }
  if (ph0 <= 8 && 8 < ph1) {
    {
        EpiResid e{p.out, (float*)(ws + OFF_CTXRES), mod0 + 2 * D, (float*)(R2 + R_PART)};
        gemm256_phase<2>(sw, wmix + WM_OUT, LDW, MIXb, LDH, D, 8, smem_all, e);
      }
    if (8 + 1 < ph1) grid.sync();
  }
  if (ph0 <= 9 && 9 < ph1) {
    if (lane_id() == 0 && (sw & 3) == 0) *(volatile unsigned*)(smem + VB_CTR_OFF) = 0u;
    __syncthreads();
    {
        modulate_phase(sw, p, p.norm_ffn_g, mod0, 3, 4, Hb, (const float*)(R2 + R_PART), mod0 + 4 * MODN + 2 * D);
        for (int it = bid; it < CVT_MIX1_ITEMS; it += G) cvt_mix1(sw, p, it, (float*)smem);
      }
    if (9 + 1 < ph1) grid.sync();
  }
  if (ph0 <= 10 && 10 < ph1) {
    {
        EpiSwiglu e{Zb};
        gemm256_phase<0>(sw, (const bf16_t*)(R2 + RF_GU), LDW, Hb, LDH, D, 44, smem_all, e);
      }
    if (10 + 1 < ph1) grid.sync();
  }
  if (ph0 <= 11 && 11 < ph1) {
    {
        EpiResid e{p.out, (float*)(ws + OFF_CTXRES), mod0 + 5 * D, (float*)(R2 + R_PART)};
        gemm256_phase<2>(sw, (const bf16_t*)(R2 + RF_D), LDWF, Zb, LDG, FFN, 8, smem_all, e);
      }
    if (11 + 1 < ph1) grid.sync();
  }
  if (ph0 <= 12 && 12 < ph1) {
    modulate_phase(sw, p, p.norm_mix_g + D, mod1, 0, 1, Hb, (const float*)(R2 + R_PART), mod0 + 4 * MODN + 5 * D);
    if (12 + 1 < ph1) grid.sync();
  }
  if (ph0 <= 13 && 13 < ph1) {
    {
        EpiStore e{Zb, LDZ1, (float*)(R2 + R1_GATES), 6144};
        gemm256_phase<0>(sw, wmix + WM_IN, LDW, Hb, LDH, D, CD_INP / 256, smem_all, e);
      }
    if (13 + 1 < ph1) grid.sync();
  }
  if (ph0 <= 14 && 14 < ph1) {
    if (lane_id() == 0 && (sw & 3) == 0) *(volatile unsigned*)(smem + VB_CTR_OFF) = 0u;
    __syncthreads();
    {
        const int nqk = NT * 2 / 4;
        for (int it = bid; it < 2176 + 2176 + nqk; it += G) {
          if (it < 2176) gla_pre(sw, p, it, smem);
          else if (it < 4352) {
            int t = it - 2176; int mc = t % NCH; int bh = t / NCH; int b = bh >> 3, h = bh & 7;
            transpose64x128(sw, Zb + (size_t)(b * TPB + mc * 64) * LDZ1 + 2048 + h * 128, LDZ1,
                            (bf16_t*)(R2 + R1_VT) + ((size_t)bh * 128) * TPS + mc * 64, smem);
          } else prep1_qk(sw, p, it - 4352);
        }
      }
    if (14 + 1 < ph1) grid.sync();
  }
  if (ph0 <= 15 && 15 < ph1) {
    {
        int* ctr = (int*)(ws + OFF_CTR) + (ph0 == 15 ? 3 : 1);
        char* slot = smem_all + SMEM_BYTES - 16;
        while (true) {
          const int it = fetch_item(sw, ctr, slot);
          if (it >= 64 + 1024) break;
          if (it < 64) scan_chain<false>(sw, p, 2 * it + vb, smem);
          else {
            const int t = it - 64, qb = t & 15, bhm = t >> 4, b = bhm >> 4, hm = bhm & 15;
            const size_t r0 = (size_t)b * TPB + CTX + qb * 256;
            float gq = 0.f, gk = 0.f;
            for (int i = lane_id(); i < 128; i += 64) { gq = fmaxf(gq, fabsf(p.diff_q_norm[i])); gk = fmaxf(gk, fabsf(p.diff_k_norm[i])); }
#pragma unroll
            for (int o2 = 32; o2 > 0; o2 >>= 1) { gq = fmaxf(gq, __shfl_xor(gq, o2)); gk = fmaxf(gk, __shfl_xor(gk, o2)); }
            const float negB = -(0.125f * LOG2E * 64.f) * gq * gk;
            attn256_item<64>(sw, Zb + r0 * LDZ1 + hm * 64, LDZ1,
                             Zb + (size_t)b * TPB * LDZ1 + 1024 + hm * 64, LDZ1,
                             (const bf16_t*)(R2 + R1_VT) + ((size_t)(b * 8 + (hm >> 1)) * 128) * TPS,
                             Hb + r0 * LDH + hm * 128, LDH, TPB, negB, smem_all);
          }
        }
      }
    if (15 + 1 < ph1) grid.sync();
  }
  if (ph0 <= 16 && 16 < ph1) {
    if (lane_id() == 0 && (sw & 3) == 0) *(volatile unsigned*)(smem + VB_CTR_OFF) = 0u;
    __syncthreads();
    {
        const int nf = NT / 4;
        for (int it = bid; it < CVT_FFN_ITEMS + nf; it += G) {
          if (it < CVT_FFN_ITEMS) cvt_ffn(sw, p, 1, it, (float*)smem);
          else fin1(sw, p, it - CVT_FFN_ITEMS);
        }
      }
    if (16 + 1 < ph1) grid.sync();
  }
  if (ph0 <= 17 && 17 < ph1) {
    {
        EpiResid e{p.out, (float*)(ws + OFF_CTXRES), mod1 + 2 * D, nullptr};
        gemm256_phase<1>(sw, wmix + WM_OUT, LDW, MIXb, LDH, D, 8, smem_all, e);
      }
    if (17 + 1 < ph1) grid.sync();
  }
  if (ph0 <= 18 && 18 < ph1) {
    modulate_phase(sw, p, p.norm_ffn_g + D, mod1, 3, 4, Hb, nullptr, nullptr, false, true);
    if (18 + 1 < ph1) grid.sync();
  }
  if (ph0 <= 19 && 19 < ph1) {
    {
        EpiSwiglu e{Zb};
        gemm256_phase<1>(sw, (const bf16_t*)(R2 + RF_GU), LDW, Hb, LDH, D, 44, smem_all, e);
      }
    if (19 + 1 < ph1) grid.sync();
  }
  if (ph0 <= 20 && 20 < ph1) {
    {
        EpiResid e{p.out, (float*)(ws + OFF_CTXRES), mod1 + 5 * D, nullptr};
        gemm256_phase<1>(sw, (const bf16_t*)(R2 + RF_D), LDWF, Zb, LDG, FFN, 8, smem_all, e);
      }
  }
  if (ph0 <= 21 && 21 < ph1) { for (int it = bid; it < 128; it += G) scan_chain<true>(sw, p, it, smem); }
  if (ph0 <= 23 && 23 < ph1) { for (int it = bid; it < 128; it += G) scan_chain<false>(sw, p, it, smem); }
}

extern "C" void kernel_launch(void* const* d_in, const int* in_sizes, int n_in, void* d_out, int out_size, void* d_ws, size_t ws_size, hipStream_t stream) {
  static int grid_blocks = 0;
  if (!grid_blocks) {
    int dev = 0, cus = 0, per_cu = 0;
    hipGetDevice(&dev);
    hipDeviceGetAttribute(&cus, hipDeviceAttributeMultiprocessorCount, dev);
    hipOccupancyMaxActiveBlocksPerMultiprocessor(&per_cu, mega, 512, 0);
    if (per_cu > 1) per_cu = 1;
    if (per_cu < 1) per_cu = 1;
    grid_blocks = cus * per_cu;
    grid_blocks -= grid_blocks % 8;
  }
  if (ws_size < WS_NEED) { fprintf(stderr, "workspace too small: %zu < %zu\n", ws_size, (size_t)WS_NEED); return; }
  P p{};
  const float** pp = (const float**)&p;
  for (int i = 0; i < 32; ++i) pp[i] = (const float*)d_in[i];
  p.out = (float*)d_out;
  p.ws = (char*)d_ws;
#ifndef PROBE_PHASE
  int ph0 = 0, ph1 = NPHASE;
  void* args[] = {&p, &ph0, &ph1};
  hipError_t e = hipLaunchCooperativeKernel((void*)mega, dim3(grid_blocks), dim3(512), args, 0, stream);
  if (e != hipSuccess) fprintf(stderr, "cooperative launch failed: %s (grid %d)\n", hipGetErrorString(e), grid_blocks);
#else
  int segs[3][2] = {{0, PROBE_AFTER + 1}, {PROBE_PHASE, PROBE_PHASE + 1}, {PROBE_AFTER + 1, NPHASE}};
  for (int s = 0; s < 3; ++s) {
    void* args[] = {&p, &segs[s][0], &segs[s][1]};
    hipError_t e = hipLaunchCooperativeKernel((void*)mega, dim3(grid_blocks), dim3(512), args, 0, stream);
    if (e != hipSuccess) fprintf(stderr, "cooperative launch failed: %s (grid %d)\n", hipGetErrorString(e), grid_blocks);
  }
#endif
}
```

```cpp
#include <hip/hip_runtime.h>
#include <hip/hip_cooperative_groups.h>
#include <cstdio>
#include <cstdint>
namespace cg = cooperative_groups;

#define DEVI __device__ __forceinline__
typedef unsigned short bf16_t;
typedef short bf16x8 __attribute__((ext_vector_type(8)));
typedef short bf16x4 __attribute__((ext_vector_type(4)));
typedef float f32x4 __attribute__((ext_vector_type(4)));
typedef float f32x2 __attribute__((ext_vector_type(2)));
typedef unsigned u32x4 __attribute__((ext_vector_type(4)));
typedef unsigned u32x2 __attribute__((ext_vector_type(2)));
typedef __bf16 bfv2 __attribute__((ext_vector_type(2)));

constexpr int D = 2048, NB = 4, SEQ = 4096, CTX = 256, TPB = SEQ + CTX  , NT = NB * TPB  ;
constexpr int NCH = TPB / 64;
constexpr int FFN = 5632;
constexpr int AB_IN = 5216, AB_INP = 5376, CD_IN = 6176, CD_INP = 6400;
constexpr int MODN = 6 * D;
constexpr int LDH = 2112, LDZ0 = 5440, LDZ1 = 6464, LDG = 5696, LDW = 2112, LDW5 = 576, LDWF = 5696, LDK = 1600, LDQA = 576, TPS = 4416;
constexpr float EPS = 1e-6f;
constexpr float LOG2E = 1.4426950408889634f;

constexpr size_t OFF_CTR = 0;
constexpr size_t OFF_MOD = 4096;
constexpr size_t OFF_CTXRES = OFF_MOD + (size_t)2 * 5 * MODN * 4;
constexpr size_t OFF_WMIX = OFF_CTXRES + (size_t)NB * CTX * D * 4;
constexpr size_t OFF_H = OFF_WMIX + (size_t)41943040;
constexpr size_t OFF_MIX = OFF_H + (size_t)NT * LDH * 2;
constexpr size_t OFF_Z = OFF_MIX + (size_t)NT * LDH * 2;
constexpr size_t OFF_R2 = OFF_Z + (size_t)NT * LDZ1 * 2;
constexpr size_t SZ_T = (size_t)4096 * TPS * 2;
constexpr size_t SZ_TOK1024 = (size_t)NT * 1024 * 2;
constexpr size_t WM_IN = 0;
constexpr size_t WM_OUT = (size_t)CD_INP * LDW;
constexpr size_t WM_UQ = WM_OUT + (size_t)D * LDW;
constexpr size_t WM_UKV = WM_UQ + (size_t)1536 * LDW5;
static_assert((WM_UKV + (size_t)2048 * LDW5) * 2 <= 41943040, "wmix");
constexpr size_t R_QUP = 0;
constexpr size_t R_K = R_QUP + (size_t)NT * 1536 * 2;
constexpr size_t R_VT = R_K + (size_t)NT * LDK * 2;
constexpr size_t R_GQ = R_VT + SZ_T;
constexpr size_t R_GK = R_GQ + SZ_TOK1024;
constexpr size_t R_GKT = R_GK + SZ_TOK1024;
constexpr size_t R_GVT = R_GKT + SZ_T;
constexpr size_t R_TM = R_GVT + SZ_T;
constexpr size_t R_QKM = R_TM + SZ_TOK1024;
constexpr size_t R_GC = R_QKM + SZ_TOK1024;
constexpr size_t R_BETA = R_GC + (size_t)NT * 16 * 4;
constexpr size_t R_GATES = R_BETA + (size_t)NT * 16 * 4;
constexpr size_t R_END0 = R_GATES + (size_t)NT * 32 * 4;
constexpr size_t R1_VT = 0;
constexpr size_t R1_QG = R1_VT + SZ_T;
constexpr size_t R1_KGT = R1_QG + SZ_TOK1024;
constexpr size_t R1_VTG = R1_KGT + SZ_T;
constexpr size_t R1_AM = R1_VTG + SZ_T;
constexpr size_t R1_EL = R1_AM + (size_t)2176 * 4096 * 2;
constexpr size_t R1_GATES = R1_EL + (size_t)2176 * 128 * 4;
constexpr size_t R1_REC = R1_GATES + (size_t)NT * 32 * 4;
constexpr size_t R1_END = R1_REC + 2 * SZ_TOK1024;
constexpr size_t RF_GU = 0;
constexpr size_t RF_D = RF_GU + (size_t)2 * FFN * LDW * 2;
static_assert(RF_D + (size_t)D * LDWF * 2 <= R1_KGT, "ffn overlay L1");
static_assert(RF_D + (size_t)D * LDWF * 2 <= R_VT, "ffn overlay L0");
static_assert(NT * (size_t)LDG * 2 <= NT * (size_t)LDZ1 * 2, "G fits Z");
constexpr size_t R_PART = (size_t)128 << 20;
constexpr size_t WS_NEED = OFF_R2 + (R_END0 > R1_END ? R_END0 : R1_END);
static_assert(WS_NEED <= (size_t)805306368, "ws");

struct P {
  const float *x, *c, *ctx, *c_ctx, *ada_w, *ada_b, *norm_mix_g, *norm_ffn_g, *ffn_w_gate, *ffn_w_up, *ffn_w_down;
  const float *ab_w_in, *mla_q_a_norm, *mla_w_uq, *mla_kv_a_norm, *mla_w_ukv, *mla_q_norm, *mla_k_norm;
  const float *gdn_conv_w, *gdn_a_log, *gdn_dt_bias, *gdn_out_norm, *ab_w_out;
  const float *cd_w_in, *diff_q_norm, *diff_k_norm, *diff_lambda, *diff_sub_norm, *gla_gate_w2, *gla_gate_b2, *gla_out_norm, *cd_w_out;
  float* out;
  char* ws;
};

DEVI unsigned pk2(float lo, float hi) { f32x2 v = {lo, hi}; bfv2 b = __builtin_convertvector(v, bfv2); return __builtin_bit_cast(unsigned, b); }
DEVI float bflo(unsigned u) { return __uint_as_float(u << 16); }
DEVI float bfhi(unsigned u) { return __uint_as_float(u & 0xffff0000u); }
DEVI float bf2f(bf16_t h) { return __uint_as_float(((unsigned)h) << 16); }
DEVI bf16_t f2bf(float f) { return (bf16_t)(pk2(f, 0.f) & 0xffffu); }
DEVI f32x4 mfma16(bf16x8 a, bf16x8 b, f32x4 c) { return __builtin_amdgcn_mfma_f32_16x16x32_bf16(a, b, c, 0, 0, 0); }
DEVI bf16x8 pack8(f32x4 a, f32x4 b) { u32x4 u = {pk2(a[0], a[1]), pk2(a[2], a[3]), pk2(b[0], b[1]), pk2(b[2], b[3])}; return __builtin_bit_cast(bf16x8, u); }
DEVI u32x2 pack4(f32x4 a) { u32x2 u = {pk2(a[0], a[1]), pk2(a[2], a[3])}; return u; }
DEVI bf16x8 cat8(u32x2 lo, u32x2 hi) { u32x4 u = {lo[0], lo[1], hi[0], hi[1]}; return __builtin_bit_cast(bf16x8, u); }
DEVI float wave_sum(float v) {
#pragma unroll
  for (int o = 32; o > 0; o >>= 1) v += __shfl_xor(v, o);
  return v;
}
DEVI float silu_f(float v) { return v * __builtin_amdgcn_rcpf(1.f + __expf(-v)); }
DEVI float* xrow(const P& p, int r) {
  int b = r / TPB, q = r - b * TPB;
  return q < CTX ? (float*)(p.ws + OFF_CTXRES) + (size_t)(b * CTX + q) * D : p.out + (size_t)(b * SEQ + q - CTX) * D;
}
DEVI int modidx(int r) { int b = r / TPB; return (r - b * TPB) < CTX ? 4 : b; }
DEVI bf16x8 ldsperm(const bf16_t* base, int row, int stride, int ks, int fq) {
  const bf16_t* p = base + row * stride + ks * 32 + fq * 4;
  u32x2 lo = *(const u32x2*)p, hi = *(const u32x2*)(p + 16);
  return cat8(lo, hi);
}

DEVI int lane_id() { int l; asm volatile("v_mbcnt_lo_u32_b32 %0, -1, 0\n\tv_mbcnt_hi_u32_b32 %0, -1, %0" : "=v"(l)); return l; }
#define VT ((((sw) & 3) << 6) | lane_id())
constexpr int VB_CTR_OFF = 75776 - 32;
DEVI void vbar(const void* vbase) {
  typedef __attribute__((address_space(3))) unsigned lds_u32;
  lds_u32* ctr = (lds_u32*)(size_t)(unsigned)(size_t)(__attribute__((address_space(3))) const char*)((const char*)vbase + VB_CTR_OFF);
  __builtin_amdgcn_fence(__ATOMIC_RELEASE, "workgroup");
  asm volatile("s_waitcnt vmcnt(0) lgkmcnt(0)" ::: "memory");
  unsigned old = 0;
  if (lane_id() == 0) old = __hip_atomic_fetch_add(ctr, 1u, __ATOMIC_RELAXED, __HIP_MEMORY_SCOPE_WORKGROUP);
  const unsigned gen = (unsigned)__builtin_amdgcn_readfirstlane((int)old) >> 2;
  while ((__hip_atomic_load(ctr, __ATOMIC_RELAXED, __HIP_MEMORY_SCOPE_WORKGROUP) >> 2) == gen) __builtin_amdgcn_s_sleep(1);
  __builtin_amdgcn_fence(__ATOMIC_ACQUIRE, "workgroup");
  asm volatile("" ::: "memory");
}
struct EpiStore {
  bf16_t* C; int ldc; float* side; int side_c0;
  DEVI void operator()(const f32x4 (&acc)[8][4], int nb, int mb, int fr, int fq, int pk) const {
#pragma unroll
    for (int ni = 0; ni < 4; ++ni) {
      const int m = mb + ni * 16 + fr;
#pragma unroll
      for (int mi = 0; mi < 8; ++mi) {
        const int n = nb + mi * 16 + fq * 4;
        *(u32x2*)(C + (size_t)m * ldc + n) = pack4(acc[mi][ni]);
        if (side && n >= side_c0 && n < side_c0 + 32) *(f32x4*)(side + (size_t)m * 32 + (n - side_c0)) = acc[mi][ni];
      }
      asm volatile("" ::: "memory");
    }
  }
};
struct EpiResid {
  float* out; float* ctxres; const float* gate; float* part;
  DEVI void operator()(const f32x4 (&acc)[8][4], int nb, int mb, int fr, int fq, int pk) const {
#pragma unroll
    for (int ni = 0; ni < 4; ++ni) {
      const int m = mb + ni * 16 + fr;
      int bb = m / TPB, qq = m - bb * TPB;
      float* xr = qq < CTX ? ctxres + (size_t)(bb * CTX + qq) * D : out + (size_t)(bb * SEQ + qq - CTX) * D;
      const float* g = gate + (size_t)(qq < CTX ? 4 : bb) * MODN;
#pragma unroll
      for (int mi = 0; mi < 8; ++mi) {
        const int n = nb + mi * 16 + fq * 4;
        const f32x4 gv = *(const f32x4*)(g + n);
        if (pk >= 0) {
          *(f32x4*)(part + ((size_t)(pk * (NB * CTX) + bb * CTX + qq)) * D + n) = acc[mi][ni];
        } else {
          f32x4 xv = *(f32x4*)(xr + n);
          xv += gv * acc[mi][ni];
          *(f32x4*)(xr + n) = xv;
        }
        if ((mi & 1) == 1) asm volatile("" ::: "memory");
      }
    }
  }
};
struct EpiProbe {
  float* dump; int flag;
  DEVI void operator()(const f32x4 (&acc)[8][4], int nb, int mb, int fr, int fq, int pk) const {
    if (flag) {
#pragma unroll
      for (int mi = 0; mi < 8; ++mi)
#pragma unroll
        for (int ni = 0; ni < 4; ++ni) *(f32x4*)(dump + (size_t)(mi * 4 + ni) * 4096 + (fr * 4 + fq) * 4) = acc[mi][ni];
    }
  }
};
struct EpiSwiglu {
  bf16_t* G;
  DEVI void operator()(const f32x4 (&acc)[8][4], int nb, int mb, int fr, int fq, int pk) const {
#pragma unroll
    for (int ni = 0; ni < 4; ++ni) {
      const int m = mb + ni * 16 + fr;
#pragma unroll
      for (int mi = 0; mi < 8; mi += 2) {
        const int R = nb + mi * 16;
        const int hc = (R >> 5) * 16 + fq * 4;
        f32x4 g = acc[mi][ni], u = acc[mi + 1][ni], o;
#pragma unroll
        for (int j = 0; j < 4; ++j) o[j] = silu_f(g[j]) * u[j];
        *(u32x2*)(G + (size_t)m * LDG + hc) = pack4(o);
      }
    }
  }
};
DEVI int lds_byte2(int r, int c) { int st = (r >> 4) * 2 + (c >> 5), ob = (r & 15) * 64 + (c & 31) * 2; return st * 1024 + (ob ^ (((ob >> 9) & 1) << 5)); }
DEVI void stage_rc2(int b, int& R, int& C) { int st = b >> 10, sb = b & 1023, swz = sb ^ (((sb >> 9) & 1) << 5); R = (st >> 1) * 16 + swz / 64; C = (st & 1) * 32 + (swz % 64) / 2; }

template <int MODE, class Epi>
DEVI void gemm256_phase(int sw, const bf16_t* __restrict__ W, int ldw, const bf16_t* __restrict__ X, int ldx, int K, int nN, char* shm, const Epi& epi) {
  constexpr int TILE_B = 256 * 64 * 2, STAGE_B = 2 * TILE_B;
  const int wid = sw, lane = lane_id(), wr = wid >> 2, wc = wid & 3, fr = lane & 15, fq = lane >> 4;
  const int lds_lo = (fr * 64 + fq * 16) ^ ((fr >> 3) << 5);
  unsigned offW[4], offX[4];
#pragma unroll
  for (int i = 0; i < 4; ++i) { int R, C; stage_rc2(wid * 1024 + i * 8192 + lane * 16, R, C); offW[i] = (unsigned)(R * ldw + C) * 2u; offX[i] = (unsigned)(R * ldx + C) * 2u; }
  const int ntf = K >> 6;
  const int nM = (MODE == 0 || MODE == 3) ? 68 : 64, nfull = nM * nN, nunits = MODE == 2 ? nfull + 256 : nfull;
  auto decode = [&](int L, int& n0, int& m0, int& kt0, int& ntk) {
    if (MODE == 2 && L >= nfull) {
      const int j = L - nfull, tile = j >> 3, ks = j & 7;
      n0 = (tile & 7) * 256; m0 = (tile >> 3) * 17 * 256; ntk = ntf >> 3; kt0 = ks * ntk;
    } else {
      int wgid = L;
      { const int q = nfull / 8, r = nfull % 8, xcd = wgid % 8, off = wgid / 8; wgid = (xcd < r ? xcd * (q + 1) : r * (q + 1) + (xcd - r) * q) + off; }
      constexpr int WGM = 4;
      const int nig = WGM * nN, gid = wgid / nig, fm = gid * WGM, gsz = (nM - fm) < WGM ? (nM - fm) : WGM;
      const int pm = fm + ((wgid % nig) % gsz), pn = (wgid % nig) / gsz;
      n0 = pn * 256; m0 = (MODE == 0 ? pm : (pm / 16) * 17 + 1 + (pm % 16)) * 256; kt0 = 0; ntk = ntf;
    }
    if (MODE == 3) { n0 = 0; m0 = 0; }
    n0 = __builtin_amdgcn_readfirstlane(n0); m0 = __builtin_amdgcn_readfirstlane(m0);
    kt0 = __builtin_amdgcn_readfirstlane(kt0); ntk = __builtin_amdgcn_readfirstlane(ntk);
  };
  auto stage = [&](int buf, int n0, int m0, int kt) {
    const char* wk = (const char*)(W + (size_t)n0 * ldw) + kt * 128;
    const char* xk = (const char*)(X + (size_t)m0 * ldx) + kt * 128;
#pragma unroll
    for (int i = 0; i < 4; ++i) {
      unsigned ow = offW[i], ox = offX[i];
      asm volatile("" : "+v"(ow), "+v"(ox));
      __builtin_amdgcn_global_load_lds((const unsigned*)(wk + ow), (unsigned*)(shm + buf * STAGE_B + wid * 1024 + i * 8192), 16, 0, 0);
      __builtin_amdgcn_global_load_lds((const unsigned*)(xk + ox), (unsigned*)(shm + buf * STAGE_B + TILE_B + wid * 1024 + i * 8192), 16, 0, 0);
    }
  };
  int L = blockIdx.x;
  if (L >= nunits) return;
  int n0, m0, kt0, ntk;
  decode(L, n0, m0, kt0, ntk);
  int b0 = 0;
  stage(0, n0, m0, kt0);
  asm volatile("s_waitcnt vmcnt(0)" ::: "memory");
  __syncthreads();
  while (true) {
    const int Ln = L + gridDim.x;
    const bool has_next = Ln < nunits;
    int n1 = 0, m1 = 0, kt1 = 0, ntk1 = 0;
    if (has_next) decode(Ln, n1, m1, kt1, ntk1);
    f32x4 acc[8][4];
#pragma unroll
    for (int i = 0; i < 8; ++i)
#pragma unroll
      for (int j = 0; j < 4; ++j) acc[i][j] = (f32x4){0.f, 0.f, 0.f, 0.f};
    for (int t = 0; t < ntk; ++t) {
      const int cur = (b0 + t) & 1;
      const bool st_own = t + 1 < ntk, st_next = !st_own && has_next;
      if (wid < 4) {
        if (st_own) stage(cur ^ 1, n0, m0, kt0 + t + 1);
        else if (st_next) stage(cur ^ 1, n1, m1, kt1);
      }
      const char* SAp = shm + cur * STAGE_B + wr * (16 * 1024) + lds_lo;
      const char* SBp = shm + cur * STAGE_B + TILE_B + wc * (8 * 1024) + lds_lo;
#pragma unroll
      for (int ks = 0; ks < 2; ++ks) {
        const int kx = (wid >> 2) ? (1 - 2 * ks) * 1024 : 0;
        bf16x8 At[8], Bf[4];
#pragma unroll
        for (int m = 0; m < 8; ++m) At[m] = *(const bf16x8*)(SAp + (2 * m + ks) * 1024 + kx);
#pragma unroll
        for (int n = 0; n < 4; ++n) Bf[n] = *(const bf16x8*)(SBp + (2 * n + ks) * 1024 + kx);
#pragma unroll
        for (int m = 0; m < 8; ++m)
#pragma unroll
          for (int n = 0; n < 4; ++n) acc[m][n] = mfma16(At[m], Bf[n], acc[m][n]);
        __builtin_amdgcn_sched_barrier(0);
        if (ks == 0 && wid >= 4) {
          if (st_own) stage(cur ^ 1, n0, m0, kt0 + t + 1);
          else if (st_next) stage(cur ^ 1, n1, m1, kt1);
        }
      }
      asm volatile("s_waitcnt vmcnt(0)" ::: "memory");
      __syncthreads();
    }
    epi(acc, n0 + wr * 128, m0 + wc * 64, fr, fq, (MODE == 2 && L >= nfull) ? ((L - nfull) & 7) : -1);
    if (!has_next) break;
    b0 = (b0 + ntk) & 1; L = Ln; n0 = n1; m0 = m1; kt0 = kt1; ntk = ntk1;
  }
}

DEVI void cvt_tile(int sw, const float* __restrict__ src, int ldn, int Nvalid, bf16_t* __restrict__ dst, int ldk, int kt, int nt, int rmul, int roff, float* sm) {
  const int tid = VT;
  const int k0 = kt * 64, n0 = nt * 64;
  vbar(sm);
  {
    const int n4 = (tid & 15) * 4, n = n0 + n4;
    f32x4 v[4];
#pragma unroll
    for (int i = 0; i < 4; ++i) {
      const int kk = (tid >> 4) + 16 * i;
      v[i] = (n < Nvalid) ? *(const f32x4*)(src + (size_t)(k0 + kk) * ldn + n) : (f32x4){0.f, 0.f, 0.f, 0.f};
    }
#pragma unroll
    for (int i = 0; i < 4; ++i) {
      const int kk = (tid >> 4) + 16 * i;
#pragma unroll
      for (int jj = 0; jj < 4; ++jj) sm[(n4 + jj) * 65 + kk] = v[i][jj];
    }
  }
  vbar(sm);
  {
    int nn = tid >> 2, kq = tid & 3, n = n0 + nn;
    int drow = (n >> 4) * rmul + roff + (n & 15);
    const float* s = sm + nn * 65 + kq * 16;
    u32x4 a = {pk2(s[0], s[1]), pk2(s[2], s[3]), pk2(s[4], s[5]), pk2(s[6], s[7])};
    u32x4 b = {pk2(s[8], s[9]), pk2(s[10], s[11]), pk2(s[12], s[13]), pk2(s[14], s[15])};
    bf16_t* d = dst + (size_t)drow * ldk + k0 + kq * 16;
    *(u32x4*)d = a; *(u32x4*)(d + 8) = b;
  }
}
DEVI bool cvt_try(int sw, int& idx, const float* src, int N, int Npad, bf16_t* dst, int K, int ldk, int rmul, int roff, float* sm) {
  int kts = K >> 6, n = kts * (Npad >> 6);
  if (idx < n) { cvt_tile(sw, src, N, N, dst, ldk, idx % kts, idx / kts, rmul, roff, sm); return true; }
  idx -= n; return false;
}
DEVI void cvt_ffn(int sw, const P& p, int layer, int idx, float* sm) {
  bf16_t* gu = (bf16_t*)(p.ws + OFF_R2 + RF_GU); bf16_t* dn = (bf16_t*)(p.ws + OFF_R2 + RF_D);
  if (cvt_try(sw, idx, p.ffn_w_gate + (size_t)layer * D * FFN, FFN, FFN, gu, D, LDW, 32, 0, sm)) return;
  if (cvt_try(sw, idx, p.ffn_w_up + (size_t)layer * D * FFN, FFN, FFN, gu, D, LDW, 32, 16, sm)) return;
  cvt_try(sw, idx, p.ffn_w_down + (size_t)layer * FFN * D, D, D, dn, FFN, LDWF, 16, 0, sm);
}
constexpr int CVT_FFN_ITEMS = 3 * (D / 64) * (FFN / 64);
constexpr int CVT_MIX0_ITEMS = 32 * 84 + 8 * 24 + 8 * 32 + 32 * 32;
constexpr int CVT_MIX1_ITEMS = 32 * 100 + 32 * 32;
DEVI void cvt_mix0(int sw, const P& p, int idx, float* sm) {
  bf16_t* w = (bf16_t*)(p.ws + OFF_WMIX);
  if (cvt_try(sw, idx, p.ab_w_in, AB_IN, AB_INP, w + WM_IN, D, LDW, 16, 0, sm)) return;
  if (cvt_try(sw, idx, p.mla_w_uq, 1536, 1536, w + WM_UQ, 512, LDW5, 16, 0, sm)) return;
  if (cvt_try(sw, idx, p.mla_w_ukv, 2048, 2048, w + WM_UKV, 512, LDW5, 16, 0, sm)) return;
  cvt_try(sw, idx, p.ab_w_out, D, D, w + WM_OUT, D, LDW, 16, 0, sm);
}
DEVI void cvt_mix1(int sw, const P& p, int idx, float* sm) {
  bf16_t* w = (bf16_t*)(p.ws + OFF_WMIX);
  if (cvt_try(sw, idx, p.cd_w_in, CD_IN, CD_INP, w + WM_IN, D, LDW, 16, 0, sm)) return;
  cvt_try(sw, idx, p.cd_w_out, D, D, w + WM_OUT, D, LDW, 16, 0, sm);
}

DEVI void ada_item(int sw, const P& p, int item, float* sm) {
  const int tid = VT;
  const int l = item / 96, cb = item % 96;
  float* sc = sm;
  float* red = sm + 5 * 2048;
  vbar(sm);
  for (int i = tid; i < 5 * 2048; i += 256) {
    int s5 = i >> 11, k = i & 2047;
    float v = s5 < 4 ? p.c[s5 * D + k] : p.c_ctx[k];
    sc[i] = silu_f(v);
  }
  vbar(sm);
  const int ct = tid & 31, kg = tid >> 5;
  const float* w = p.ada_w + ((size_t)l * D + kg * 256) * MODN + cb * 128 + ct * 4;
  f32x4 a0 = {0.f, 0.f, 0.f, 0.f}, a1 = a0, a2 = a0, a3 = a0, a4 = a0;
#pragma unroll 16
  for (int k = 0; k < 256; ++k) {
    const f32x4 wv = *(const f32x4*)(w + (size_t)k * MODN);
    const int kk = kg * 256 + k;
    a0 += sc[kk] * wv; a1 += sc[2048 + kk] * wv; a2 += sc[4096 + kk] * wv; a3 += sc[6144 + kk] * wv; a4 += sc[8192 + kk] * wv;
  }
  *(f32x4*)(red + (kg * 5 + 0) * 128 + ct * 4) = a0; *(f32x4*)(red + (kg * 5 + 1) * 128 + ct * 4) = a1; *(f32x4*)(red + (kg * 5 + 2) * 128 + ct * 4) = a2;
  *(f32x4*)(red + (kg * 5 + 3) * 128 + ct * 4) = a3; *(f32x4*)(red + (kg * 5 + 4) * 128 + ct * 4) = a4;
  vbar(sm);
  for (int i = tid; i < 5 * 128; i += 256) {
    int s5 = i >> 7, cc = i & 127;
    float v = 0.f;
#pragma unroll
    for (int g = 0; g < 8; ++g) v += red[(g * 5 + s5) * 128 + cc];
    int n = cb * 128 + cc;
    ((float*)(p.ws + OFF_MOD))[((size_t)l * 5 + s5) * MODN + n] = v + p.ada_b[(size_t)l * MODN + n];
  }
}

DEVI void modulate_phase(int sw, const P& p, const float* g, const float* modl, int shift_i, int scale_i, bf16_t* H, const float* part = nullptr, const float* gate_ctx = nullptr, bool from_input = false) {
  const int lane = VT & 63;
  const int gw = (blockIdx.x * 2 + (sw >> 2)) * 4 + (sw & 3), nw = gridDim.x * 8;
  for (int r = gw; r < NT; r += nw) {
    const float* xr = xrow(p, r);
    if (from_input) { const int bb = r / TPB, qq = r - bb * TPB; xr = qq < CTX ? p.ctx + (size_t)(bb * CTX + qq) * D : p.x + (size_t)(bb * SEQ + qq - CTX) * D; }
    const float* mb = modl + (size_t)modidx(r) * MODN;
    f32x4 v[8]; float ss = 0.f;
#pragma unroll
    for (int i = 0; i < 8; ++i) v[i] = *(const f32x4*)(xr + i * 256 + lane * 4);
    if (part && modidx(r) == 4) {
      const int cr = (r / TPB) * CTX + (r % TPB);
#pragma unroll
      for (int i = 0; i < 8; ++i) {
        f32x4 sacc = {0.f, 0.f, 0.f, 0.f};
#pragma unroll
        for (int ks = 0; ks < 8; ++ks) sacc += *(const f32x4*)(part + ((size_t)(ks * (NB * CTX) + cr)) * D + i * 256 + lane * 4);
        v[i] += *(const f32x4*)(gate_ctx + i * 256 + lane * 4) * sacc;
        *(f32x4*)(xrow(p, r) + i * 256 + lane * 4) = v[i];
      }
    }
    if (from_input) {
      float* xw = xrow(p, r);
#pragma unroll
      for (int i = 0; i < 8; ++i) *(f32x4*)(xw + i * 256 + lane * 4) = v[i];
    }
#pragma unroll
    for (int i = 0; i < 8; ++i) ss += v[i][0] * v[i][0] + v[i][1] * v[i][1] + v[i][2] * v[i][2] + v[i][3] * v[i][3];
    ss = wave_sum(ss);
    float rs = rsqrtf(ss * (1.f / D) + EPS);
#pragma unroll
    for (int i = 0; i < 8; ++i) {
      int cidx = i * 256 + lane * 4;
      f32x4 gg = *(const f32x4*)(g + cidx), sh = *(const f32x4*)(mb + shift_i * D + cidx), sc = *(const f32x4*)(mb + scale_i * D + cidx);
      f32x4 y;
#pragma unroll
      for (int j = 0; j < 4; ++j) y[j] = v[i][j] * rs * gg[j] * (1.f + sc[j]) + sh[j];
      *(u32x2*)(H + (size_t)r * LDH + cidx) = pack4(y);
    }
  }
}

template <int DQK>
DEVI void attn256_item(int sw, const bf16_t* __restrict__ Q, int ldq, const bf16_t* __restrict__ Kp, int ldk, const bf16_t* __restrict__ Vt,
                       bf16_t* __restrict__ O, int ldo, int nkeys, float negB, char* shm) {
  constexpr int KS = DQK / 32, KCH = DQK / 8, KBYTES = 64 * DQK * 2, STG = KBYTES + 16384, NKI = (64 * KCH) / 512;
  const int wid = sw, lane = lane_id(), fr = lane & 15, fq = lane >> 4, rsw = (fr >> 1) & 7;
  unsigned offK[NKI], offV[2];
#pragma unroll
  for (int i = 0; i < NKI; ++i) {
    const int q = (wid * NKI + i) * 64 + lane, row = q / KCH, cp = q - row * KCH;
    const int c = (cp & ~7) | ((cp & 7) ^ ((row >> 1) & 7));
    offK[i] = (unsigned)(row * ldk + c * 8) * 2u;
  }
#pragma unroll
  for (int i = 0; i < 2; ++i) {
    const int q = (wid * 2 + i) * 64 + lane, row = q >> 3, cp = q & 7;
    const int c = cp ^ ((row >> 1) & 7);
    offV[i] = (unsigned)(row * TPS + c * 8) * 2u;
  }
  auto stage = [&](int buf, int k0) {
    const char* kb = (const char*)(Kp + (size_t)k0 * ldk);
    const char* vb = (const char*)(Vt + k0);
#pragma unroll
    for (int i = 0; i < NKI; ++i) {
      unsigned o = offK[i]; asm volatile("" : "+v"(o));
      __builtin_amdgcn_global_load_lds((const unsigned*)(kb + o), (unsigned*)(shm + buf * STG + (wid * NKI + i) * 1024), 16, 0, 0);
    }
#pragma unroll
    for (int i = 0; i < 2; ++i) {
      unsigned o = offV[i]; asm volatile("" : "+v"(o));
      __builtin_amdgcn_global_load_lds((const unsigned*)(vb + o), (unsigned*)(shm + buf * STG + KBYTES + (wid * 2 + i) * 1024), 16, 0, 0);
    }
  };
  bf16x8 qf[2][KS];
#pragma unroll
  for (int nt = 0; nt < 2; ++nt)
#pragma unroll
    for (int ks = 0; ks < KS; ++ks) qf[nt][ks] = *(const bf16x8*)(Q + (size_t)(wid * 32 + nt * 16 + fr) * ldq + ks * 32 + fq * 8);
  f32x4 o[8][2];
#pragma unroll
  for (int i = 0; i < 8; ++i) { o[i][0] = (f32x4){0.f, 0.f, 0.f, 0.f}; o[i][1] = (f32x4){0.f, 0.f, 0.f, 0.f}; }
  float l_[2] = {0.f, 0.f};
  const int ntile = nkeys >> 6;
  __syncthreads();
  stage(0, 0);
  asm volatile("s_waitcnt vmcnt(0)" ::: "memory");
  __syncthreads();
  for (int t = 0; t < ntile; ++t) {
    const int cur = t & 1;
    if (wid < 4 && t + 1 < ntile) stage(cur ^ 1, (t + 1) * 64);
    const bf16_t* Ks = (const bf16_t*)(shm + cur * STG);
    const char* Vs = shm + cur * STG + KBYTES;
#pragma unroll
    for (int half = 0; half < 2; ++half) {
      f32x4 s[2][2];
#pragma unroll
      for (int i = 0; i < 2; ++i) { s[i][0] = (f32x4){negB, negB, negB, negB}; s[i][1] = (f32x4){negB, negB, negB, negB}; }
#pragma unroll
      for (int ks = 0; ks < KS; ++ks)
#pragma unroll
        for (int kt = 0; kt < 2; ++kt) {
          const int krow = half * 32 + 8 * (fr >> 2) + 4 * kt + (fr & 3);
          const int ksw = (krow >> 1) & 7;
          bf16x8 kf = *(const bf16x8*)(Ks + krow * DQK + ((((ks * 4 + fq) & ~7) | (((ks * 4 + fq) & 7) ^ ksw)) * 8));
          s[kt][0] = mfma16(kf, qf[0][ks], s[kt][0]);
          s[kt][1] = mfma16(kf, qf[1][ks], s[kt][1]);
        }
      bf16x8 pf[2];
#pragma unroll
      for (int nt = 0; nt < 2; ++nt) {
        float rs = 0.f;
#pragma unroll
        for (int kt = 0; kt < 2; ++kt)
#pragma unroll
          for (int j = 0; j < 4; ++j) { float pv = __builtin_amdgcn_exp2f(s[kt][nt][j]); s[kt][nt][j] = pv; rs += pv; }
        l_[nt] += rs;
        pf[nt] = pack8(s[0][nt], s[1][nt]);
      }
#pragma unroll
      for (int dt = 0; dt < 8; ++dt) {
        bf16x8 vf = *(const bf16x8*)(Vs + (dt * 16 + fr) * 128 + (((half * 4 + fq) ^ rsw) * 16));
        o[dt][0] = mfma16(vf, pf[0], o[dt][0]);
        o[dt][1] = mfma16(vf, pf[1], o[dt][1]);
      }
      if (half == 0 && wid >= 4 && t + 1 < ntile) stage(cur ^ 1, (t + 1) * 64);
    }
    asm volatile("s_waitcnt vmcnt(0)" ::: "memory");
    __syncthreads();
  }
#pragma unroll
  for (int nt = 0; nt < 2; ++nt) {
    float l = l_[nt];
    l += __shfl_xor(l, 16); l += __shfl_xor(l, 32);
    float inv = 1.f / l;
#pragma unroll
    for (int dt = 0; dt < 8; ++dt) {
      f32x4 v = o[dt][nt] * inv;
      *(u32x2*)(O + (size_t)(wid * 32 + nt * 16 + fr) * ldo + dt * 16 + fq * 4) = pack4(v);
    }
  }
}

DEVI void prep0_norm512(int sw, const P& p, int item) {
  const int lane = lane_id();
  const int w0 = (item * 4 + (sw & 3)) * 8;
  u32x4 u[8];
#pragma unroll
  for (int q = 0; q < 8; ++q) { int w = w0 + q, r = w >> 1, which = w & 1; u[q] = *(const u32x4*)((const bf16_t*)(p.ws + OFF_Z) + (size_t)r * LDZ0 + which * 512 + lane * 8); }
#pragma unroll
  for (int q = 0; q < 8; ++q) {
    int w = w0 + q, r = w >> 1, which = w & 1;
    float v[8] = {bflo(u[q][0]), bfhi(u[q][0]), bflo(u[q][1]), bfhi(u[q][1]), bflo(u[q][2]), bfhi(u[q][2]), bflo(u[q][3]), bfhi(u[q][3])};
    float ss = 0.f;
#pragma unroll
    for (int j = 0; j < 8; ++j) ss += v[j] * v[j];
    ss = wave_sum(ss);
    float rs = rsqrtf(ss * (1.f / 512.f) + EPS);
    const float* g = (which ? p.mla_kv_a_norm : p.mla_q_a_norm) + lane * 8;
    u32x4 o = {pk2(v[0] * rs * g[0], v[1] * rs * g[1]), pk2(v[2] * rs * g[2], v[3] * rs * g[3]), pk2(v[4] * rs * g[4], v[5] * rs * g[5]), pk2(v[6] * rs * g[6], v[7] * rs * g[7])};
    *(u32x4*)((bf16_t*)(p.ws + OFF_H) + (size_t)which * NT * LDQA + (size_t)r * LDQA + lane * 8) = o;
  }
}
DEVI void store_T(int sw, const bf16_t* T, bf16_t* __restrict__ dst) {
  const int tid = VT;
#pragma unroll
  for (int i = 0; i < 4; ++i) {
    const int c = tid + 256 * i, row = c >> 3, ch = c & 7;
    *(u32x4*)(dst + (size_t)row * TPS + ch * 8) = *(const u32x4*)(T + row * 72 + ch * 8);
  }
}
DEVI void put_T(bf16_t* T, int d, int half, const float (&y)[32]) {
#pragma unroll
  for (int i = 0; i < 4; ++i) {
    u32x4 u = {pk2(y[8 * i], y[8 * i + 1]), pk2(y[8 * i + 2], y[8 * i + 3]), pk2(y[8 * i + 4], y[8 * i + 5]), pk2(y[8 * i + 6], y[8 * i + 7])};
    *(u32x4*)(T + d * 72 + half * 32 + 8 * i) = u;
  }
}
DEVI void prep0_gdn(int sw, const P& p, int item, float* sm) {
  const int tid = VT;
  const int which = item & 3; int t = item >> 2;
  const int mc = t % NCH; t /= NCH;
  const int h = t & 7, b = t >> 3;
  const int p0 = mc * 64;
  const int bh = b * 8 + h;
  char* R2 = p.ws + OFF_R2;
  if (which == 3) {
    if (tid < 128) {
      const int dir = tid >> 6, ln = tid & 63;
      const int c = dir ? 63 - ln : ln;
      const float* gr = (const float*)(R2 + R_GATES) + (size_t)(b * TPB + p0 + c) * 32;
      const float A = __expf(p.gdn_a_log[dir * 8 + h]), dtb = p.gdn_dt_bias[dir * 8 + h];
      const float a = gr[dir * 8 + h] + dtb, bb = gr[16 + dir * 8 + h];
      const float sp = fmaxf(a, 0.f) + log1pf(__expf(-fabsf(a)));
      float v = -A * sp;
#pragma unroll
      for (int off = 1; off < 64; off <<= 1) { float t2 = __shfl_up(v, off); if (ln >= off) v += t2; }
      ((float*)(R2 + R_GC))[(size_t)(bh * 2 + dir) * TPB + p0 + c] = v;
      ((float*)(R2 + R_BETA))[(size_t)(bh * 2 + dir) * TPB + p0 + c] = 1.f / (1.f + __expf(-bb));
    }
    vbar(sm);
    return;
  }
  const int d = tid & 127, half = tid >> 7;
  const int col0 = 1088 + which * 1024 + h * 128;
  const int col = col0 + d;
  const int lo = p0 < CTX ? 0 : CTX, hi = p0 < CTX ? CTX : TPB;
  bf16_t* xin = (bf16_t*)sm;
  float* sq = (float*)(xin + 72 * 128);
  float* nrm = sq + 64 * 129;
  bf16_t* yb = (bf16_t*)(nrm + 64);
  vbar(sm);
  {
    const bf16_t* zb = (const bf16_t*)(p.ws + OFF_Z) + (size_t)(b * TPB) * LDZ0 + col0;
    for (int c = tid; c < 68 * 16; c += 256) {
      const int row = c >> 4, ch = c & 15, pp = p0 - 2 + row;
      u32x4 v = {0u, 0u, 0u, 0u};
      if (pp >= lo && pp < hi) v = *(const u32x4*)(zb + (size_t)pp * LDZ0 + ch * 8);
      *(u32x4*)(xin + row * 128 + ch * 8) = v;
    }
  }
  vbar(sm);
  const float w0 = p.gdn_conv_w[0 * 3072 + col - 1088], w1 = p.gdn_conv_w[1 * 3072 + col - 1088], w2 = p.gdn_conv_w[2 * 3072 + col - 1088],
              w3 = p.gdn_conv_w[3 * 3072 + col - 1088], w4 = p.gdn_conv_w[4 * 3072 + col - 1088];
  const int ps = p0 + half * 32;
  const bf16_t* xc = xin + (half * 32) * 128 + d;
  float xm2 = bf2f(xc[0]), xm1 = bf2f(xc[128]), x0 = bf2f(xc[256]), xp1 = bf2f(xc[384]);
  float y[32];
#pragma unroll
  for (int i = 0; i < 32; ++i) {
    float xp2 = bf2f(xc[(i + 4) * 128]);
    float a = w0 * xm2 + w1 * xm1 + w2 * x0 + w3 * xp1 + w4 * xp2;
    y[i] = silu_f(a);
    xm2 = xm1; xm1 = x0; x0 = xp1; xp1 = xp2;
  }
  if (which == 2) {
    vbar(sm);
    put_T(xin, d, half, y);
    vbar(sm);
    store_T(sw, xin, (bf16_t*)(R2 + R_GVT) + ((size_t)bh * 128) * TPS + p0);
    return;
  }
#pragma unroll
  for (int i = 0; i < 32; ++i) sq[(half * 32 + i) * 129 + d] = y[i] * y[i];
  vbar(sm);
  {
    int c = tid >> 2, part = tid & 3;
    float sacc = 0.f;
    for (int i = 0; i < 32; ++i) sacc += sq[c * 129 + part * 32 + i];
    sacc += __shfl_xor(sacc, 1); sacc += __shfl_xor(sacc, 2);
    if (part == 0) nrm[c] = rsqrtf(sacc + EPS) * (which == 0 ? 0.08838834764831845f : 1.f);
  }
  vbar(sm);
#pragma unroll
  for (int i = 0; i < 32; ++i) { y[i] *= nrm[half * 32 + i]; yb[(half * 32 + i) * 136 + d] = f2bf(y[i]); }
  if (which == 1) put_T(xin, d, half, y);
  vbar(sm);
  if (which == 1) store_T(sw, xin, (bf16_t*)(R2 + R_GKT) + ((size_t)bh * 128) * TPS + p0);
  {
    bf16_t* dq = (bf16_t*)(R2 + (which == 0 ? R_GQ : R_GK)) + ((size_t)bh * TPB + p0) * 128;
#pragma unroll
    for (int i = 0; i < 4; ++i) {
      const int c = tid + 256 * i, row = c >> 4, ch = c & 15;
      *(u32x4*)(dq + row * 128 + ch * 8) = *(const u32x4*)(yb + row * 136 + ch * 8);
    }
  }
}

DEVI float rope64(float val, int lane, int t) {
  int i = lane & 15, hf = (lane >> 4) & 1, axis = lane >> 5;
  float pos = (float)(axis ? (t & 63) : (t >> 6));
  float invf = exp2f(-(float)(2 * i) * (13.287712379549449f / 32.f));
  float ang = pos * invf;
  float cs = __cosf(ang), sn = __sinf(ang);
  float partner = __shfl_xor(val, 16);
  return hf ? (val * cs + partner * sn) : (val * cs - partner * sn);
}

DEVI void prep0_q(int sw, const P& p, int item) {
  const int lane = lane_id();
  const int w0 = (item * 4 + (sw & 3)) * 8;
  const int r = w0 >> 3;
  bf16_t* qb = (bf16_t*)(p.ws + OFF_R2 + R_QUP) + (size_t)r * 1536;
  float a[8], b[8], c[8];
#pragma unroll
  for (int h = 0; h < 8; ++h) { a[h] = bf2f(qb[h * 192 + lane]); b[h] = bf2f(qb[h * 192 + 64 + lane]); c[h] = bf2f(qb[h * 192 + 128 + lane]); }
  const float g0 = p.mla_q_norm[lane], g1 = p.mla_q_norm[64 + lane], g2 = p.mla_q_norm[128 + lane];
  const int pp = r % TPB;
  const float sc = 0.07216878364870322f * LOG2E;
#pragma unroll
  for (int h = 0; h < 8; ++h) {
    float ss = wave_sum(a[h] * a[h] + b[h] * b[h] + c[h] * c[h]);
    float rs = rsqrtf(ss * (1.f / 192.f) + EPS);
    float x = a[h] * rs * g0, y = b[h] * rs * g1, z = c[h] * rs * g2;
    if (pp >= CTX) z = rope64(z, lane, pp - CTX);
    qb[h * 192 + lane] = f2bf(x * sc); qb[h * 192 + 64 + lane] = f2bf(y * sc); qb[h * 192 + 128 + lane] = f2bf(z * sc);
  }
}
DEVI void prep0_k(int sw, const P& p, int item) {
  const int lane = lane_id();
  const int w0 = (item * 4 + (sw & 3)) * 8;
  const int r = w0 >> 3;
  const bf16_t* kv = (const bf16_t*)(p.ws + OFF_MIX) + (size_t)r * LDH;
  const float c0 = bf2f(((const bf16_t*)(p.ws + OFF_Z) + (size_t)r * LDZ0 + 1024)[lane]);
  float a[8], b[8];
#pragma unroll
  for (int h = 0; h < 8; ++h) { a[h] = bf2f(kv[h * 256 + lane]); b[h] = bf2f(kv[h * 256 + 64 + lane]); }
  const float g0 = p.mla_k_norm[lane], g1 = p.mla_k_norm[64 + lane], g2 = p.mla_k_norm[128 + lane];
  const int pp = r % TPB;
  bf16_t* k = (bf16_t*)(p.ws + OFF_R2 + R_K) + (size_t)r * LDK;
#pragma unroll
  for (int h = 0; h < 8; ++h) {
    float ss = wave_sum(a[h] * a[h] + b[h] * b[h] + c0 * c0);
    float rs = rsqrtf(ss * (1.f / 192.f) + EPS);
    float x = a[h] * rs * g0, y = b[h] * rs * g1, z = c0 * rs * g2;
    if (pp >= CTX) z = rope64(z, lane, pp - CTX);
    k[h * 192 + lane] = f2bf(x); k[h * 192 + 64 + lane] = f2bf(y); k[h * 192 + 128 + lane] = f2bf(z);
  }
}
DEVI void transpose64x128(int sw, const bf16_t* __restrict__ src, int ld, bf16_t* __restrict__ dst  , char* smb) {
  const int tid = VT, d = tid & 127, half = tid >> 7;
  float y[32];
#pragma unroll
  for (int i = 0; i < 32; ++i) y[i] = bf2f(src[(size_t)(half * 32 + i) * ld + d]);
  bf16_t* T = (bf16_t*)smb;
  vbar(smb);
  put_T(T, d, half, y);
  vbar(smb);
  store_T(sw, T, dst);
}
DEVI void gdn_pre(int sw, const P& p, int item, char* smraw) {
  const int tid = VT, lane = tid & 63, wid = tid >> 6, fr = lane & 15, fq = lane >> 4;
  const int mc = item % NCH; int t = item / NCH;
  const int dir = t & 1, bh = t >> 1;
  const int p0 = mc * 64;
  char* R2 = p.ws + OFF_R2;
  bf16_t* qs = (bf16_t*)smraw;
  bf16_t* ks = qs + 64 * 136;
  float* Ls = (float*)(ks + 64 * 136);
  float* gcs = Ls + 4096;
  float* bes = gcs + 64;
  vbar(smraw);
  {
    const bf16_t* gq = (const bf16_t*)(R2 + R_GQ) + ((size_t)bh * TPB + p0) * 128;
    const bf16_t* gk = (const bf16_t*)(R2 + R_GK) + ((size_t)bh * TPB + p0) * 128;
#pragma unroll
    for (int i = 0; i < 4; ++i) {
      int c = tid + 256 * i, row = c >> 4, kc = c & 15;
      *(u32x4*)(qs + row * 136 + kc * 8) = *(const u32x4*)(gq + row * 128 + kc * 8);
      *(u32x4*)(ks + row * 136 + kc * 8) = *(const u32x4*)(gk + row * 128 + kc * 8);
    }
    if (tid < 64) {
      gcs[tid] = ((const float*)(R2 + R_GC))[(size_t)(bh * 2 + dir) * TPB + p0 + tid];
      bes[tid] = ((const float*)(R2 + R_BETA))[(size_t)(bh * 2 + dir) * TPB + p0 + tid];
    }
  }
  vbar(smraw);
  {
    const int it = wid;
    const int i = it * 16 + fr;
    const float gi = gcs[i], bi = bes[i];
    bf16x8 bq[4], bk[4];
#pragma unroll
    for (int s = 0; s < 4; ++s) {
      bq[s] = *(const bf16x8*)(qs + i * 136 + s * 32 + fq * 8);
      bk[s] = *(const bf16x8*)(ks + i * 136 + s * 32 + fq * 8);
    }
    bf16_t* qkm = (bf16_t*)(R2 + R_QKM) + (size_t)item * 4096;
#pragma unroll
    for (int jt = 0; jt < 4; ++jt) {
      f32x4 akk = {0.f, 0.f, 0.f, 0.f}, aqk = {0.f, 0.f, 0.f, 0.f};
#pragma unroll
      for (int s = 0; s < 4; ++s) {
        bf16x8 a = *(const bf16x8*)(ks + (jt * 16 + fr) * 136 + s * 32 + fq * 8);
        akk = mfma16(a, bk[s], akk);
        aqk = mfma16(a, bq[s], aqk);
      }
      f32x4 qo;
#pragma unroll
      for (int jj = 0; jj < 4; ++jj) {
        int j = jt * 16 + fq * 4 + jj;
        float gj = gcs[j];
        bool before = dir ? (j > i) : (j < i);
        bool incl = before || (j == i);
        float e = incl ? __expf(gi - gj) : 0.f;
        qo[jj] = aqk[jj] * e;
        float lv = before ? bi * akk[jj] * e : 0.f;
        int ti = dir ? 63 - i : i, tj = dir ? 63 - j : j;
        Ls[tj * 64 + ti] = lv;
      }
      *(u32x2*)(qkm + i * 64 + jt * 16 + fq * 4) = pack4(qo);
    }
  }
  vbar(smraw);
  if (wid == 0) {
    const int j = lane;
    const int sj = dir ? 63 - j : j;
    float x[64];
#pragma unroll
    for (int t2 = 0; t2 < 64; ++t2) x[t2] = (t2 == sj) ? 1.f : 0.f;
    typedef __attribute__((address_space(3))) const f32x4 lds_f32x4;
    unsigned lofs = (unsigned)(size_t)(__attribute__((address_space(3))) const float*)Ls;
    asm volatile("" : "+v"(lofs));
    lds_f32x4* L4 = (lds_f32x4*)(size_t)lofs;
    f32x4 rowv[16];
#pragma unroll
    for (int g = 0; g < 16; ++g) rowv[g] = L4[g];
#pragma unroll
    for (int t2 = 0; t2 < 63; ++t2) {
      f32x4 nxt[16];
#pragma unroll
      for (int g = 0; g < 16; ++g) nxt[g] = (t2 + 1 < 63 && g >= (t2 + 2) / 4) ? L4[(t2 + 1) * 16 + g] : (f32x4){0.f, 0.f, 0.f, 0.f};
      const float xt = x[t2];
#pragma unroll
      for (int i = t2 + 1; i < 64; ++i) x[i] -= rowv[i >> 2][i & 3] * xt;
#pragma unroll
      for (int g = 0; g < 16; ++g) rowv[g] = nxt[g];
    }
    bf16_t* tm = (bf16_t*)(R2 + R_TM) + (size_t)item * 4096;
#pragma unroll
    for (int t2 = 0; t2 < 64; ++t2) {
      int i = dir ? 63 - t2 : t2;
      tm[i * 64 + j] = f2bf(x[t2]);
    }
  }
}

template <bool GDN>
DEVI void scan_chain(int sw, const P& p, int item, char* smraw) {
  const int tid = VT, lane = tid & 63, wid = tid >> 6, fr = lane & 15, fq = lane >> 4;
  int slice, dir, h, b, NH, DV;
  if (GDN) { slice = item & 1; dir = (item >> 1) & 1; h = (item >> 2) & 7; b = item >> 5; NH = 8; DV = 128; }
  else { slice = item & 3; dir = (item >> 2) & 1; h = (item >> 3) & 3; b = item >> 5; NH = 4; DV = 256; }
  const int bh = b * NH + h, bhd = bh * 2 + dir;
  char* R2 = p.ws + OFF_R2;
  bf16_t* kbg = (bf16_t*)smraw;
  bf16_t* qd = kbg + 64 * 136;
  bf16_t* kend = qd + 64 * 136;
  bf16_t* Tm = kend + 128 * 72;
  bf16_t* QK = Tm + 64 * 72;
  float* f_e = (float*)(QK + 64 * 72);
  float* f_b = f_e + 64;
  float* f_k = f_b + 64;
  float* el = f_k + 64;
  float* f_last = el + 128;
  const int e0 = slice * 64 + wid * 16;
  f32x4 S[8];
#pragma unroll
  for (int i = 0; i < 8; ++i) S[i] = (f32x4){0.f, 0.f, 0.f, 0.f};
  bf16_t* rec = (bf16_t*)(GDN ? (p.ws + OFF_H) : (R2 + R1_REC)) + (size_t)dir * NT * 1024;
  for (int n = 0; n < NCH; ++n) {
    const int mc = dir == 0 ? n : (n < 4 ? 3 - n : 71 - n);
    const int p0 = mc * 64;
    const int itc = bhd * NCH + mc;
    __syncthreads();
    if (GDN) {
      if (tid < 64) {
        const float* gc = (const float*)(R2 + R_GC) + (size_t)bhd * TPB + p0;
        float gcv = gc[tid], gl = gc[dir ? 0 : 63];
        f_e[tid] = __expf(gcv);
        f_b[tid] = ((const float*)(R2 + R_BETA))[(size_t)bhd * TPB + p0 + tid];
        f_k[tid] = __expf(gl - gcv);
        if (tid == 0) f_last[0] = __expf(gl);
      }
    } else {
      if (tid < 128) el[tid] = ((const float*)(R2 + R1_EL))[(size_t)itc * 128 + tid];
    }
    __syncthreads();
    if (GDN) {
      const bf16_t* gq = (const bf16_t*)(R2 + R_GQ) + ((size_t)bh * TPB + p0) * 128;
      const bf16_t* gk = (const bf16_t*)(R2 + R_GK) + ((size_t)bh * TPB + p0) * 128;
      const bf16_t* gkt = (const bf16_t*)(R2 + R_GKT) + ((size_t)bh * 128) * TPS + p0;
      const bf16_t* tm = (const bf16_t*)(R2 + R_TM) + (size_t)itc * 4096;
      const bf16_t* qkm = (const bf16_t*)(R2 + R_QKM) + (size_t)itc * 4096;
#pragma unroll
      for (int i = 0; i < 4; ++i) {
        int c = tid + 256 * i, row = c >> 4, kc = c & 15;
        u32x4 uq = *(const u32x4*)(gq + row * 128 + kc * 8), uk = *(const u32x4*)(gk + row * 128 + kc * 8);
        float fe = f_e[row], fk = f_b[row] * fe;
        u32x4 oq, ok;
#pragma unroll
        for (int j = 0; j < 4; ++j) { oq[j] = pk2(bflo(uq[j]) * fe, bfhi(uq[j]) * fe); ok[j] = pk2(bflo(uk[j]) * fk, bfhi(uk[j]) * fk); }
        *(u32x4*)(qd + row * 136 + kc * 8) = oq;
        *(u32x4*)(kbg + row * 136 + kc * 8) = ok;
      }
#pragma unroll
      for (int i = 0; i < 4; ++i) {
        int c = tid + 256 * i, row = c >> 3, cc = c & 7;
        u32x4 u = *(const u32x4*)(gkt + (size_t)row * TPS + cc * 8), o;
#pragma unroll
        for (int j = 0; j < 4; ++j) o[j] = pk2(bflo(u[j]) * f_k[cc * 8 + 2 * j], bfhi(u[j]) * f_k[cc * 8 + 2 * j + 1]);
        *(u32x4*)(kend + row * 72 + cc * 8) = o;
      }
#pragma unroll
      for (int i = 0; i < 2; ++i) {
        int c = tid + 256 * i, row = c >> 3, cc = c & 7;
        *(u32x4*)(Tm + row * 72 + cc * 8) = *(const u32x4*)(tm + row * 64 + cc * 8);
        *(u32x4*)(QK + row * 72 + cc * 8) = *(const u32x4*)(qkm + row * 64 + cc * 8);
      }
    } else {
      const bf16_t* gq = (const bf16_t*)(R2 + R1_QG) + ((size_t)bhd * TPB + p0) * 128;
      const bf16_t* gkt = (const bf16_t*)(R2 + R1_KGT) + ((size_t)bhd * 128) * TPS + p0;
      const bf16_t* am = (const bf16_t*)(R2 + R1_AM) + (size_t)itc * 4096;
#pragma unroll
      for (int i = 0; i < 4; ++i) {
        int c = tid + 256 * i, row = c >> 4, kc = c & 15;
        *(u32x4*)(qd + row * 136 + kc * 8) = *(const u32x4*)(gq + row * 128 + kc * 8);
      }
#pragma unroll
      for (int i = 0; i < 4; ++i) {
        int c = tid + 256 * i, row = c >> 3, cc = c & 7;
        *(u32x4*)(kend + row * 72 + cc * 8) = *(const u32x4*)(gkt + (size_t)row * TPS + cc * 8);
      }
#pragma unroll
      for (int i = 0; i < 2; ++i) {
        int c = tid + 256 * i, row = c >> 3, cc = c & 7;
        *(u32x4*)(QK + row * 72 + cc * 8) = *(const u32x4*)(am + row * 64 + cc * 8);
      }
    }
    __syncthreads();
    bf16x8 Sop[4];
#pragma unroll
    for (int ks = 0; ks < 4; ++ks) Sop[ks] = pack8(S[2 * ks], S[2 * ks + 1]);
    bf16x8 vop[2];
    if (GDN) {
      const bf16_t* gvt = (const bf16_t*)(R2 + R_GVT) + ((size_t)bh * 128 + e0 + fr) * TPS + p0;
      f32x4 X[4];
#pragma unroll
      for (int ct = 0; ct < 4; ++ct) {
        u32x2 u = *(const u32x2*)(gvt + ct * 16 + fq * 4);
        const float* fb = f_b + ct * 16 + fq * 4;
        f32x4 vb = {bflo(u[0]) * fb[0], bfhi(u[0]) * fb[1], bflo(u[1]) * fb[2], bfhi(u[1]) * fb[3]};
        f32x4 acc = {0.f, 0.f, 0.f, 0.f};
#pragma unroll
        for (int ks = 0; ks < 4; ++ks) acc = mfma16(ldsperm(kbg, ct * 16 + fr, 136, ks, fq), Sop[ks], acc);
        X[ct] = vb - acc;
      }
      bf16x8 Xop[2] = {pack8(X[0], X[1]), pack8(X[2], X[3])};
      f32x4 vn[4];
#pragma unroll
      for (int ct = 0; ct < 4; ++ct) {
        f32x4 acc = {0.f, 0.f, 0.f, 0.f};
#pragma unroll
        for (int kk = 0; kk < 2; ++kk) acc = mfma16(ldsperm(Tm, ct * 16 + fr, 72, kk, fq), Xop[kk], acc);
        vn[ct] = acc;
      }
      vop[0] = pack8(vn[0], vn[1]); vop[1] = pack8(vn[2], vn[3]);
    } else {
      const bf16_t* gvt = (const bf16_t*)(R2 + R1_VTG) + ((size_t)bh * 256 + e0 + fr) * TPS + p0;
#pragma unroll
      for (int kk = 0; kk < 2; ++kk) {
        u32x2 lo = *(const u32x2*)(gvt + kk * 32 + fq * 4), hi = *(const u32x2*)(gvt + kk * 32 + 16 + fq * 4);
        vop[kk] = cat8(lo, hi);
      }
    }
#pragma unroll
    for (int ct = 0; ct < 4; ++ct) {
      f32x4 acc = {0.f, 0.f, 0.f, 0.f};
#pragma unroll
      for (int ks = 0; ks < 4; ++ks) acc = mfma16(Sop[ks], ldsperm(qd, ct * 16 + fr, 136, ks, fq), acc);
#pragma unroll
      for (int kk = 0; kk < 2; ++kk) acc = mfma16(vop[kk], ldsperm(QK, ct * 16 + fr, 72, kk, fq), acc);
      *(u32x2*)(rec + (size_t)(b * TPB + p0 + ct * 16 + fr) * 1024 + h * DV + e0 + fq * 4) = pack4(acc);
    }
#pragma unroll
    for (int dt = 0; dt < 8; ++dt) {
      if (GDN) S[dt] *= f_last[0];
      else S[dt] *= *(const f32x4*)(el + dt * 16 + fq * 4);
#pragma unroll
      for (int kk = 0; kk < 2; ++kk) S[dt] = mfma16(ldsperm(kend, dt * 16 + fr, 72, kk, fq), vop[kk], S[dt]);
    }
  }
}

DEVI void fin0_rec(int sw, const P& p, int item) {
  const int lane = lane_id();
  const int w0 = (item * 4 + (sw & 3)) * 8;
  const int r = w0 >> 3;
  const bf16_t* r0 = (const bf16_t*)(p.ws + OFF_H) + (size_t)r * 1024 + lane * 2;
  const bf16_t* zz = (const bf16_t*)(p.ws + OFF_Z) + (size_t)r * LDZ0 + 4160 + lane * 2;
  unsigned u0[8], u1[8], uz[8];
#pragma unroll
  for (int h = 0; h < 8; ++h) { u0[h] = *(const unsigned*)(r0 + h * 128); u1[h] = *(const unsigned*)(r0 + (size_t)NT * 1024 + h * 128); uz[h] = *(const unsigned*)(zz + h * 128); }
  const float n0 = p.gdn_out_norm[lane * 2], n1 = p.gdn_out_norm[lane * 2 + 1];
#pragma unroll
  for (int h = 0; h < 8; ++h) {
    float a = bflo(u0[h]) + bflo(u1[h]), b = bfhi(u0[h]) + bfhi(u1[h]);
    float ss = wave_sum(a * a + b * b);
    float rs = rsqrtf(ss * (1.f / 128.f) + EPS);
    float oa = a * rs * n0 * silu_f(bflo(uz[h])), ob = b * rs * n1 * silu_f(bfhi(uz[h]));
    *(unsigned*)((bf16_t*)(p.ws + OFF_MIX) + (size_t)r * LDH + 1024 + h * 128 + lane * 2) = pk2(oa, ob);
  }
}

DEVI void prep1_qk(int sw, const P& p, int item) {
  const int lane = lane_id();
  const int w = item * 4 + (sw & 3);
  const int which = w & 1, r = w >> 1;
  bf16_t* q = (bf16_t*)(p.ws + OFF_Z) + (size_t)r * LDZ1 + which * 1024;
  float a[16];
#pragma unroll
  for (int hm = 0; hm < 16; ++hm) a[hm] = bf2f(q[hm * 64 + lane]);
  const float* gn = which ? p.diff_k_norm : p.diff_q_norm;
  const float g0 = gn[lane], g1 = gn[64 + lane];
  const int pp = r % TPB;
#pragma unroll
  for (int hm = 0; hm < 16; ++hm) {
    float ss = wave_sum(a[hm] * a[hm]);
    float rs = rsqrtf(ss * (1.f / 64.f) + EPS);
    float x = a[hm] * rs * ((hm & 1) ? g1 : g0);
    if (pp >= CTX) x = rope64(x, lane, pp - CTX);
    if (which == 0) x *= 0.125f * LOG2E;
    q[hm * 64 + lane] = f2bf(x);
  }
}
DEVI void gla_pre(int sw, const P& p, int item, char* smraw) {
  const int tid = VT, lane = tid & 63, wid = tid >> 6, fr = lane & 15, fq = lane >> 4;
  const int mc = item % NCH; int t = item / NCH;
  const int dir = t & 1, bh = t >> 1, h = bh & 3, b = bh >> 2;
  const int p0 = mc * 64;
  char* R2 = p.ws + OFF_R2;
  float* cum = (float*)smraw;
  float* lr = cum + 64 * 129;
  float* last = lr + 64 * 16;
  bf16_t* QS = (bf16_t*)(last + 128);
  bf16_t* KS = QS + 64 * 136;
  const bf16_t* z = (const bf16_t*)(p.ws + OFF_Z) + (size_t)(b * TPB + p0) * LDZ1;
  vbar(smraw);
#pragma unroll
  for (int i = tid; i < 64 * 16; i += 256) lr[i] = ((const float*)(R2 + R1_GATES))[(size_t)(b * TPB + p0 + (i >> 4)) * 32 + dir * 16 + (i & 15)];
  vbar(smraw);
  {
    const int d = tid & 127, half = tid >> 7;
    float w2[16];
#pragma unroll
    for (int rr = 0; rr < 16; ++rr) w2[rr] = p.gla_gate_w2[((size_t)dir * 16 + rr) * 512 + h * 128 + d];
    const float b2 = p.gla_gate_b2[dir * 512 + h * 128 + d];
#pragma unroll 4
    for (int i = 0; i < 32; ++i) {
      int c = half * 32 + i;
      float lg = b2;
#pragma unroll
      for (int rr = 0; rr < 16; ++rr) lg += lr[c * 16 + rr] * w2[rr];
      float ls = fminf(lg, 0.f) - __logf(1.f + __expf(-fabsf(lg)));
      cum[c * 129 + d] = ls * (1.f / 16.f);
    }
  }
  vbar(smraw);
  if (tid < 128) {
    float cv[64];
#pragma unroll
    for (int i = 0; i < 64; ++i) cv[i] = cum[(dir ? 63 - i : i) * 129 + tid];
    float run = 0.f;
#pragma unroll
    for (int i = 0; i < 64; ++i) { run += cv[i]; cum[(dir ? 63 - i : i) * 129 + tid] = run; }
    last[tid] = run;
    ((float*)(R2 + R1_EL))[(size_t)item * 128 + tid] = __expf(run);
  }
  vbar(smraw);
  {
    bf16_t* qg = (bf16_t*)(R2 + R1_QG) + ((size_t)(bh * 2 + dir) * TPB + p0) * 128;
#pragma unroll
    for (int i = tid; i < 64 * 64; i += 256) {
      int c = i >> 6, d = (i & 63) * 2;
      unsigned uq = *(const unsigned*)(z + (size_t)c * LDZ1 + 3072 + h * 128 + d);
      unsigned uk = *(const unsigned*)(z + (size_t)c * LDZ1 + 3584 + h * 128 + d);
      float c0 = cum[c * 129 + d], c1 = cum[c * 129 + d + 1];
      unsigned oq = pk2(bflo(uq) * 0.08838834764831845f * __expf(c0), bfhi(uq) * 0.08838834764831845f * __expf(c1));
      unsigned ok = pk2(bflo(uk) * __expf(-c0), bfhi(uk) * __expf(-c1));
      *(unsigned*)(QS + c * 136 + d) = oq;
      *(unsigned*)(KS + c * 136 + d) = ok;
      *(unsigned*)(qg + (size_t)c * 128 + d) = oq;
    }
    {
      const int d = tid >> 1, half = tid & 1;
      const float ld = last[d];
      float y[32];
#pragma unroll
      for (int i = 0; i < 32; ++i) {
        int c = half * 32 + i;
        y[i] = bf2f(z[(size_t)c * LDZ1 + 3584 + h * 128 + d]) * __expf(ld - cum[c * 129 + d]);
      }
      vbar(smraw);
      put_T((bf16_t*)smraw, d, half, y);
      vbar(smraw);
      store_T(sw, (const bf16_t*)smraw, (bf16_t*)(R2 + R1_KGT) + ((size_t)(bh * 2 + dir) * 128) * TPS + p0);
    }
  }
  {
    const int it = wid, i = it * 16 + fr;
    bf16x8 bq[4];
#pragma unroll
    for (int s = 0; s < 4; ++s) bq[s] = *(const bf16x8*)(QS + i * 136 + s * 32 + fq * 8);
    bf16_t* am = (bf16_t*)(R2 + R1_AM) + (size_t)item * 4096;
#pragma unroll
    for (int jt = 0; jt < 4; ++jt) {
      f32x4 a = {0.f, 0.f, 0.f, 0.f};
#pragma unroll
      for (int s = 0; s < 4; ++s) a = mfma16(*(const bf16x8*)(KS + (jt * 16 + fr) * 136 + s * 32 + fq * 8), bq[s], a);
#pragma unroll
      for (int jj = 0; jj < 4; ++jj) {
        int j = jt * 16 + fq * 4 + jj;
        bool incl = dir ? (j >= i) : (j <= i);
        a[jj] = incl ? a[jj] : 0.f;
      }
      *(u32x2*)(am + i * 64 + jt * 16 + fq * 4) = pack4(a);
    }
  }
  if (dir == 0) {
    const bf16_t* src = z + 4096 + h * 256;
    bf16_t* dst = (bf16_t*)(R2 + R1_VTG) + ((size_t)bh * 256) * TPS + p0;
    transpose64x128(sw, src, LDZ1, dst, smraw);
    transpose64x128(sw, src + 128, LDZ1, dst + (size_t)128 * TPS, smraw);
  }
}
constexpr float LAM_INIT = 0.35550906759096927f;
DEVI void fin1(int sw, const P& p, int item) {
  const int lane = lane_id();
  const int r = item * 4 + (sw & 3);
  bf16_t* mix = (bf16_t*)(p.ws + OFF_MIX) + (size_t)r * LDH;
  const bf16_t* o = (const bf16_t*)(p.ws + OFF_H) + (size_t)r * LDH + lane * 2;
  const bf16_t* r0 = (const bf16_t*)(p.ws + OFF_R2 + R1_REC) + (size_t)r * 1024 + lane * 4;
  const bf16_t* zg = (const bf16_t*)(p.ws + OFF_Z) + (size_t)r * LDZ1 + 5120 + lane * 4;
  unsigned u1[8], u2[8];
  u32x2 a0[4], a1[4], ag[4];
#pragma unroll
  for (int h = 0; h < 8; ++h) { u1[h] = *(const unsigned*)(o + h * 256); u2[h] = *(const unsigned*)(o + h * 256 + 128); }
#pragma unroll
  for (int h = 0; h < 4; ++h) { a0[h] = *(const u32x2*)(r0 + h * 256); a1[h] = *(const u32x2*)(r0 + (size_t)NT * 1024 + h * 256); ag[h] = *(const u32x2*)(zg + h * 256); }
  float l01 = wave_sum(p.diff_lambda[lane] * p.diff_lambda[64 + lane]);
  float l23 = wave_sum(p.diff_lambda[128 + lane] * p.diff_lambda[192 + lane]);
  const float lam = __expf(l01) - __expf(l23) + LAM_INIT;
  const float s0 = p.diff_sub_norm[lane * 2], s1 = p.diff_sub_norm[lane * 2 + 1];
#pragma unroll
  for (int h = 0; h < 8; ++h) {
    float a = bflo(u1[h]) - lam * bflo(u2[h]), b = bfhi(u1[h]) - lam * bfhi(u2[h]);
    float ss = wave_sum(a * a + b * b);
    float rs = rsqrtf(ss * (1.f / 128.f) + EPS) * (1.f - LAM_INIT);
    *(unsigned*)(mix + h * 128 + lane * 2) = pk2(a * rs * s0, b * rs * s1);
  }
  const f32x4 gn = *(const f32x4*)(p.gla_out_norm + lane * 4);
#pragma unroll
  for (int h = 0; h < 4; ++h) {
    float v[4] = {bflo(a0[h][0]) + bflo(a1[h][0]), bfhi(a0[h][0]) + bfhi(a1[h][0]), bflo(a0[h][1]) + bflo(a1[h][1]), bfhi(a0[h][1]) + bfhi(a1[h][1])};
    float ss = wave_sum(v[0] * v[0] + v[1] * v[1] + v[2] * v[2] + v[3] * v[3]);
    float rs = rsqrtf(ss * (1.f / 256.f) + EPS);
    float g[4] = {bflo(ag[h][0]), bfhi(ag[h][0]), bflo(ag[h][1]), bfhi(ag[h][1])};
    f32x4 ov;
#pragma unroll
    for (int q = 0; q < 4; ++q) ov[q] = v[q] * rs * gn[q] * silu_f(g[q]);
    *(u32x2*)(mix + 1024 + h * 256 + lane * 4) = pack4(ov);
  }
}

DEVI int fetch_item(int sw, int* ctr, char* slot) {
  __syncthreads();
  if (sw == 0 && lane_id() == 0) *(volatile int*)slot = atomicAdd(ctr, 1);
  __syncthreads();
  return __builtin_amdgcn_readfirstlane(*(volatile int*)slot);
}
DEVI void gbar(int sw, unsigned* cnt, unsigned* gen, unsigned nblk, unsigned epoch) {
  __syncthreads();
  if (sw == 0 && lane_id() == 0) {
    __threadfence();
    const unsigned prev = __hip_atomic_fetch_add(cnt, 1u, __ATOMIC_RELAXED, __HIP_MEMORY_SCOPE_AGENT);
    if (prev == epoch * nblk - 1u) __hip_atomic_store(gen, epoch, __ATOMIC_RELAXED, __HIP_MEMORY_SCOPE_AGENT);
    else while (__hip_atomic_load(gen, __ATOMIC_RELAXED, __HIP_MEMORY_SCOPE_AGENT) < epoch) __builtin_amdgcn_s_sleep(2);
    __threadfence();
  }
  __syncthreads();
}
constexpr int SMEM_HALF = 75776;
constexpr int SMEM_BYTES = 2 * SMEM_HALF;
constexpr int NPHASE = 21;

__global__ void __launch_bounds__(512, 2) mega(P p, int ph0, int ph1) {
  __shared__ __attribute__((aligned(1024))) char smem_all[SMEM_BYTES];
  cg::grid_group grid = cg::this_grid();
#ifdef PH_LO
  ph0 = PH_LO; ph1 = PH_HI;
#endif
  const int sw = __builtin_amdgcn_readfirstlane(threadIdx.x >> 6);
  const int vb = sw >> 2;
  const int G = gridDim.x * 2, bid = blockIdx.x * 2 + vb;
  char* smem = smem_all + vb * SMEM_HALF;
  unsigned* gb_cnt = (unsigned*)(p.ws + OFF_CTR) + 256;
  unsigned* gb_gen = (unsigned*)(p.ws + OFF_CTR) + 320;
  unsigned epoch = 0;
  char* ws = p.ws;
  char* R2 = ws + OFF_R2;
  bf16_t* wmix = (bf16_t*)(ws + OFF_WMIX);
  bf16_t* Hb = (bf16_t*)(ws + OFF_H);
  bf16_t* MIXb = (bf16_t*)(ws + OFF_MIX);
  bf16_t* Zb = (bf16_t*)(ws + OFF_Z);
  const float* mod0 = (const float*)(ws + OFF_MOD);
  const float* mod1 = mod0 + 5 * MODN;

  if (ph0 <= 0 && 0 < ph1) {
    if (lane_id() == 0 && (sw & 3) == 0) *(volatile unsigned*)(smem + VB_CTR_OFF) = 0u;
    __syncthreads();
    {
        for (int it = bid; it < 192 + CVT_MIX0_ITEMS; it += G) {
          if (it < 192) ada_item(sw, p, it, (float*)smem);
          else cvt_mix0(sw, p, it - 192, (float*)smem);
        }
        if (blockIdx.x == 0 && sw == 0 && lane_id() < 16) ((int*)(ws + OFF_CTR))[lane_id()] = 0;
        if (blockIdx.x == 0 && sw == 0 && lane_id() < 2) ((unsigned*)(ws + OFF_CTR))[256 + 64 * lane_id()] = 0u;
      }
    if (0 + 1 < ph1) grid.sync();
  }
  if (ph0 <= 1 && 1 < ph1) {
    modulate_phase(sw, p, p.norm_mix_g, mod0, 0, 1, Hb, nullptr, nullptr, true);
    if (1 + 1 < ph1) gbar(sw, gb_cnt, gb_gen, gridDim.x, ++epoch);
  }
  if (ph0 <= 2 && 2 < ph1) {
    {
        EpiStore e{Zb, LDZ0, (float*)(R2 + R_GATES), 5184};
        gemm256_phase<0>(sw, wmix + WM_IN, LDW, Hb, LDH, D, AB_INP / 256, smem_all, e);
      }
    if (2 + 1 < ph1) gbar(sw, gb_cnt, gb_gen, gridDim.x, ++epoch);
  }
  if (ph0 <= 3 && 3 < ph1) {
    if (lane_id() == 0 && (sw & 3) == 0) *(volatile unsigned*)(smem + VB_CTR_OFF) = 0u;
    __syncthreads();
    {
        for (int it = bid; it < 8704 + 1088; it += G) {
          if (it < 8704) prep0_gdn(sw, p, (it & ~3) | ((it + (it >> 9)) & 3), (float*)smem);
          else prep0_norm512(sw, p, it - 8704);
        }
      }
    if (3 + 1 < ph1) gbar(sw, gb_cnt, gb_gen, gridDim.x, ++epoch);
  }
  if (ph0 <= 4 && 4 < ph1) {
    {
        EpiStore eq{(bf16_t*)(R2 + R_QUP), 1536, nullptr, 0};
        gemm256_phase<0>(sw, wmix + WM_UQ, LDW5, Hb, LDQA, 512, 6, smem_all, eq);
        EpiStore ek{MIXb, LDH, nullptr, 0};
        gemm256_phase<0>(sw, wmix + WM_UKV, LDW5, Hb + (size_t)NT * LDQA, LDQA, 512, 8, smem_all, ek);
      }
    if (4 + 1 < ph1) gbar(sw, gb_cnt, gb_gen, gridDim.x, ++epoch);
  }
  if (ph0 <= 5 && 5 < ph1) {
    if (lane_id() == 0 && (sw & 3) == 0) *(volatile unsigned*)(smem + VB_CTR_OFF) = 0u;
    __syncthreads();
    {
        const int nq = NT * 8 / 4 / 8;
        for (int it = bid; it < 4352 + 2176 + 2 * nq; it += G) {
          if (it < 4352) gdn_pre(sw, p, it, smem);
          else if (it < 4352 + 2176) {
            int t = it - 4352; int mc = t % NCH; int bh = t / NCH; int b = bh >> 3, h = bh & 7;
            transpose64x128(sw, MIXb + (size_t)(b * TPB + mc * 64) * LDH + h * 256 + 128, LDH,
                            (bf16_t*)(R2 + R_VT) + ((size_t)bh * 128) * TPS + mc * 64, smem);
          } else if (it < 4352 + 2176 + nq) prep0_q(sw, p, it - 4352 - 2176);
          else prep0_k(sw, p, it - 4352 - 2176 - nq);
        }
      }
    if (5 + 1 < ph1) gbar(sw, gb_cnt, gb_gen, gridDim.x, ++epoch);
  }
  if (ph0 <= 6 && 6 < ph1) {
    {
        int* ctr = (int*)(ws + OFF_CTR) + (ph0 == 6 ? 2 : 0);
        char* slot = smem_all + SMEM_BYTES - 16;
        while (true) {
          const int it = fetch_item(sw, ctr, slot);
          if (it >= 608) break;
          if (it < 64) scan_chain<true>(sw, p, 2 * it + vb, smem);
          else {
            int bh, prow, nkeys;
            if (it < 576) { const int t = it - 64; bh = t >> 4; prow = CTX + (t & 15) * 256; nkeys = TPB; }
            else { bh = it - 576; prow = 0; nkeys = CTX; }
            const int b = bh >> 3, h = bh & 7;
            const size_t r0 = (size_t)b * TPB + prow;
            float gq = 0.f, gk = 0.f;
            for (int i = lane_id(); i < 192; i += 64) { gq = fmaxf(gq, fabsf(p.mla_q_norm[i])); gk = fmaxf(gk, fabsf(p.mla_k_norm[i])); }
#pragma unroll
            for (int o2 = 32; o2 > 0; o2 >>= 1) { gq = fmaxf(gq, __shfl_xor(gq, o2)); gk = fmaxf(gk, __shfl_xor(gk, o2)); }
            const float negB = -(0.07216878364870322f * LOG2E * 192.f) * gq * gk;
            attn256_item<192>(sw, (const bf16_t*)(R2 + R_QUP) + r0 * 1536 + h * 192, 1536,
                              (const bf16_t*)(R2 + R_K) + (size_t)b * TPB * LDK + h * 192, LDK,
                              (const bf16_t*)(R2 + R_VT) + ((size_t)bh * 128) * TPS,
                              MIXb + r0 * LDH + h * 128, LDH, nkeys, negB, smem_all);
          }
        }
      }
    if (6 + 1 < ph1) gbar(sw, gb_cnt, gb_gen, gridDim.x, ++epoch);
  }
  if (ph0 <= 7 && 7 < ph1) {
    if (lane_id() == 0 && (sw & 3) == 0) *(volatile unsigned*)(smem + VB_CTR_OFF) = 0u;
    __syncthreads();
    {
        const int nf = NT * 8 / 4 / 8;
        for (int it = bid; it < CVT_FFN_ITEMS + nf; it += G) {
          if (it < CVT_FFN_ITEMS) cvt_ffn(sw, p, 0, it, (float*)smem);
          else fin0_rec(sw, p, it - CVT_FFN_ITEMS);
        }
      }
    if (7 + 1 < ph1) gbar(sw, gb_cnt, gb_gen, gridDim.x, ++epoch);
  }
  if (ph0 <= 8 && 8 < ph1) {
    {
        EpiResid e{p.out, (float*)(ws + OFF_CTXRES), mod0 + 2 * D, (float*)(R2 + R_PART)};
        gemm256_phase<2>(sw, wmix + WM_OUT, LDW, MIXb, LDH, D, 8, smem_all, e);
      }
    if (8 + 1 < ph1) gbar(sw, gb_cnt, gb_gen, gridDim.x, ++epoch);
  }
  if (ph0 <= 9 && 9 < ph1) {
    if (lane_id() == 0 && (sw & 3) == 0) *(volatile unsigned*)(smem + VB_CTR_OFF) = 0u;
    __syncthreads();
    {
        modulate_phase(sw, p, p.norm_ffn_g, mod0, 3, 4, Hb, (const float*)(R2 + R_PART), mod0 + 4 * MODN + 2 * D);
        for (int it = bid; it < CVT_MIX1_ITEMS; it += G) cvt_mix1(sw, p, it, (float*)smem);
      }
    if (9 + 1 < ph1) gbar(sw, gb_cnt, gb_gen, gridDim.x, ++epoch);
  }
  if (ph0 <= 10 && 10 < ph1) {
    {
        EpiSwiglu e{Zb};
        gemm256_phase<0>(sw, (const bf16_t*)(R2 + RF_GU), LDW, Hb, LDH, D, 44, smem_all, e);
      }
    if (10 + 1 < ph1) gbar(sw, gb_cnt, gb_gen, gridDim.x, ++epoch);
  }
  if (ph0 <= 11 && 11 < ph1) {
    {
        EpiResid e{p.out, (float*)(ws + OFF_CTXRES), mod0 + 5 * D, (float*)(R2 + R_PART)};
        gemm256_phase<2>(sw, (const bf16_t*)(R2 + RF_D), LDWF, Zb, LDG, FFN, 8, smem_all, e);
      }
    if (11 + 1 < ph1) gbar(sw, gb_cnt, gb_gen, gridDim.x, ++epoch);
  }
  if (ph0 <= 12 && 12 < ph1) {
    modulate_phase(sw, p, p.norm_mix_g + D, mod1, 0, 1, Hb, (const float*)(R2 + R_PART), mod0 + 4 * MODN + 5 * D);
    if (12 + 1 < ph1) gbar(sw, gb_cnt, gb_gen, gridDim.x, ++epoch);
  }
  if (ph0 <= 13 && 13 < ph1) {
    {
        EpiStore e{Zb, LDZ1, (float*)(R2 + R1_GATES), 6144};
        gemm256_phase<0>(sw, wmix + WM_IN, LDW, Hb, LDH, D, CD_INP / 256, smem_all, e);
      }
    if (13 + 1 < ph1) gbar(sw, gb_cnt, gb_gen, gridDim.x, ++epoch);
  }
  if (ph0 <= 14 && 14 < ph1) {
    if (lane_id() == 0 && (sw & 3) == 0) *(volatile unsigned*)(smem + VB_CTR_OFF) = 0u;
    __syncthreads();
    {
        const int nqk = NT * 2 / 4;
        for (int it = bid; it < 2176 + 2176 + nqk; it += G) {
          if (it < 2176) gla_pre(sw, p, it, smem);
          else if (it < 4352) {
            int t = it - 2176; int mc = t % NCH; int bh = t / NCH; int b = bh >> 3, h = bh & 7;
            transpose64x128(sw, Zb + (size_t)(b * TPB + mc * 64) * LDZ1 + 2048 + h * 128, LDZ1,
                            (bf16_t*)(R2 + R1_VT) + ((size_t)bh * 128) * TPS + mc * 64, smem);
          } else prep1_qk(sw, p, it - 4352);
        }
      }
    if (14 + 1 < ph1) gbar(sw, gb_cnt, gb_gen, gridDim.x, ++epoch);
  }
  if (ph0 <= 15 && 15 < ph1) {
    {
        int* ctr = (int*)(ws + OFF_CTR) + (ph0 == 15 ? 3 : 1);
        char* slot = smem_all + SMEM_BYTES - 16;
        while (true) {
          const int it = fetch_item(sw, ctr, slot);
          if (it >= 64 + 1024) break;
          if (it < 64) scan_chain<false>(sw, p, 2 * it + vb, smem);
          else {
            const int t = it - 64, qb = t & 15, bhm = t >> 4, b = bhm >> 4, hm = bhm & 15;
            const size_t r0 = (size_t)b * TPB + CTX + qb * 256;
            float gq = 0.f, gk = 0.f;
            for (int i = lane_id(); i < 128; i += 64) { gq = fmaxf(gq, fabsf(p.diff_q_norm[i])); gk = fmaxf(gk, fabsf(p.diff_k_norm[i])); }
#pragma unroll
            for (int o2 = 32; o2 > 0; o2 >>= 1) { gq = fmaxf(gq, __shfl_xor(gq, o2)); gk = fmaxf(gk, __shfl_xor(gk, o2)); }
            const float negB = -(0.125f * LOG2E * 64.f) * gq * gk;
            attn256_item<64>(sw, Zb + r0 * LDZ1 + hm * 64, LDZ1,
                             Zb + (size_t)b * TPB * LDZ1 + 1024 + hm * 64, LDZ1,
                             (const bf16_t*)(R2 + R1_VT) + ((size_t)(b * 8 + (hm >> 1)) * 128) * TPS,
                             Hb + r0 * LDH + hm * 128, LDH, TPB, negB, smem_all);
          }
        }
      }
    if (15 + 1 < ph1) gbar(sw, gb_cnt, gb_gen, gridDim.x, ++epoch);
  }
  if (ph0 <= 16 && 16 < ph1) {
    if (lane_id() == 0 && (sw & 3) == 0) *(volatile unsigned*)(smem + VB_CTR_OFF) = 0u;
    __syncthreads();
    {
        const int nf = NT / 4;
        for (int it = bid; it < CVT_FFN_ITEMS + nf; it += G) {
          if (it < CVT_FFN_ITEMS) cvt_ffn(sw, p, 1, it, (float*)smem);
          else fin1(sw, p, it - CVT_FFN_ITEMS);
        }
      }
    if (16 + 1 < ph1) gbar(sw, gb_cnt, gb_gen, gridDim.x, ++epoch);
  }
  if (ph0 <= 17 && 17 < ph1) {
    {
        EpiResid e{p.out, (float*)(ws + OFF_CTXRES), mod1 + 2 * D, nullptr};
        gemm256_phase<1>(sw, wmix + WM_OUT, LDW, MIXb, LDH, D, 8, smem_all, e);
      }
    if (17 + 1 < ph1) gbar(sw, gb_cnt, gb_gen, gridDim.x, ++epoch);
  }
  if (ph0 <= 18 && 18 < ph1) {
    modulate_phase(sw, p, p.norm_ffn_g + D, mod1, 3, 4, Hb);
    if (18 + 1 < ph1) gbar(sw, gb_cnt, gb_gen, gridDim.x, ++epoch);
  }
  if (ph0 <= 19 && 19 < ph1) {
    {
        EpiSwiglu e{Zb};
        gemm256_phase<1>(sw, (const bf16_t*)(R2 + RF_GU), LDW, Hb, LDH, D, 44, smem_all, e);
      }
    if (19 + 1 < ph1) gbar(sw, gb_cnt, gb_gen, gridDim.x, ++epoch);
  }
  if (ph0 <= 20 && 20 < ph1) {
    {
        EpiResid e{p.out, (float*)(ws + OFF_CTXRES), mod1 + 5 * D, nullptr};
        gemm256_phase<1>(sw, (const bf16_t*)(R2 + RF_D), LDWF, Zb, LDG, FFN, 8, smem_all, e);
      }
  }
  if (ph0 <= 21 && 21 < ph1) { for (int it = bid; it < 128; it += G) scan_chain<true>(sw, p, it, smem); }
  if (ph0 <= 23 && 23 < ph1) { for (int it = bid; it < 128; it += G) scan_chain<false>(sw, p, it, smem); }
}

extern "C" void kernel_launch(void* const* d_in, const int* in_sizes, int n_in, void* d_out, int out_size, void* d_ws, size_t ws_size, hipStream_t stream) {
  static int grid_blocks = 0;
  if (!grid_blocks) {
    int dev = 0, cus = 0, per_cu = 0;
    hipGetDevice(&dev);
    hipDeviceGetAttribute(&cus, hipDeviceAttributeMultiprocessorCount, dev);
    hipOccupancyMaxActiveBlocksPerMultiprocessor(&per_cu, mega, 512, 0);
    if (per_cu > 1) per_cu = 1;
    if (per_cu < 1) per_cu = 1;
    grid_blocks = cus * per_cu;
    grid_blocks -= grid_blocks % 8;
  }
  if (ws_size < WS_NEED) { fprintf(stderr, "workspace too small: %zu < %zu\n", ws_size, (size_t)WS_NEED); return; }
  P p{};
  const float** pp = (const float**)&p;
  for (int i = 0; i < 32; ++i) pp[i] = (const float*)d_in[i];
  p.out = (float*)d_out;
  p.ws = (char*)d_ws;
#ifndef PROBE_PHASE
  int ph0 = 0, ph1 = NPHASE;
  void* args[] = {&p, &ph0, &ph1};
  hipError_t e = hipLaunchCooperativeKernel((void*)mega, dim3(grid_blocks), dim3(512), args, 0, stream);
  if (e != hipSuccess) fprintf(stderr, "cooperative launch failed: %s (grid %d)\n", hipGetErrorString(e), grid_blocks);
#else
  int segs[3][2] = {{0, PROBE_AFTER + 1}, {PROBE_PHASE, PROBE_PHASE + 1}, {PROBE_AFTER + 1, NPHASE}};
  for (int s = 0; s < 3; ++s) {
    void* args[] = {&p, &segs[s][0], &segs[s][1]};
    hipError_t e = hipLaunchCooperativeKernel((void*)mega, dim3(grid_blocks), dim3(512), args, 0, stream);
    if (e != hipSuccess) fprintf(stderr, "cooperative launch failed: %s (grid %d)\n", hipGetErrorString(e), grid_blocks);
  }
#endif
}
```

```cpp
#include <hip/hip_runtime.h>
#include <hip/hip_cooperative_groups.h>
#include <cstdio>
#include <cstdint>
namespace cg = cooperative_groups;

#define DEVI __device__ __forceinline__
typedef unsigned short bf16_t;
typedef short bf16x8 __attribute__((ext_vector_type(8)));
typedef short bf16x4 __attribute__((ext_vector_type(4)));
typedef float f32x4 __attribute__((ext_vector_type(4)));
typedef float f32x2 __attribute__((ext_vector_type(2)));
typedef unsigned u32x4 __attribute__((ext_vector_type(4)));
typedef unsigned u32x2 __attribute__((ext_vector_type(2)));
typedef __bf16 bfv2 __attribute__((ext_vector_type(2)));

constexpr int D = 2048, NB = 4, SEQ = 4096, CTX = 256, TPB = SEQ + CTX  , NT = NB * TPB  ;
constexpr int NCH = TPB / 64;
constexpr int FFN = 5632;
constexpr int AB_IN = 5216, AB_INP = 5376, CD_IN = 6176, CD_INP = 6400;
constexpr int MODN = 6 * D;
constexpr int LDH = 2112, LDZ0 = 5440, LDZ1 = 6464, LDG = 5696, LDW = 2112, LDW5 = 576, LDWF = 5696, LDK = 1600, LDQA = 576, TPS = 4416;
constexpr float EPS = 1e-6f;
constexpr float LOG2E = 1.4426950408889634f;

constexpr size_t OFF_CTR = 0;
constexpr size_t OFF_MOD = 4096;
constexpr size_t OFF_CTXRES = OFF_MOD + (size_t)2 * 5 * MODN * 4;
constexpr size_t OFF_WMIX = OFF_CTXRES + (size_t)NB * CTX * D * 4;
constexpr size_t OFF_H = OFF_WMIX + (size_t)41943040;
constexpr size_t OFF_MIX = OFF_H + (size_t)NT * LDH * 2;
constexpr size_t OFF_Z = OFF_MIX + (size_t)NT * LDH * 2;
constexpr size_t OFF_R2 = OFF_Z + (size_t)NT * LDZ1 * 2;
constexpr size_t SZ_T = (size_t)4096 * TPS * 2;
constexpr size_t SZ_TOK1024 = (size_t)NT * 1024 * 2;
constexpr size_t WM_IN = 0;
constexpr size_t WM_OUT = (size_t)CD_INP * LDW;
constexpr size_t WM_UQ = WM_OUT + (size_t)D * LDW;
constexpr size_t WM_UKV = WM_UQ + (size_t)1536 * LDW5;
static_assert((WM_UKV + (size_t)2048 * LDW5) * 2 <= 41943040, "wmix");
constexpr size_t R_QUP = 0;
constexpr size_t R_K = R_QUP + (size_t)NT * 1536 * 2;
constexpr size_t R_VT = R_K + (size_t)NT * LDK * 2;
constexpr size_t R_GQ = R_VT + SZ_T;
constexpr size_t R_GK = R_GQ + SZ_TOK1024;
constexpr size_t R_GKT = R_GK + SZ_TOK1024;
constexpr size_t R_GVT = R_GKT + SZ_T;
constexpr size_t R_TM = R_GVT + SZ_T;
constexpr size_t R_QKM = R_TM + SZ_TOK1024;
constexpr size_t R_GC = R_QKM + SZ_TOK1024;
constexpr size_t R_BETA = R_GC + (size_t)NT * 16 * 4;
constexpr size_t R_GATES = R_BETA + (size_t)NT * 16 * 4;
constexpr size_t R_END0 = R_GATES + (size_t)NT * 32 * 4;
constexpr size_t R1_VT = 0;
constexpr size_t R1_QG = R1_VT + SZ_T;
constexpr size_t R1_KGT = R1_QG + SZ_TOK1024;
constexpr size_t R1_VTG = R1_KGT + SZ_T;
constexpr size_t R1_AM = R1_VTG + SZ_T;
constexpr size_t R1_EL = R1_AM + (size_t)2176 * 4096 * 2;
constexpr size_t R1_GATES = R1_EL + (size_t)2176 * 128 * 4;
constexpr size_t R1_REC = R1_GATES + (size_t)NT * 32 * 4;
constexpr size_t R1_END = R1_REC + 2 * SZ_TOK1024;
constexpr size_t RF_GU = 0;
constexpr size_t RF_D = RF_GU + (size_t)2 * FFN * LDW * 2;
static_assert(RF_D + (size_t)D * LDWF * 2 <= R1_KGT, "ffn overlay L1");
static_assert(RF_D + (size_t)D * LDWF * 2 <= R_VT, "ffn overlay L0");
static_assert(NT * (size_t)LDG * 2 <= NT * (size_t)LDZ1 * 2, "G fits Z");
constexpr size_t R_PART = (size_t)128 << 20;
constexpr size_t WS_NEED = OFF_R2 + (R_END0 > R1_END ? R_END0 : R1_END);
static_assert(WS_NEED <= (size_t)805306368, "ws");

struct P {
  const float *x, *c, *ctx, *c_ctx, *ada_w, *ada_b, *norm_mix_g, *norm_ffn_g, *ffn_w_gate, *ffn_w_up, *ffn_w_down;
  const float *ab_w_in, *mla_q_a_norm, *mla_w_uq, *mla_kv_a_norm, *mla_w_ukv, *mla_q_norm, *mla_k_norm;
  const float *gdn_conv_w, *gdn_a_log, *gdn_dt_bias, *gdn_out_norm, *ab_w_out;
  const float *cd_w_in, *diff_q_norm, *diff_k_norm, *diff_lambda, *diff_sub_norm, *gla_gate_w2, *gla_gate_b2, *gla_out_norm, *cd_w_out;
  float* out;
  char* ws;
};

DEVI unsigned pk2(float lo, float hi) { f32x2 v = {lo, hi}; bfv2 b = __builtin_convertvector(v, bfv2); return __builtin_bit_cast(unsigned, b); }
DEVI float bflo(unsigned u) { return __uint_as_float(u << 16); }
DEVI float bfhi(unsigned u) { return __uint_as_float(u & 0xffff0000u); }
DEVI float bf2f(bf16_t h) { return __uint_as_float(((unsigned)h) << 16); }
DEVI bf16_t f2bf(float f) { return (bf16_t)(pk2(f, 0.f) & 0xffffu); }
DEVI f32x4 mfma16(bf16x8 a, bf16x8 b, f32x4 c) { return __builtin_amdgcn_mfma_f32_16x16x32_bf16(a, b, c, 0, 0, 0); }
DEVI bf16x8 pack8(f32x4 a, f32x4 b) { u32x4 u = {pk2(a[0], a[1]), pk2(a[2], a[3]), pk2(b[0], b[1]), pk2(b[2], b[3])}; return __builtin_bit_cast(bf16x8, u); }
DEVI u32x2 pack4(f32x4 a) { u32x2 u = {pk2(a[0], a[1]), pk2(a[2], a[3])}; return u; }
DEVI bf16x8 cat8(u32x2 lo, u32x2 hi) { u32x4 u = {lo[0], lo[1], hi[0], hi[1]}; return __builtin_bit_cast(bf16x8, u); }
DEVI float wave_sum(float v) {
#pragma unroll
  for (int o = 32; o > 0; o >>= 1) v += __shfl_xor(v, o);
  return v;
}
DEVI float silu_f(float v) { return v * __builtin_amdgcn_rcpf(1.f + __expf(-v)); }
DEVI float* xrow(const P& p, int r) {
  int b = r / TPB, q = r - b * TPB;
  return q < CTX ? (float*)(p.ws + OFF_CTXRES) + (size_t)(b * CTX + q) * D : p.out + (size_t)(b * SEQ + q - CTX) * D;
}
DEVI int modidx(int r) { int b = r / TPB; return (r - b * TPB) < CTX ? 4 : b; }
DEVI bf16x8 ldsperm(const bf16_t* base, int row, int stride, int ks, int fq) {
  const bf16_t* p = base + row * stride + ks * 32 + fq * 4;
  u32x2 lo = *(const u32x2*)p, hi = *(const u32x2*)(p + 16);
  return cat8(lo, hi);
}

DEVI int lane_id() { int l; asm volatile("v_mbcnt_lo_u32_b32 %0, -1, 0\n\tv_mbcnt_hi_u32_b32 %0, -1, %0" : "=v"(l)); return l; }
#define VT ((((sw) & 3) << 6) | lane_id())
constexpr int VB_CTR_OFF = 75776 - 32;
DEVI void vbar(const void* vbase) {
  typedef __attribute__((address_space(3))) unsigned lds_u32;
  lds_u32* ctr = (lds_u32*)(size_t)(unsigned)(size_t)(__attribute__((address_space(3))) const char*)((const char*)vbase + VB_CTR_OFF);
  __builtin_amdgcn_fence(__ATOMIC_RELEASE, "workgroup");
  asm volatile("s_waitcnt vmcnt(0) lgkmcnt(0)" ::: "memory");
  unsigned old = 0;
  if (lane_id() == 0) old = __hip_atomic_fetch_add(ctr, 1u, __ATOMIC_RELAXED, __HIP_MEMORY_SCOPE_WORKGROUP);
  const unsigned gen = (unsigned)__builtin_amdgcn_readfirstlane((int)old) >> 2;
  while ((__hip_atomic_load(ctr, __ATOMIC_RELAXED, __HIP_MEMORY_SCOPE_WORKGROUP) >> 2) == gen) __builtin_amdgcn_s_sleep(1);
  __builtin_amdgcn_fence(__ATOMIC_ACQUIRE, "workgroup");
  asm volatile("" ::: "memory");
}
struct EpiStore {
  bf16_t* C; int ldc; float* side; int side_c0;
  DEVI void operator()(const f32x4 (&acc)[8][4], int nb, int mb, int fr, int fq, int pk) const {
#pragma unroll
    for (int ni = 0; ni < 4; ++ni) {
      const int m = mb + ni * 16 + fr;
#pragma unroll
      for (int mi = 0; mi < 8; ++mi) {
        const int n = nb + mi * 16 + fq * 4;
        *(u32x2*)(C + (size_t)m * ldc + n) = pack4(acc[mi][ni]);
        if (side && n >= side_c0 && n < side_c0 + 32) *(f32x4*)(side + (size_t)m * 32 + (n - side_c0)) = acc[mi][ni];
      }
      asm volatile("" ::: "memory");
    }
  }
};
struct EpiResid {
  float* out; float* ctxres; const float* gate; float* part;
  DEVI void operator()(const f32x4 (&acc)[8][4], int nb, int mb, int fr, int fq, int pk) const {
#pragma unroll
    for (int ni = 0; ni < 4; ++ni) {
      const int m = mb + ni * 16 + fr;
      int bb = m / TPB, qq = m - bb * TPB;
      float* xr = qq < CTX ? ctxres + (size_t)(bb * CTX + qq) * D : out + (size_t)(bb * SEQ + qq - CTX) * D;
      const float* g = gate + (size_t)(qq < CTX ? 4 : bb) * MODN;
#pragma unroll
      for (int mi = 0; mi < 8; ++mi) {
        const int n = nb + mi * 16 + fq * 4;
        const f32x4 gv = *(const f32x4*)(g + n);
        if (pk >= 0) {
          *(f32x4*)(part + ((size_t)(pk * (NB * CTX) + bb * CTX + qq)) * D + n) = acc[mi][ni];
        } else {
          f32x4 xv = *(f32x4*)(xr + n);
          xv += gv * acc[mi][ni];
          *(f32x4*)(xr + n) = xv;
        }
        if ((mi & 1) == 1) asm volatile("" ::: "memory");
      }
    }
  }
};
struct EpiProbe {
  float* dump; int flag;
  DEVI void operator()(const f32x4 (&acc)[8][4], int nb, int mb, int fr, int fq, int pk) const {
    if (flag) {
#pragma unroll
      for (int mi = 0; mi < 8; ++mi)
#pragma unroll
        for (int ni = 0; ni < 4; ++ni) *(f32x4*)(dump + (size_t)(mi * 4 + ni) * 4096 + (fr * 4 + fq) * 4) = acc[mi][ni];
    }
  }
};
struct EpiSwiglu {
  bf16_t* G;
  DEVI void operator()(const f32x4 (&acc)[8][4], int nb, int mb, int fr, int fq, int pk) const {
#pragma unroll
    for (int ni = 0; ni < 4; ++ni) {
      const int m = mb + ni * 16 + fr;
#pragma unroll
      for (int mi = 0; mi < 8; mi += 2) {
        const int R = nb + mi * 16;
        const int hc = (R >> 5) * 16 + fq * 4;
        f32x4 g = acc[mi][ni], u = acc[mi + 1][ni], o;
#pragma unroll
        for (int j = 0; j < 4; ++j) o[j] = silu_f(g[j]) * u[j];
        *(u32x2*)(G + (size_t)m * LDG + hc) = pack4(o);
      }
    }
  }
};
DEVI int lds_byte2(int r, int c) { int st = (r >> 4) * 2 + (c >> 5), ob = (r & 15) * 64 + (c & 31) * 2; return st * 1024 + (ob ^ (((ob >> 9) & 1) << 5)); }
DEVI void stage_rc2(int b, int& R, int& C) { int st = b >> 10, sb = b & 1023, swz = sb ^ (((sb >> 9) & 1) << 5); R = (st >> 1) * 16 + swz / 64; C = (st & 1) * 32 + (swz % 64) / 2; }

template <int MODE, class Epi>
DEVI void gemm256_phase(int sw, const bf16_t* __restrict__ W, int ldw, const bf16_t* __restrict__ X, int ldx, int K, int nN, char* shm, const Epi& epi) {
  constexpr int TILE_B = 256 * 64 * 2, STAGE_B = 2 * TILE_B;
  const int wid = sw, lane = lane_id(), wr = wid >> 2, wc = wid & 3, fr = lane & 15, fq = lane >> 4;
  const int lds_lo = (fr * 64 + fq * 16) ^ ((fr >> 3) << 5);
  unsigned offW[4], offX[4];
#pragma unroll
  for (int i = 0; i < 4; ++i) { int R, C; stage_rc2(wid * 1024 + i * 8192 + lane * 16, R, C); offW[i] = (unsigned)(R * ldw + C) * 2u; offX[i] = (unsigned)(R * ldx + C) * 2u; }
  const int ntf = K >> 6;
  const int nM = (MODE == 0 || MODE == 3) ? 68 : 64, nfull = nM * nN, nunits = MODE == 2 ? nfull + 256 : nfull;
  auto decode = [&](int L, int& n0, int& m0, int& kt0, int& ntk) {
    if (MODE == 2 && L >= nfull) {
      const int j = L - nfull, tile = j >> 3, ks = j & 7;
      n0 = (tile & 7) * 256; m0 = (tile >> 3) * 17 * 256; ntk = ntf >> 3; kt0 = ks * ntk;
    } else {
      int wgid = L;
      { const int q = nfull / 8, r = nfull % 8, xcd = wgid % 8, off = wgid / 8; wgid = (xcd < r ? xcd * (q + 1) : r * (q + 1) + (xcd - r) * q) + off; }
      constexpr int WGM = 4;
      const int nig = WGM * nN, gid = wgid / nig, fm = gid * WGM, gsz = (nM - fm) < WGM ? (nM - fm) : WGM;
      const int pm = fm + ((wgid % nig) % gsz), pn = (wgid % nig) / gsz;
      n0 = pn * 256; m0 = (MODE == 0 ? pm : (pm / 16) * 17 + 1 + (pm % 16)) * 256; kt0 = 0; ntk = ntf;
    }
    if (MODE == 3) { n0 = 0; m0 = 0; }
    n0 = __builtin_amdgcn_readfirstlane(n0); m0 = __builtin_amdgcn_readfirstlane(m0);
    kt0 = __builtin_amdgcn_readfirstlane(kt0); ntk = __builtin_amdgcn_readfirstlane(ntk);
  };
  auto stage = [&](int buf, int n0, int m0, int kt) {
    const char* wk = (const char*)(W + (size_t)n0 * ldw) + kt * 128;
    const char* xk = (const char*)(X + (size_t)m0 * ldx) + kt * 128;
#pragma unroll
    for (int i = 0; i < 4; ++i) {
      unsigned ow = offW[i], ox = offX[i];
      asm volatile("" : "+v"(ow), "+v"(ox));
      __builtin_amdgcn_global_load_lds((const unsigned*)(wk + ow), (unsigned*)(shm + buf * STAGE_B + wid * 1024 + i * 8192), 16, 0, 0);
      __builtin_amdgcn_global_load_lds((const unsigned*)(xk + ox), (unsigned*)(shm + buf * STAGE_B + TILE_B + wid * 1024 + i * 8192), 16, 0, 0);
    }
  };
  int L = blockIdx.x;
  if (L >= nunits) return;
  int n0, m0, kt0, ntk;
  decode(L, n0, m0, kt0, ntk);
  int b0 = 0;
  stage(0, n0, m0, kt0);
  asm volatile("s_waitcnt vmcnt(0)" ::: "memory");
  __syncthreads();
  while (true) {
    const int Ln = L + gridDim.x;
    const bool has_next = Ln < nunits;
    int n1 = 0, m1 = 0, kt1 = 0, ntk1 = 0;
    if (has_next) decode(Ln, n1, m1, kt1, ntk1);
    f32x4 acc[8][4];
#pragma unroll
    for (int i = 0; i < 8; ++i)
#pragma unroll
      for (int j = 0; j < 4; ++j) acc[i][j] = (f32x4){0.f, 0.f, 0.f, 0.f};
    for (int t = 0; t < ntk; ++t) {
      const int cur = (b0 + t) & 1;
      const bool st_own = t + 1 < ntk, st_next = !st_own && has_next;
      if (wid < 4) {
        if (st_own) stage(cur ^ 1, n0, m0, kt0 + t + 1);
        else if (st_next) stage(cur ^ 1, n1, m1, kt1);
      }
      const char* SAp = shm + cur * STAGE_B + wr * (16 * 1024) + lds_lo;
      const char* SBp = shm + cur * STAGE_B + TILE_B + wc * (8 * 1024) + lds_lo;
#pragma unroll
      for (int ks = 0; ks < 2; ++ks) {
        const int kx = (wid >> 2) ? (1 - 2 * ks) * 1024 : 0;
        bf16x8 At[8], Bf[4];
#pragma unroll
        for (int m = 0; m < 8; ++m) At[m] = *(const bf16x8*)(SAp + (2 * m + ks) * 1024 + kx);
#pragma unroll
        for (int n = 0; n < 4; ++n) Bf[n] = *(const bf16x8*)(SBp + (2 * n + ks) * 1024 + kx);
#pragma unroll
        for (int m = 0; m < 8; ++m)
#pragma unroll
          for (int n = 0; n < 4; ++n) acc[m][n] = mfma16(At[m], Bf[n], acc[m][n]);
        __builtin_amdgcn_sched_barrier(0);
        if (ks == 0 && wid >= 4) {
          if (st_own) stage(cur ^ 1, n0, m0, kt0 + t + 1);
          else if (st_next) stage(cur ^ 1, n1, m1, kt1);
        }
      }
      asm volatile("s_waitcnt vmcnt(0)" ::: "memory");
      __syncthreads();
    }
    epi(acc, n0 + wr * 128, m0 + wc * 64, fr, fq, (MODE == 2 && L >= nfull) ? ((L - nfull) & 7) : -1);
    if (!has_next) break;
    b0 = (b0 + ntk) & 1; L = Ln; n0 = n1; m0 = m1; kt0 = kt1; ntk = ntk1;
  }
}

DEVI void cvt_tile(int sw, const float* __restrict__ src, int ldn, int Nvalid, bf16_t* __restrict__ dst, int ldk, int kt, int nt, int rmul, int roff, float* sm) {
  const int tid = VT;
  const int k0 = kt * 64, n0 = nt * 64;
  vbar(sm);
  {
    const int n4 = (tid & 15) * 4, n = n0 + n4;
    f32x4 v[4];
#pragma unroll
    for (int i = 0; i < 4; ++i) {
      const int kk = (tid >> 4) + 16 * i;
      v[i] = (n < Nvalid) ? *(const f32x4*)(src + (size_t)(k0 + kk) * ldn + n) : (f32x4){0.f, 0.f, 0.f, 0.f};
    }
#pragma unroll
    for (int i = 0; i < 4; ++i) {
      const int kk = (tid >> 4) + 16 * i;
#pragma unroll
      for (int jj = 0; jj < 4; ++jj) sm[(n4 + jj) * 65 + kk] = v[i][jj];
    }
  }
  vbar(sm);
  {
    int nn = tid >> 2, kq = tid & 3, n = n0 + nn;
    int drow = (n >> 4) * rmul + roff + (n & 15);
    const float* s = sm + nn * 65 + kq * 16;
    u32x4 a = {pk2(s[0], s[1]), pk2(s[2], s[3]), pk2(s[4], s[5]), pk2(s[6], s[7])};
    u32x4 b = {pk2(s[8], s[9]), pk2(s[10], s[11]), pk2(s[12], s[13]), pk2(s[14], s[15])};
    bf16_t* d = dst + (size_t)drow * ldk + k0 + kq * 16;
    *(u32x4*)d = a; *(u32x4*)(d + 8) = b;
  }
}
DEVI bool cvt_try(int sw, int& idx, const float* src, int N, int Npad, bf16_t* dst, int K, int ldk, int rmul, int roff, float* sm) {
  int kts = K >> 6, n = kts * (Npad >> 6);
  if (idx < n) { cvt_tile(sw, src, N, N, dst, ldk, idx % kts, idx / kts, rmul, roff, sm); return true; }
  idx -= n; return false;
}
DEVI void cvt_ffn(int sw, const P& p, int layer, int idx, float* sm) {
  bf16_t* gu = (bf16_t*)(p.ws + OFF_R2 + RF_GU); bf16_t* dn = (bf16_t*)(p.ws + OFF_R2 + RF_D);
  if (cvt_try(sw, idx, p.ffn_w_gate + (size_t)layer * D * FFN, FFN, FFN, gu, D, LDW, 32, 0, sm)) return;
  if (cvt_try(sw, idx, p.ffn_w_up + (size_t)layer * D * FFN, FFN, FFN, gu, D, LDW, 32, 16, sm)) return;
  cvt_try(sw, idx, p.ffn_w_down + (size_t)layer * FFN * D, D, D, dn, FFN, LDWF, 16, 0, sm);
}
constexpr int CVT_FFN_ITEMS = 3 * (D / 64) * (FFN / 64);
constexpr int CVT_MIX0_ITEMS = 32 * 84 + 8 * 24 + 8 * 32 + 32 * 32;
constexpr int CVT_MIX1_ITEMS = 32 * 100 + 32 * 32;
DEVI void cvt_mix0(int sw, const P& p, int idx, float* sm) {
  bf16_t* w = (bf16_t*)(p.ws + OFF_WMIX);
  if (cvt_try(sw, idx, p.ab_w_in, AB_IN, AB_INP, w + WM_IN, D, LDW, 16, 0, sm)) return;
  if (cvt_try(sw, idx, p.mla_w_uq, 1536, 1536, w + WM_UQ, 512, LDW5, 16, 0, sm)) return;
  if (cvt_try(sw, idx, p.mla_w_ukv, 2048, 2048, w + WM_UKV, 512, LDW5, 16, 0, sm)) return;
  cvt_try(sw, idx, p.ab_w_out, D, D, w + WM_OUT, D, LDW, 16, 0, sm);
}
DEVI void cvt_mix1(int sw, const P& p, int idx, float* sm) {
  bf16_t* w = (bf16_t*)(p.ws + OFF_WMIX);
  if (cvt_try(sw, idx, p.cd_w_in, CD_IN, CD_INP, w + WM_IN, D, LDW, 16, 0, sm)) return;
  cvt_try(sw, idx, p.cd_w_out, D, D, w + WM_OUT, D, LDW, 16, 0, sm);
}

DEVI void ada_item(int sw, const P& p, int item, float* sm) {
  const int tid = VT;
  const int l = item / 96, cb = item % 96;
  float* sc = sm;
  float* red = sm + 5 * 2048;
  vbar(sm);
  for (int i = tid; i < 5 * 2048; i += 256) {
    int s5 = i >> 11, k = i & 2047;
    float v = s5 < 4 ? p.c[s5 * D + k] : p.c_ctx[k];
    sc[i] = silu_f(v);
  }
  vbar(sm);
  const int ct = tid & 31, kg = tid >> 5;
  const float* w = p.ada_w + ((size_t)l * D + kg * 256) * MODN + cb * 128 + ct * 4;
  f32x4 a0 = {0.f, 0.f, 0.f, 0.f}, a1 = a0, a2 = a0, a3 = a0, a4 = a0;
#pragma unroll 16
  for (int k = 0; k < 256; ++k) {
    const f32x4 wv = *(const f32x4*)(w + (size_t)k * MODN);
    const int kk = kg * 256 + k;
    a0 += sc[kk] * wv; a1 += sc[2048 + kk] * wv; a2 += sc[4096 + kk] * wv; a3 += sc[6144 + kk] * wv; a4 += sc[8192 + kk] * wv;
  }
  *(f32x4*)(red + (kg * 5 + 0) * 128 + ct * 4) = a0; *(f32x4*)(red + (kg * 5 + 1) * 128 + ct * 4) = a1; *(f32x4*)(red + (kg * 5 + 2) * 128 + ct * 4) = a2;
  *(f32x4*)(red + (kg * 5 + 3) * 128 + ct * 4) = a3; *(f32x4*)(red + (kg * 5 + 4) * 128 + ct * 4) = a4;
  vbar(sm);
  for (int i = tid; i < 5 * 128; i += 256) {
    int s5 = i >> 7, cc = i & 127;
    float v = 0.f;
#pragma unroll
    for (int g = 0; g < 8; ++g) v += red[(g * 5 + s5) * 128 + cc];
    int n = cb * 128 + cc;
    ((float*)(p.ws + OFF_MOD))[((size_t)l * 5 + s5) * MODN + n] = v + p.ada_b[(size_t)l * MODN + n];
  }
}

DEVI void modulate_phase(int sw, const P& p, const float* g, const float* modl, int shift_i, int scale_i, bf16_t* H, const float* part = nullptr, const float* gate_ctx = nullptr, bool from_input = false) {
  const int lane = VT & 63;
  const int gw = (blockIdx.x * 2 + (sw >> 2)) * 4 + (sw & 3), nw = gridDim.x * 8;
  for (int r = gw; r < NT; r += nw) {
    const float* xr = xrow(p, r);
    if (from_input) { const int bb = r / TPB, qq = r - bb * TPB; xr = qq < CTX ? p.ctx + (size_t)(bb * CTX + qq) * D : p.x + (size_t)(bb * SEQ + qq - CTX) * D; }
    const float* mb = modl + (size_t)modidx(r) * MODN;
    f32x4 v[8]; float ss = 0.f;
#pragma unroll
    for (int i = 0; i < 8; ++i) v[i] = *(const f32x4*)(xr + i * 256 + lane * 4);
    if (part && modidx(r) == 4) {
      const int cr = (r / TPB) * CTX + (r % TPB);
#pragma unroll
      for (int i = 0; i < 8; ++i) {
        f32x4 sacc = {0.f, 0.f, 0.f, 0.f};
#pragma unroll
        for (int ks = 0; ks < 8; ++ks) sacc += *(const f32x4*)(part + ((size_t)(ks * (NB * CTX) + cr)) * D + i * 256 + lane * 4);
        v[i] += *(const f32x4*)(gate_ctx + i * 256 + lane * 4) * sacc;
        *(f32x4*)(xrow(p, r) + i * 256 + lane * 4) = v[i];
      }
    }
    if (from_input) {
      float* xw = xrow(p, r);
#pragma unroll
      for (int i = 0; i < 8; ++i) *(f32x4*)(xw + i * 256 + lane * 4) = v[i];
    }
#pragma unroll
    for (int i = 0; i < 8; ++i) ss += v[i][0] * v[i][0] + v[i][1] * v[i][1] + v[i][2] * v[i][2] + v[i][3] * v[i][3];
    ss = wave_sum(ss);
    float rs = rsqrtf(ss * (1.f / D) + EPS);
#pragma unroll
    for (int i = 0; i < 8; ++i) {
      int cidx = i * 256 + lane * 4;
      f32x4 gg = *(const f32x4*)(g + cidx), sh = *(const f32x4*)(mb + shift_i * D + cidx), sc = *(const f32x4*)(mb + scale_i * D + cidx);
      f32x4 y;
#pragma unroll
      for (int j = 0; j < 4; ++j) y[j] = v[i][j] * rs * gg[j] * (1.f + sc[j]) + sh[j];
      *(u32x2*)(H + (size_t)r * LDH + cidx) = pack4(y);
    }
  }
}

template <int DQK>
DEVI void attn256_item(int sw, const bf16_t* __restrict__ Q, int ldq, const bf16_t* __restrict__ Kp, int ldk, const bf16_t* __restrict__ Vt,
                       bf16_t* __restrict__ O, int ldo, int nkeys, float negB, char* shm) {
  constexpr int KS = DQK / 32, KCH = DQK / 8, KBYTES = 64 * DQK * 2, STG = KBYTES + 16384, NKI = (64 * KCH) / 512;
  const int wid = sw, lane = lane_id(), fr = lane & 15, fq = lane >> 4, rsw = (fr >> 1) & 7;
  unsigned offK[NKI], offV[2];
#pragma unroll
  for (int i = 0; i < NKI; ++i) {
    const int q = (wid * NKI + i) * 64 + lane, row = q / KCH, cp = q - row * KCH;
    const int c = (cp & ~7) | ((cp & 7) ^ ((row >> 1) & 7));
    offK[i] = (unsigned)(row * ldk + c * 8) * 2u;
  }
#pragma unroll
  for (int i = 0; i < 2; ++i) {
    const int q = (wid * 2 + i) * 64 + lane, row = q >> 3, cp = q & 7;
    const int c = cp ^ ((row >> 1) & 7);
    offV[i] = (unsigned)(row * TPS + c * 8) * 2u;
  }
  auto stage = [&](int buf, int k0) {
    const char* kb = (const char*)(Kp + (size_t)k0 * ldk);
    const char* vb = (const char*)(Vt + k0);
#pragma unroll
    for (int i = 0; i < NKI; ++i) {
      unsigned o = offK[i]; asm volatile("" : "+v"(o));
      __builtin_amdgcn_global_load_lds((const unsigned*)(kb + o), (unsigned*)(shm + buf * STG + (wid * NKI + i) * 1024), 16, 0, 0);
    }
#pragma unroll
    for (int i = 0; i < 2; ++i) {
      unsigned o = offV[i]; asm volatile("" : "+v"(o));
      __builtin_amdgcn_global_load_lds((const unsigned*)(vb + o), (unsigned*)(shm + buf * STG + KBYTES + (wid * 2 + i) * 1024), 16, 0, 0);
    }
  };
  bf16x8 qf[2][KS];
#pragma unroll
  for (int nt = 0; nt < 2; ++nt)
#pragma unroll
    for (int ks = 0; ks < KS; ++ks) qf[nt][ks] = *(const bf16x8*)(Q + (size_t)(wid * 32 + nt * 16 + fr) * ldq + ks * 32 + fq * 8);
  f32x4 o[8][2];
#pragma unroll
  for (int i = 0; i < 8; ++i) { o[i][0] = (f32x4){0.f, 0.f, 0.f, 0.f}; o[i][1] = (f32x4){0.f, 0.f, 0.f, 0.f}; }
  float l_[2] = {0.f, 0.f};
  const int ntile = nkeys >> 6;
  __syncthreads();
  stage(0, 0);
  asm volatile("s_waitcnt vmcnt(0)" ::: "memory");
  __syncthreads();
  for (int t = 0; t < ntile; ++t) {
    const int cur = t & 1;
    if (wid < 4 && t + 1 < ntile) stage(cur ^ 1, (t + 1) * 64);
    const bf16_t* Ks = (const bf16_t*)(shm + cur * STG);
    const char* Vs = shm + cur * STG + KBYTES;
#pragma unroll
    for (int half = 0; half < 2; ++half) {
      f32x4 s[2][2];
#pragma unroll
      for (int i = 0; i < 2; ++i) { s[i][0] = (f32x4){negB, negB, negB, negB}; s[i][1] = (f32x4){negB, negB, negB, negB}; }
#pragma unroll
      for (int ks = 0; ks < KS; ++ks)
#pragma unroll
        for (int kt = 0; kt < 2; ++kt) {
          const int krow = half * 32 + 8 * (fr >> 2) + 4 * kt + (fr & 3);
          const int ksw = (krow >> 1) & 7;
          bf16x8 kf = *(const bf16x8*)(Ks + krow * DQK + ((((ks * 4 + fq) & ~7) | (((ks * 4 + fq) & 7) ^ ksw)) * 8));
          s[kt][0] = mfma16(kf, qf[0][ks], s[kt][0]);
          s[kt][1] = mfma16(kf, qf[1][ks], s[kt][1]);
        }
      bf16x8 pf[2];
#pragma unroll
      for (int nt = 0; nt < 2; ++nt) {
        float rs = 0.f;
#pragma unroll
        for (int kt = 0; kt < 2; ++kt)
#pragma unroll
          for (int j = 0; j < 4; ++j) { float pv = __builtin_amdgcn_exp2f(s[kt][nt][j]); s[kt][nt][j] = pv; rs += pv; }
        l_[nt] += rs;
        pf[nt] = pack8(s[0][nt], s[1][nt]);
      }
#pragma unroll
      for (int dt = 0; dt < 8; ++dt) {
        bf16x8 vf = *(const bf16x8*)(Vs + (dt * 16 + fr) * 128 + (((half * 4 + fq) ^ rsw) * 16));
        o[dt][0] = mfma16(vf, pf[0], o[dt][0]);
        o[dt][1] = mfma16(vf, pf[1], o[dt][1]);
      }
      if (half == 0 && wid >= 4 && t + 1 < ntile) stage(cur ^ 1, (t + 1) * 64);
    }
    asm volatile("s_waitcnt vmcnt(0)" ::: "memory");
    __syncthreads();
  }
#pragma unroll
  for (int nt = 0; nt < 2; ++nt) {
    float l = l_[nt];
    l += __shfl_xor(l, 16); l += __shfl_xor(l, 32);
    float inv = 1.f / l;
#pragma unroll
    for (int dt = 0; dt < 8; ++dt) {
      f32x4 v = o[dt][nt] * inv;
      *(u32x2*)(O + (size_t)(wid * 32 + nt * 16 + fr) * ldo + dt * 16 + fq * 4) = pack4(v);
    }
  }
}

DEVI void prep0_norm512(int sw, const P& p, int item) {
  const int lane = lane_id();
  const int w0 = (item * 4 + (sw & 3)) * 8;
  u32x4 u[8];
#pragma unroll
  for (int q = 0; q < 8; ++q) { int w = w0 + q, r = w >> 1, which = w & 1; u[q] = *(const u32x4*)((const bf16_t*)(p.ws + OFF_Z) + (size_t)r * LDZ0 + which * 512 + lane * 8); }
#pragma unroll
  for (int q = 0; q < 8; ++q) {
    int w = w0 + q, r = w >> 1, which = w & 1;
    float v[8] = {bflo(u[q][0]), bfhi(u[q][0]), bflo(u[q][1]), bfhi(u[q][1]), bflo(u[q][2]), bfhi(u[q][2]), bflo(u[q][3]), bfhi(u[q][3])};
    float ss = 0.f;
#pragma unroll
    for (int j = 0; j < 8; ++j) ss += v[j] * v[j];
    ss = wave_sum(ss);
    float rs = rsqrtf(ss * (1.f / 512.f) + EPS);
    const float* g = (which ? p.mla_kv_a_norm : p.mla_q_a_norm) + lane * 8;
    u32x4 o = {pk2(v[0] * rs * g[0], v[1] * rs * g[1]), pk2(v[2] * rs * g[2], v[3] * rs * g[3]), pk2(v[4] * rs * g[4], v[5] * rs * g[5]), pk2(v[6] * rs * g[6], v[7] * rs * g[7])};
    *(u32x4*)((bf16_t*)(p.ws + OFF_H) + (size_t)which * NT * LDQA + (size_t)r * LDQA + lane * 8) = o;
  }
}
DEVI void store_T(int sw, const bf16_t* T, bf16_t* __restrict__ dst) {
  const int tid = VT;
#pragma unroll
  for (int i = 0; i < 4; ++i) {
    const int c = tid + 256 * i, row = c >> 3, ch = c & 7;
    *(u32x4*)(dst + (size_t)row * TPS + ch * 8) = *(const u32x4*)(T + row * 72 + ch * 8);
  }
}
DEVI void put_T(bf16_t* T, int d, int half, const float (&y)[32]) {
#pragma unroll
  for (int i = 0; i < 4; ++i) {
    u32x4 u = {pk2(y[8 * i], y[8 * i + 1]), pk2(y[8 * i + 2], y[8 * i + 3]), pk2(y[8 * i + 4], y[8 * i + 5]), pk2(y[8 * i + 6], y[8 * i + 7])};
    *(u32x4*)(T + d * 72 + half * 32 + 8 * i) = u;
  }
}
DEVI void prep0_gdn(int sw, const P& p, int item, float* sm) {
  const int tid = VT;
  const int which = item & 3; int t = item >> 2;
  const int mc = t % NCH; t /= NCH;
  const int h = t & 7, b = t >> 3;
  const int p0 = mc * 64;
  const int bh = b * 8 + h;
  char* R2 = p.ws + OFF_R2;
  if (which == 3) {
    if (tid < 128) {
      const int dir = tid >> 6, ln = tid & 63;
      const int c = dir ? 63 - ln : ln;
      const float* gr = (const float*)(R2 + R_GATES) + (size_t)(b * TPB + p0 + c) * 32;
      const float A = __expf(p.gdn_a_log[dir * 8 + h]), dtb = p.gdn_dt_bias[dir * 8 + h];
      const float a = gr[dir * 8 + h] + dtb, bb = gr[16 + dir * 8 + h];
      const float sp = fmaxf(a, 0.f) + log1pf(__expf(-fabsf(a)));
      float v = -A * sp;
#pragma unroll
      for (int off = 1; off < 64; off <<= 1) { float t2 = __shfl_up(v, off); if (ln >= off) v += t2; }
      ((float*)(R2 + R_GC))[(size_t)(bh * 2 + dir) * TPB + p0 + c] = v;
      ((float*)(R2 + R_BETA))[(size_t)(bh * 2 + dir) * TPB + p0 + c] = 1.f / (1.f + __expf(-bb));
    }
    vbar(sm);
    return;
  }
  const int d = tid & 127, half = tid >> 7;
  const int col0 = 1088 + which * 1024 + h * 128;
  const int col = col0 + d;
  const int lo = p0 < CTX ? 0 : CTX, hi = p0 < CTX ? CTX : TPB;
  bf16_t* xin = (bf16_t*)sm;
  float* sq = (float*)(xin + 72 * 128);
  float* nrm = sq + 64 * 129;
  bf16_t* yb = (bf16_t*)(nrm + 64);
  vbar(sm);
  {
    const bf16_t* zb = (const bf16_t*)(p.ws + OFF_Z) + (size_t)(b * TPB) * LDZ0 + col0;
    for (int c = tid; c < 68 * 16; c += 256) {
      const int row = c >> 4, ch = c & 15, pp = p0 - 2 + row;
      u32x4 v = {0u, 0u, 0u, 0u};
      if (pp >= lo && pp < hi) v = *(const u32x4*)(zb + (size_t)pp * LDZ0 + ch * 8);
      *(u32x4*)(xin + row * 128 + ch * 8) = v;
    }
  }
  vbar(sm);
  const float w0 = p.gdn_conv_w[0 * 3072 + col - 1088], w1 = p.gdn_conv_w[1 * 3072 + col - 1088], w2 = p.gdn_conv_w[2 * 3072 + col - 1088],
              w3 = p.gdn_conv_w[3 * 3072 + col - 1088], w4 = p.gdn_conv_w[4 * 3072 + col - 1088];
  const int ps = p0 + half * 32;
  const bf16_t* xc = xin + (half * 32) * 128 + d;
  float xm2 = bf2f(xc[0]), xm1 = bf2f(xc[128]), x0 = bf2f(xc[256]), xp1 = bf2f(xc[384]);
  float y[32];
#pragma unroll
  for (int i = 0; i < 32; ++i) {
    float xp2 = bf2f(xc[(i + 4) * 128]);
    float a = w0 * xm2 + w1 * xm1 + w2 * x0 + w3 * xp1 + w4 * xp2;
    y[i] = silu_f(a);
    xm2 = xm1; xm1 = x0; x0 = xp1; xp1 = xp2;
  }
  if (which == 2) {
    vbar(sm);
    put_T(xin, d, half, y);
    vbar(sm);
    store_T(sw, xin, (bf16_t*)(R2 + R_GVT) + ((size_t)bh * 128) * TPS + p0);
    return;
  }
#pragma unroll
  for (int i = 0; i < 32; ++i) sq[(half * 32 + i) * 129 + d] = y[i] * y[i];
  vbar(sm);
  {
    int c = tid >> 2, part = tid & 3;
    float sacc = 0.f;
    for (int i = 0; i < 32; ++i) sacc += sq[c * 129 + part * 32 + i];
    sacc += __shfl_xor(sacc, 1); sacc += __shfl_xor(sacc, 2);
    if (part == 0) nrm[c] = rsqrtf(sacc + EPS) * (which == 0 ? 0.08838834764831845f : 1.f);
  }
  vbar(sm);
#pragma unroll
  for (int i = 0; i < 32; ++i) { y[i] *= nrm[half * 32 + i]; yb[(half * 32 + i) * 136 + d] = f2bf(y[i]); }
  if (which == 1) put_T(xin, d, half, y);
  vbar(sm);
  if (which == 1) store_T(sw, xin, (bf16_t*)(R2 + R_GKT) + ((size_t)bh * 128) * TPS + p0);
  {
    bf16_t* dq = (bf16_t*)(R2 + (which == 0 ? R_GQ : R_GK)) + ((size_t)bh * TPB + p0) * 128;
#pragma unroll
    for (int i = 0; i < 4; ++i) {
      const int c = tid + 256 * i, row = c >> 4, ch = c & 15;
      *(u32x4*)(dq + row * 128 + ch * 8) = *(const u32x4*)(yb + row * 136 + ch * 8);
    }
  }
}

DEVI float rope64(float val, int lane, int t) {
  int i = lane & 15, hf = (lane >> 4) & 1, axis = lane >> 5;
  float pos = (float)(axis ? (t & 63) : (t >> 6));
  float invf = exp2f(-(float)(2 * i) * (13.287712379549449f / 32.f));
  float ang = pos * invf;
  float cs = __cosf(ang), sn = __sinf(ang);
  float partner = __shfl_xor(val, 16);
  return hf ? (val * cs + partner * sn) : (val * cs - partner * sn);
}

DEVI void prep0_q(int sw, const P& p, int item) {
  const int lane = lane_id();
  const int w0 = (item * 4 + (sw & 3)) * 8;
  const int r = w0 >> 3;
  bf16_t* qb = (bf16_t*)(p.ws + OFF_R2 + R_QUP) + (size_t)r * 1536;
  float a[8], b[8], c[8];
#pragma unroll
  for (int h = 0; h < 8; ++h) { a[h] = bf2f(qb[h * 192 + lane]); b[h] = bf2f(qb[h * 192 + 64 + lane]); c[h] = bf2f(qb[h * 192 + 128 + lane]); }
  const float g0 = p.mla_q_norm[lane], g1 = p.mla_q_norm[64 + lane], g2 = p.mla_q_norm[128 + lane];
  const int pp = r % TPB;
  const float sc = 0.07216878364870322f * LOG2E;
#pragma unroll
  for (int h = 0; h < 8; ++h) {
    float ss = wave_sum(a[h] * a[h] + b[h] * b[h] + c[h] * c[h]);
    float rs = rsqrtf(ss * (1.f / 192.f) + EPS);
    float x = a[h] * rs * g0, y = b[h] * rs * g1, z = c[h] * rs * g2;
    if (pp >= CTX) z = rope64(z, lane, pp - CTX);
    qb[h * 192 + lane] = f2bf(x * sc); qb[h * 192 + 64 + lane] = f2bf(y * sc); qb[h * 192 + 128 + lane] = f2bf(z * sc);
  }
}
DEVI void prep0_k(int sw, const P& p, int item) {
  const int lane = lane_id();
  const int w0 = (item * 4 + (sw & 3)) * 8;
  const int r = w0 >> 3;
  const bf16_t* kv = (const bf16_t*)(p.ws + OFF_MIX) + (size_t)r * LDH;
  const float c0 = bf2f(((const bf16_t*)(p.ws + OFF_Z) + (size_t)r * LDZ0 + 1024)[lane]);
  float a[8], b[8];
#pragma unroll
  for (int h = 0; h < 8; ++h) { a[h] = bf2f(kv[h * 256 + lane]); b[h] = bf2f(kv[h * 256 + 64 + lane]); }
  const float g0 = p.mla_k_norm[lane], g1 = p.mla_k_norm[64 + lane], g2 = p.mla_k_norm[128 + lane];
  const int pp = r % TPB;
  bf16_t* k = (bf16_t*)(p.ws + OFF_R2 + R_K) + (size_t)r * LDK;
#pragma unroll
  for (int h = 0; h < 8; ++h) {
    float ss = wave_sum(a[h] * a[h] + b[h] * b[h] + c0 * c0);
    float rs = rsqrtf(ss * (1.f / 192.f) + EPS);
    float x = a[h] * rs * g0, y = b[h] * rs * g1, z = c0 * rs * g2;
    if (pp >= CTX) z = rope64(z, lane, pp - CTX);
    k[h * 192 + lane] = f2bf(x); k[h * 192 + 64 + lane] = f2bf(y); k[h * 192 + 128 + lane] = f2bf(z);
  }
}
DEVI void transpose64x128(int sw, const bf16_t* __restrict__ src, int ld, bf16_t* __restrict__ dst  , char* smb) {
  const int tid = VT, d = tid & 127, half = tid >> 7;
  float y[32];
#pragma unroll
  for (int i = 0; i < 32; ++i) y[i] = bf2f(src[(size_t)(half * 32 + i) * ld + d]);
  bf16_t* T = (bf16_t*)smb;
  vbar(smb);
  put_T(T, d, half, y);
  vbar(smb);
  store_T(sw, T, dst);
}
DEVI void gdn_pre(int sw, const P& p, int item, char* smraw) {
  const int tid = VT, lane = tid & 63, wid = tid >> 6, fr = lane & 15, fq = lane >> 4;
  const int mc = item % NCH; int t = item / NCH;
  const int dir = t & 1, bh = t >> 1;
  const int p0 = mc * 64;
  char* R2 = p.ws + OFF_R2;
  bf16_t* qs = (bf16_t*)smraw;
  bf16_t* ks = qs + 64 * 136;
  float* Ls = (float*)(ks + 64 * 136);
  float* gcs = Ls + 4096;
  float* bes = gcs + 64;
  vbar(smraw);
  {
    const bf16_t* gq = (const bf16_t*)(R2 + R_GQ) + ((size_t)bh * TPB + p0) * 128;
    const bf16_t* gk = (const bf16_t*)(R2 + R_GK) + ((size_t)bh * TPB + p0) * 128;
#pragma unroll
    for (int i = 0; i < 4; ++i) {
      int c = tid + 256 * i, row = c >> 4, kc = c & 15;
      *(u32x4*)(qs + row * 136 + kc * 8) = *(const u32x4*)(gq + row * 128 + kc * 8);
      *(u32x4*)(ks + row * 136 + kc * 8) = *(const u32x4*)(gk + row * 128 + kc * 8);
    }
    if (tid < 64) {
      gcs[tid] = ((const float*)(R2 + R_GC))[(size_t)(bh * 2 + dir) * TPB + p0 + tid];
      bes[tid] = ((const float*)(R2 + R_BETA))[(size_t)(bh * 2 + dir) * TPB + p0 + tid];
    }
  }
  vbar(smraw);
  {
    const int it = wid;
    const int i = it * 16 + fr;
    const float gi = gcs[i], bi = bes[i];
    bf16x8 bq[4], bk[4];
#pragma unroll
    for (int s = 0; s < 4; ++s) {
      bq[s] = *(const bf16x8*)(qs + i * 136 + s * 32 + fq * 8);
      bk[s] = *(const bf16x8*)(ks + i * 136 + s * 32 + fq * 8);
    }
    bf16_t* qkm = (bf16_t*)(R2 + R_QKM) + (size_t)item * 4096;
#pragma unroll
    for (int jt = 0; jt < 4; ++jt) {
      f32x4 akk = {0.f, 0.f, 0.f, 0.f}, aqk = {0.f, 0.f, 0.f, 0.f};
#pragma unroll
      for (int s = 0; s < 4; ++s) {
        bf16x8 a = *(const bf16x8*)(ks + (jt * 16 + fr) * 136 + s * 32 + fq * 8);
        akk = mfma16(a, bk[s], akk);
        aqk = mfma16(a, bq[s], aqk);
      }
      f32x4 qo;
#pragma unroll
      for (int jj = 0; jj < 4; ++jj) {
        int j = jt * 16 + fq * 4 + jj;
        float gj = gcs[j];
        bool before = dir ? (j > i) : (j < i);
        bool incl = before || (j == i);
        float e = incl ? __expf(gi - gj) : 0.f;
        qo[jj] = aqk[jj] * e;
        float lv = before ? bi * akk[jj] * e : 0.f;
        int ti = dir ? 63 - i : i, tj = dir ? 63 - j : j;
        Ls[tj * 64 + ti] = lv;
      }
      *(u32x2*)(qkm + i * 64 + jt * 16 + fq * 4) = pack4(qo);
    }
  }
  vbar(smraw);
  if (wid == 0) {
    const int j = lane;
    const int sj = dir ? 63 - j : j;
    float x[64];
#pragma unroll
    for (int t2 = 0; t2 < 64; ++t2) x[t2] = (t2 == sj) ? 1.f : 0.f;
    typedef __attribute__((address_space(3))) const f32x4 lds_f32x4;
    unsigned lofs = (unsigned)(size_t)(__attribute__((address_space(3))) const float*)Ls;
    asm volatile("" : "+v"(lofs));
    lds_f32x4* L4 = (lds_f32x4*)(size_t)lofs;
    f32x4 rowv[16];
#pragma unroll
    for (int g = 0; g < 16; ++g) rowv[g] = L4[g];
#pragma unroll
    for (int t2 = 0; t2 < 63; ++t2) {
      f32x4 nxt[16];
#pragma unroll
      for (int g = 0; g < 16; ++g) nxt[g] = (t2 + 1 < 63 && g >= (t2 + 2) / 4) ? L4[(t2 + 1) * 16 + g] : (f32x4){0.f, 0.f, 0.f, 0.f};
      const float xt = x[t2];
#pragma unroll
      for (int i = t2 + 1; i < 64; ++i) x[i] -= rowv[i >> 2][i & 3] * xt;
#pragma unroll
      for (int g = 0; g < 16; ++g) rowv[g] = nxt[g];
    }
    bf16_t* tm = (bf16_t*)(R2 + R_TM) + (size_t)item * 4096;
#pragma unroll
    for (int t2 = 0; t2 < 64; ++t2) {
      int i = dir ? 63 - t2 : t2;
      tm[i * 64 + j] = f2bf(x[t2]);
    }
  }
}

template <bool GDN>
DEVI void scan_chain(int sw, const P& p, int item, char* smraw) {
  const int tid = VT, lane = tid & 63, wid = tid >> 6, fr = lane & 15, fq = lane >> 4;
  int slice, dir, h, b, NH, DV;
  if (GDN) { slice = item & 1; dir = (item >> 1) & 1; h = (item >> 2) & 7; b = item >> 5; NH = 8; DV = 128; }
  else { slice = item & 3; dir = (item >> 2) & 1; h = (item >> 3) & 3; b = item >> 5; NH = 4; DV = 256; }
  const int bh = b * NH + h, bhd = bh * 2 + dir;
  char* R2 = p.ws + OFF_R2;
  bf16_t* kbg = (bf16_t*)smraw;
  bf16_t* qd = kbg + 64 * 136;
  bf16_t* kend = qd + 64 * 136;
  bf16_t* Tm = kend + 128 * 72;
  bf16_t* QK = Tm + 64 * 72;
  float* f_e = (float*)(QK + 64 * 72);
  float* f_b = f_e + 64;
  float* f_k = f_b + 64;
  float* el = f_k + 64;
  float* f_last = el + 128;
  const int e0 = slice * 64 + wid * 16;
  f32x4 S[8];
#pragma unroll
  for (int i = 0; i < 8; ++i) S[i] = (f32x4){0.f, 0.f, 0.f, 0.f};
  bf16_t* rec = (bf16_t*)(GDN ? (p.ws + OFF_H) : (R2 + R1_REC)) + (size_t)dir * NT * 1024;
  for (int n = 0; n < NCH; ++n) {
    const int mc = dir == 0 ? n : (n < 4 ? 3 - n : 71 - n);
    const int p0 = mc * 64;
    const int itc = bhd * NCH + mc;
    __syncthreads();
    if (GDN) {
      if (tid < 64) {
        const float* gc = (const float*)(R2 + R_GC) + (size_t)bhd * TPB + p0;
        float gcv = gc[tid], gl = gc[dir ? 0 : 63];
        f_e[tid] = __expf(gcv);
        f_b[tid] = ((const float*)(R2 + R_BETA))[(size_t)bhd * TPB + p0 + tid];
        f_k[tid] = __expf(gl - gcv);
        if (tid == 0) f_last[0] = __expf(gl);
      }
    } else {
      if (tid < 128) el[tid] = ((const float*)(R2 + R1_EL))[(size_t)itc * 128 + tid];
    }
    __syncthreads();
    if (GDN) {
      const bf16_t* gq = (const bf16_t*)(R2 + R_GQ) + ((size_t)bh * TPB + p0) * 128;
      const bf16_t* gk = (const bf16_t*)(R2 + R_GK) + ((size_t)bh * TPB + p0) * 128;
      const bf16_t* gkt = (const bf16_t*)(R2 + R_GKT) + ((size_t)bh * 128) * TPS + p0;
      const bf16_t* tm = (const bf16_t*)(R2 + R_TM) + (size_t)itc * 4096;
      const bf16_t* qkm = (const bf16_t*)(R2 + R_QKM) + (size_t)itc * 4096;
#pragma unroll
      for (int i = 0; i < 4; ++i) {
        int c = tid + 256 * i, row = c >> 4, kc = c & 15;
        u32x4 uq = *(const u32x4*)(gq + row * 128 + kc * 8), uk = *(const u32x4*)(gk + row * 128 + kc * 8);
        float fe = f_e[row], fk = f_b[row] * fe;
        u32x4 oq, ok;
#pragma unroll
        for (int j = 0; j < 4; ++j) { oq[j] = pk2(bflo(uq[j]) * fe, bfhi(uq[j]) * fe); ok[j] = pk2(bflo(uk[j]) * fk, bfhi(uk[j]) * fk); }
        *(u32x4*)(qd + row * 136 + kc * 8) = oq;
        *(u32x4*)(kbg + row * 136 + kc * 8) = ok;
      }
#pragma unroll
      for (int i = 0; i < 4; ++i) {
        int c = tid + 256 * i, row = c >> 3, cc = c & 7;
        u32x4 u = *(const u32x4*)(gkt + (size_t)row * TPS + cc * 8), o;
#pragma unroll
        for (int j = 0; j < 4; ++j) o[j] = pk2(bflo(u[j]) * f_k[cc * 8 + 2 * j], bfhi(u[j]) * f_k[cc * 8 + 2 * j + 1]);
        *(u32x4*)(kend + row * 72 + cc * 8) = o;
      }
#pragma unroll
      for (int i = 0; i < 2; ++i) {
        int c = tid + 256 * i, row = c >> 3, cc = c & 7;
        *(u32x4*)(Tm + row * 72 + cc * 8) = *(const u32x4*)(tm + row * 64 + cc * 8);
        *(u32x4*)(QK + row * 72 + cc * 8) = *(const u32x4*)(qkm + row * 64 + cc * 8);
      }
    } else {
      const bf16_t* gq = (const bf16_t*)(R2 + R1_QG) + ((size_t)bhd * TPB + p0) * 128;
      const bf16_t* gkt = (const bf16_t*)(R2 + R1_KGT) + ((size_t)bhd * 128) * TPS + p0;
      const bf16_t* am = (const bf16_t*)(R2 + R1_AM) + (size_t)itc * 4096;
#pragma unroll
      for (int i = 0; i < 4; ++i) {
        int c = tid + 256 * i, row = c >> 4, kc = c & 15;
        *(u32x4*)(qd + row * 136 + kc * 8) = *(const u32x4*)(gq + row * 128 + kc * 8);
      }
#pragma unroll
      for (int i = 0; i < 4; ++i) {
        int c = tid + 256 * i, row = c >> 3, cc = c & 7;
        *(u32x4*)(kend + row * 72 + cc * 8) = *(const u32x4*)(gkt + (size_t)row * TPS + cc * 8);
      }
#pragma unroll
      for (int i = 0; i < 2; ++i) {
        int c = tid + 256 * i, row = c >> 3, cc = c & 7;
        *(u32x4*)(QK + row * 72 + cc * 8) = *(const u32x4*)(am + row * 64 + cc * 8);
      }
    }
    __syncthreads();
    bf16x8 Sop[4];
#pragma unroll
    for (int ks = 0; ks < 4; ++ks) Sop[ks] = pack8(S[2 * ks], S[2 * ks + 1]);
    bf16x8 vop[2];
    if (GDN) {
      const bf16_t* gvt = (const bf16_t*)(R2 + R_GVT) + ((size_t)bh * 128 + e0 + fr) * TPS + p0;
      f32x4 X[4];
#pragma unroll
      for (int ct = 0; ct < 4; ++ct) {
        u32x2 u = *(const u32x2*)(gvt + ct * 16 + fq * 4);
        const float* fb = f_b + ct * 16 + fq * 4;
        f32x4 vb = {bflo(u[0]) * fb[0], bfhi(u[0]) * fb[1], bflo(u[1]) * fb[2], bfhi(u[1]) * fb[3]};
        f32x4 acc = {0.f, 0.f, 0.f, 0.f};
#pragma unroll
        for (int ks = 0; ks < 4; ++ks) acc = mfma16(ldsperm(kbg, ct * 16 + fr, 136, ks, fq), Sop[ks], acc);
        X[ct] = vb - acc;
      }
      bf16x8 Xop[2] = {pack8(X[0], X[1]), pack8(X[2], X[3])};
      f32x4 vn[4];
#pragma unroll
      for (int ct = 0; ct < 4; ++ct) {
        f32x4 acc = {0.f, 0.f, 0.f, 0.f};
#pragma unroll
        for (int kk = 0; kk < 2; ++kk) acc = mfma16(ldsperm(Tm, ct * 16 + fr, 72, kk, fq), Xop[kk], acc);
        vn[ct] = acc;
      }
      vop[0] = pack8(vn[0], vn[1]); vop[1] = pack8(vn[2], vn[3]);
    } else {
      const bf16_t* gvt = (const bf16_t*)(R2 + R1_VTG) + ((size_t)bh * 256 + e0 + fr) * TPS + p0;
#pragma unroll
      for (int kk = 0; kk < 2; ++kk) {
        u32x2 lo = *(const u32x2*)(gvt + kk * 32 + fq * 4), hi = *(const u32x2*)(gvt + kk * 32 + 16 + fq * 4);
        vop[kk] = cat8(lo, hi);
      }
    }
#pragma unroll
    for (int ct = 0; ct < 4; ++ct) {
      f32x4 acc = {0.f, 0.f, 0.f, 0.f};
#pragma unroll
      for (int ks = 0; ks < 4; ++ks) acc = mfma16(Sop[ks], ldsperm(qd, ct * 16 + fr, 136, ks, fq), acc);
#pragma unroll
      for (int kk = 0; kk < 2; ++kk) acc = mfma16(vop[kk], ldsperm(QK, ct * 16 + fr, 72, kk, fq), acc);
      *(u32x2*)(rec + (size_t)(b * TPB + p0 + ct * 16 + fr) * 1024 + h * DV + e0 + fq * 4) = pack4(acc);
    }
#pragma unroll
    for (int dt = 0; dt < 8; ++dt) {
      if (GDN) S[dt] *= f_last[0];
      else S[dt] *= *(const f32x4*)(el + dt * 16 + fq * 4);
#pragma unroll
      for (int kk = 0; kk < 2; ++kk) S[dt] = mfma16(ldsperm(kend, dt * 16 + fr, 72, kk, fq), vop[kk], S[dt]);
    }
  }
}

DEVI void fin0_rec(int sw, const P& p, int item) {
  const int lane = lane_id();
  const int w0 = (item * 4 + (sw & 3)) * 8;
  const int r = w0 >> 3;
  const bf16_t* r0 = (const bf16_t*)(p.ws + OFF_H) + (size_t)r * 1024 + lane * 2;
  const bf16_t* zz = (const bf16_t*)(p.ws + OFF_Z) + (size_t)r * LDZ0 + 4160 + lane * 2;
  unsigned u0[8], u1[8], uz[8];
#pragma unroll
  for (int h = 0; h < 8; ++h) { u0[h] = *(const unsigned*)(r0 + h * 128); u1[h] = *(const unsigned*)(r0 + (size_t)NT * 1024 + h * 128); uz[h] = *(const unsigned*)(zz + h * 128); }
  const float n0 = p.gdn_out_norm[lane * 2], n1 = p.gdn_out_norm[lane * 2 + 1];
#pragma unroll
  for (int h = 0; h < 8; ++h) {
    float a = bflo(u0[h]) + bflo(u1[h]), b = bfhi(u0[h]) + bfhi(u1[h]);
    float ss = wave_sum(a * a + b * b);
    float rs = rsqrtf(ss * (1.f / 128.f) + EPS);
    float oa = a * rs * n0 * silu_f(bflo(uz[h])), ob = b * rs * n1 * silu_f(bfhi(uz[h]));
    *(unsigned*)((bf16_t*)(p.ws + OFF_MIX) + (size_t)r * LDH + 1024 + h * 128 + lane * 2) = pk2(oa, ob);
  }
}

DEVI void prep1_qk(int sw, const P& p, int item) {
  const int lane = lane_id();
  const int w = item * 4 + (sw & 3);
  const int which = w & 1, r = w >> 1;
  bf16_t* q = (bf16_t*)(p.ws + OFF_Z) + (size_t)r * LDZ1 + which * 1024;
  float a[16];
#pragma unroll
  for (int hm = 0; hm < 16; ++hm) a[hm] = bf2f(q[hm * 64 + lane]);
  const float* gn = which ? p.diff_k_norm : p.diff_q_norm;
  const float g0 = gn[lane], g1 = gn[64 + lane];
  const int pp = r % TPB;
#pragma unroll
  for (int hm = 0; hm < 16; ++hm) {
    float ss = wave_sum(a[hm] * a[hm]);
    float rs = rsqrtf(ss * (1.f / 64.f) + EPS);
    float x = a[hm] * rs * ((hm & 1) ? g1 : g0);
    if (pp >= CTX) x = rope64(x, lane, pp - CTX);
    if (which == 0) x *= 0.125f * LOG2E;
    q[hm * 64 + lane] = f2bf(x);
  }
}
DEVI void gla_pre(int sw, const P& p, int item, char* smraw) {
  const int tid = VT, lane = tid & 63, wid = tid >> 6, fr = lane & 15, fq = lane >> 4;
  const int mc = item % NCH; int t = item / NCH;
  const int dir = t & 1, bh = t >> 1, h = bh & 3, b = bh >> 2;
  const int p0 = mc * 64;
  char* R2 = p.ws + OFF_R2;
  float* cum = (float*)smraw;
  float* lr = cum + 64 * 129;
  float* last = lr + 64 * 16;
  bf16_t* QS = (bf16_t*)(last + 128);
  bf16_t* KS = QS + 64 * 136;
  const bf16_t* z = (const bf16_t*)(p.ws + OFF_Z) + (size_t)(b * TPB + p0) * LDZ1;
  vbar(smraw);
#pragma unroll
  for (int i = tid; i < 64 * 16; i += 256) lr[i] = ((const float*)(R2 + R1_GATES))[(size_t)(b * TPB + p0 + (i >> 4)) * 32 + dir * 16 + (i & 15)];
  vbar(smraw);
  {
    const int d = tid & 127, half = tid >> 7;
    float w2[16];
#pragma unroll
    for (int rr = 0; rr < 16; ++rr) w2[rr] = p.gla_gate_w2[((size_t)dir * 16 + rr) * 512 + h * 128 + d];
    const float b2 = p.gla_gate_b2[dir * 512 + h * 128 + d];
#pragma unroll 4
    for (int i = 0; i < 32; ++i) {
      int c = half * 32 + i;
      float lg = b2;
#pragma unroll
      for (int rr = 0; rr < 16; ++rr) lg += lr[c * 16 + rr] * w2[rr];
      float ls = fminf(lg, 0.f) - __logf(1.f + __expf(-fabsf(lg)));
      cum[c * 129 + d] = ls * (1.f / 16.f);
    }
  }
  vbar(smraw);
  if (tid < 128) {
    float cv[64];
#pragma unroll
    for (int i = 0; i < 64; ++i) cv[i] = cum[(dir ? 63 - i : i) * 129 + tid];
    float run = 0.f;
#pragma unroll
    for (int i = 0; i < 64; ++i) { run += cv[i]; cum[(dir ? 63 - i : i) * 129 + tid] = run; }
    last[tid] = run;
    ((float*)(R2 + R1_EL))[(size_t)item * 128 + tid] = __expf(run);
  }
  vbar(smraw);
  {
    bf16_t* qg = (bf16_t*)(R2 + R1_QG) + ((size_t)(bh * 2 + dir) * TPB + p0) * 128;
#pragma unroll
    for (int i = tid; i < 64 * 64; i += 256) {
      int c = i >> 6, d = (i & 63) * 2;
      unsigned uq = *(const unsigned*)(z + (size_t)c * LDZ1 + 3072 + h * 128 + d);
      unsigned uk = *(const unsigned*)(z + (size_t)c * LDZ1 + 3584 + h * 128 + d);
      float c0 = cum[c * 129 + d], c1 = cum[c * 129 + d + 1];
      unsigned oq = pk2(bflo(uq) * 0.08838834764831845f * __expf(c0), bfhi(uq) * 0.08838834764831845f * __expf(c1));
      unsigned ok = pk2(bflo(uk) * __expf(-c0), bfhi(uk) * __expf(-c1));
      *(unsigned*)(QS + c * 136 + d) = oq;
      *(unsigned*)(KS + c * 136 + d) = ok;
      *(unsigned*)(qg + (size_t)c * 128 + d) = oq;
    }
    {
      const int d = tid >> 1, half = tid & 1;
      const float ld = last[d];
      float y[32];
#pragma unroll
      for (int i = 0; i < 32; ++i) {
        int c = half * 32 + i;
        y[i] = bf2f(z[(size_t)c * LDZ1 + 3584 + h * 128 + d]) * __expf(ld - cum[c * 129 + d]);
      }
      vbar(smraw);
      put_T((bf16_t*)smraw, d, half, y);
      vbar(smraw);
      store_T(sw, (const bf16_t*)smraw, (bf16_t*)(R2 + R1_KGT) + ((size_t)(bh * 2 + dir) * 128) * TPS + p0);
    }
  }
  {
    const int it = wid, i = it * 16 + fr;
    bf16x8 bq[4];
#pragma unroll
    for (int s = 0; s < 4; ++s) bq[s] = *(const bf16x8*)(QS + i * 136 + s * 32 + fq * 8);
    bf16_t* am = (bf16_t*)(R2 + R1_AM) + (size_t)item * 4096;
#pragma unroll
    for (int jt = 0; jt < 4; ++jt) {
      f32x4 a = {0.f, 0.f, 0.f, 0.f};
#pragma unroll
      for (int s = 0; s < 4; ++s) a = mfma16(*(const bf16x8*)(KS + (jt * 16 + fr) * 136 + s * 32 + fq * 8), bq[s], a);
#pragma unroll
      for (int jj = 0; jj < 4; ++jj) {
        int j = jt * 16 + fq * 4 + jj;
        bool incl = dir ? (j >= i) : (j <= i);
        a[jj] = incl ? a[jj] : 0.f;
      }
      *(u32x2*)(am + i * 64 + jt * 16 + fq * 4) = pack4(a);
    }
  }
  if (dir == 0) {
    const bf16_t* src = z + 4096 + h * 256;
    bf16_t* dst = (bf16_t*)(R2 + R1_VTG) + ((size_t)bh * 256) * TPS + p0;
    transpose64x128(sw, src, LDZ1, dst, smraw);
    transpose64x128(sw, src + 128, LDZ1, dst + (size_t)128 * TPS, smraw);
  }
}
constexpr float LAM_INIT = 0.35550906759096927f;
DEVI void fin1(int sw, const P& p, int item) {
  const int lane = lane_id();
  const int r = item * 4 + (sw & 3);
  bf16_t* mix = (bf16_t*)(p.ws + OFF_MIX) + (size_t)r * LDH;
  const bf16_t* o = (const bf16_t*)(p.ws + OFF_H) + (size_t)r * LDH + lane * 2;
  const bf16_t* r0 = (const bf16_t*)(p.ws + OFF_R2 + R1_REC) + (size_t)r * 1024 + lane * 4;
  const bf16_t* zg = (const bf16_t*)(p.ws + OFF_Z) + (size_t)r * LDZ1 + 5120 + lane * 4;
  unsigned u1[8], u2[8];
  u32x2 a0[4], a1[4], ag[4];
#pragma unroll
  for (int h = 0; h < 8; ++h) { u1[h] = *(const unsigned*)(o + h * 256); u2[h] = *(const unsigned*)(o + h * 256 + 128); }
#pragma unroll
  for (int h = 0; h < 4; ++h) { a0[h] = *(const u32x2*)(r0 + h * 256); a1[h] = *(const u32x2*)(r0 + (size_t)NT * 1024 + h * 256); ag[h] = *(const u32x2*)(zg + h * 256); }
  float l01 = wave_sum(p.diff_lambda[lane] * p.diff_lambda[64 + lane]);
  float l23 = wave_sum(p.diff_lambda[128 + lane] * p.diff_lambda[192 + lane]);
  const float lam = __expf(l01) - __expf(l23) + LAM_INIT;
  const float s0 = p.diff_sub_norm[lane * 2], s1 = p.diff_sub_norm[lane * 2 + 1];
#pragma unroll
  for (int h = 0; h < 8; ++h) {
    float a = bflo(u1[h]) - lam * bflo(u2[h]), b = bfhi(u1[h]) - lam * bfhi(u2[h]);
    float ss = wave_sum(a * a + b * b);
    float rs = rsqrtf(ss * (1.f / 128.f) + EPS) * (1.f - LAM_INIT);
    *(unsigned*)(mix + h * 128 + lane * 2) = pk2(a * rs * s0, b * rs * s1);
  }
  const f32x4 gn = *(const f32x4*)(p.gla_out_norm + lane * 4);
#pragma unroll
  for (int h = 0; h < 4; ++h) {
    float v[4] = {bflo(a0[h][0]) + bflo(a1[h][0]), bfhi(a0[h][0]) + bfhi(a1[h][0]), bflo(a0[h][1]) + bflo(a1[h][1]), bfhi(a0[h][1]) + bfhi(a1[h][1])};
    float ss = wave_sum(v[0] * v[0] + v[1] * v[1] + v[2] * v[2] + v[3] * v[3]);
    float rs = rsqrtf(ss * (1.f / 256.f) + EPS);
    float g[4] = {bflo(ag[h][0]), bfhi(ag[h][0]), bflo(ag[h][1]), bfhi(ag[h][1])};
    f32x4 ov;
#pragma unroll
    for (int q = 0; q < 4; ++q) ov[q] = v[q] * rs * gn[q] * silu_f(g[q]);
    *(u32x2*)(mix + 1024 + h * 256 + lane * 4) = pack4(ov);
  }
}

DEVI int fetch_item(int sw, int* ctr, char* slot) {
  __syncthreads();
  if (sw == 0 && lane_id() == 0) *(volatile int*)slot = atomicAdd(ctr, 1);
  __syncthreads();
  return __builtin_amdgcn_readfirstlane(*(volatile int*)slot);
}
DEVI void gbar(int sw, unsigned* cnt, unsigned* gen, unsigned nblk, unsigned epoch) {
  __syncthreads();
  if (sw == 0 && lane_id() == 0) {
    __builtin_amdgcn_fence(__ATOMIC_RELEASE, "agent");
    const unsigned prev = __hip_atomic_fetch_add(cnt, 1u, __ATOMIC_RELAXED, __HIP_MEMORY_SCOPE_AGENT);
    if (prev == epoch * nblk - 1u) __hip_atomic_store(gen, epoch, __ATOMIC_RELAXED, __HIP_MEMORY_SCOPE_AGENT);
    else while (__hip_atomic_load(gen, __ATOMIC_RELAXED, __HIP_MEMORY_SCOPE_AGENT) < epoch) __builtin_amdgcn_s_sleep(1);
    __builtin_amdgcn_fence(__ATOMIC_ACQUIRE, "agent");
  }
  __syncthreads();
}
constexpr int SMEM_HALF = 75776;
constexpr int SMEM_BYTES = 2 * SMEM_HALF;
constexpr int NPHASE = 21;

__global__ void __launch_bounds__(512, 2) mega(P p, int ph0, int ph1) {
  __shared__ __attribute__((aligned(1024))) char smem_all[SMEM_BYTES];
  cg::grid_group grid = cg::this_grid();
#ifdef PH_LO
  ph0 = PH_LO; ph1 = PH_HI;
#endif
  const int sw = __builtin_amdgcn_readfirstlane(threadIdx.x >> 6);
  const int vb = sw >> 2;
  const int G = gridDim.x * 2, bid = blockIdx.x * 2 + vb;
  char* smem = smem_all + vb * SMEM_HALF;
  unsigned* gb_cnt = (unsigned*)(p.ws + OFF_CTR) + 256;
  unsigned* gb_gen = (unsigned*)(p.ws + OFF_CTR) + 320;
  unsigned epoch = 0;
  char* ws = p.ws;
  char* R2 = ws + OFF_R2;
  bf16_t* wmix = (bf16_t*)(ws + OFF_WMIX);
  bf16_t* Hb = (bf16_t*)(ws + OFF_H);
  bf16_t* MIXb = (bf16_t*)(ws + OFF_MIX);
  bf16_t* Zb = (bf16_t*)(ws + OFF_Z);
  const float* mod0 = (const float*)(ws + OFF_MOD);
  const float* mod1 = mod0 + 5 * MODN;

  if (ph0 <= 0 && 0 < ph1) {
    if (lane_id() == 0 && (sw & 3) == 0) *(volatile unsigned*)(smem + VB_CTR_OFF) = 0u;
    __syncthreads();
    {
        for (int it = bid; it < 192 + CVT_MIX0_ITEMS; it += G) {
          if (it < 192) ada_item(sw, p, it, (float*)smem);
          else cvt_mix0(sw, p, it - 192, (float*)smem);
        }
        if (blockIdx.x == 0 && sw == 0 && lane_id() < 16) ((int*)(ws + OFF_CTR))[lane_id()] = 0;
        if (blockIdx.x == 0 && sw == 0 && lane_id() < 2) ((unsigned*)(ws + OFF_CTR))[256 + 64 * lane_id()] = 0u;
      }
    if (0 + 1 < ph1) grid.sync();
  }
  if (ph0 <= 1 && 1 < ph1) {
    modulate_phase(sw, p, p.norm_mix_g, mod0, 0, 1, Hb, nullptr, nullptr, true);
    if (1 + 1 < ph1) gbar(sw, gb_cnt, gb_gen, gridDim.x, ++epoch);
  }
  if (ph0 <= 2 && 2 < ph1) {
    {
        EpiStore e{Zb, LDZ0, (float*)(R2 + R_GATES), 5184};
        gemm256_phase<0>(sw, wmix + WM_IN, LDW, Hb, LDH, D, AB_INP / 256, smem_all, e);
      }
    if (2 + 1 < ph1) gbar(sw, gb_cnt, gb_gen, gridDim.x, ++epoch);
  }
  if (ph0 <= 3 && 3 < ph1) {
    if (lane_id() == 0 && (sw & 3) == 0) *(volatile unsigned*)(smem + VB_CTR_OFF) = 0u;
    __syncthreads();
    {
        for (int it = bid; it < 8704 + 1088; it += G) {
          if (it < 8704) prep0_gdn(sw, p, (it & ~3) | ((it + (it >> 9)) & 3), (float*)smem);
          else prep0_norm512(sw, p, it - 8704);
        }
      }
    if (3 + 1 < ph1) gbar(sw, gb_cnt, gb_gen, gridDim.x, ++epoch);
  }
  if (ph0 <= 4 && 4 < ph1) {
    {
        EpiStore eq{(bf16_t*)(R2 + R_QUP), 1536, nullptr, 0};
        gemm256_phase<0>(sw, wmix + WM_UQ, LDW5, Hb, LDQA, 512, 6, smem_all, eq);
        EpiStore ek{MIXb, LDH, nullptr, 0};
        gemm256_phase<0>(sw, wmix + WM_UKV, LDW5, Hb + (size_t)NT * LDQA, LDQA, 512, 8, smem_all, ek);
      }
    if (4 + 1 < ph1) gbar(sw, gb_cnt, gb_gen, gridDim.x, ++epoch);
  }
  if (ph0 <= 5 && 5 < ph1) {
    if (lane_id() == 0 && (sw & 3) == 0) *(volatile unsigned*)(smem + VB_CTR_OFF) = 0u;
    __syncthreads();
    {
        const int nq = NT * 8 / 4 / 8;
        for (int it = bid; it < 4352 + 2176 + 2 * nq; it += G) {
          if (it < 4352) gdn_pre(sw, p, it, smem);
          else if (it < 4352 + 2176) {
            int t = it - 4352; int mc = t % NCH; int bh = t / NCH; int b = bh >> 3, h = bh & 7;
            transpose64x128(sw, MIXb + (size_t)(b * TPB + mc * 64) * LDH + h * 256 + 128, LDH,
                            (bf16_t*)(R2 + R_VT) + ((size_t)bh * 128) * TPS + mc * 64, smem);
          } else if (it < 4352 + 2176 + nq) prep0_q(sw, p, it - 4352 - 2176);
          else prep0_k(sw, p, it - 4352 - 2176 - nq);
        }
      }
    if (5 + 1 < ph1) gbar(sw, gb_cnt, gb_gen, gridDim.x, ++epoch);
  }
  if (ph0 <= 6 && 6 < ph1) {
    {
        int* ctr = (int*)(ws + OFF_CTR) + (ph0 == 6 ? 2 : 0);
        char* slot = smem_all + SMEM_BYTES - 16;
        while (true) {
          const int it = fetch_item(sw, ctr, slot);
          if (it >= 608) break;
          if (it < 64) scan_chain<true>(sw, p, 2 * it + vb, smem);
          else {
            int bh, prow, nkeys;
            if (it < 576) { const int t = it - 64; bh = t >> 4; prow = CTX + (t & 15) * 256; nkeys = TPB; }
            else { bh = it - 576; prow = 0; nkeys = CTX; }
            const int b = bh >> 3, h = bh & 7;
            const size_t r0 = (size_t)b * TPB + prow;
            float gq = 0.f, gk = 0.f;
            for (int i = lane_id(); i < 192; i += 64) { gq = fmaxf(gq, fabsf(p.mla_q_norm[i])); gk = fmaxf(gk, fabsf(p.mla_k_norm[i])); }
#pragma unroll
            for (int o2 = 32; o2 > 0; o2 >>= 1) { gq = fmaxf(gq, __shfl_xor(gq, o2)); gk = fmaxf(gk, __shfl_xor(gk, o2)); }
            const float negB = -(0.07216878364870322f * LOG2E * 192.f) * gq * gk;
            attn256_item<192>(sw, (const bf16_t*)(R2 + R_QUP) + r0 * 1536 + h * 192, 1536,
                              (const bf16_t*)(R2 + R_K) + (size_t)b * TPB * LDK + h * 192, LDK,
                              (const bf16_t*)(R2 + R_VT) + ((size_t)bh * 128) * TPS,
                              MIXb + r0 * LDH + h * 128, LDH, nkeys, negB, smem_all);
          }
        }
      }
    if (6 + 1 < ph1) gbar(sw, gb_cnt, gb_gen, gridDim.x, ++epoch);
  }
  if (ph0 <= 7 && 7 < ph1) {
    if (lane_id() == 0 && (sw & 3) == 0) *(volatile unsigned*)(smem + VB_CTR_OFF) = 0u;
    __syncthreads();
    {
        const int nf = NT * 8 / 4 / 8;
        for (int it = bid; it < CVT_FFN_ITEMS + nf; it += G) {
          if (it < CVT_FFN_ITEMS) cvt_ffn(sw, p, 0, it, (float*)smem);
          else fin0_rec(sw, p, it - CVT_FFN_ITEMS);
        }
      }
    if (7 + 1 < ph1) gbar(sw, gb_cnt, gb_gen, gridDim.x, ++epoch);
  }
  if (ph0 <= 8 && 8 < ph1) {
    {
        EpiResid e{p.out, (float*)(ws + OFF_CTXRES), mod0 + 2 * D, (float*)(R2 + R_PART)};
        gemm256_phase<2>(sw, wmix + WM_OUT, LDW, MIXb, LDH, D, 8, smem_all, e);
      }
    if (8 + 1 < ph1) gbar(sw, gb_cnt, gb_gen, gridDim.x, ++epoch);
  }
  if (ph0 <= 9 && 9 < ph1) {
    if (lane_id() == 0 && (sw & 3) == 0) *(volatile unsigned*)(smem + VB_CTR_OFF) = 0u;
    __syncthreads();
    {
        modulate_phase(sw, p, p.norm_ffn_g, mod0, 3, 4, Hb, (const float*)(R2 + R_PART), mod0 + 4 * MODN + 2 * D);
        for (int it = bid; it < CVT_MIX1_ITEMS; it += G) cvt_mix1(sw, p, it, (float*)smem);
      }
    if (9 + 1 < ph1) gbar(sw, gb_cnt, gb_gen, gridDim.x, ++epoch);
  }
  if (ph0 <= 10 && 10 < ph1) {
    {
        EpiSwiglu e{Zb};
        gemm256_phase<0>(sw, (const bf16_t*)(R2 + RF_GU), LDW, Hb, LDH, D, 44, smem_all, e);
      }
    if (10 + 1 < ph1) gbar(sw, gb_cnt, gb_gen, gridDim.x, ++epoch);
  }
  if (ph0 <= 11 && 11 < ph1) {
    {
        EpiResid e{p.out, (float*)(ws + OFF_CTXRES), mod0 + 5 * D, (float*)(R2 + R_PART)};
        gemm256_phase<2>(sw, (const bf16_t*)(R2 + RF_D), LDWF, Zb, LDG, FFN, 8, smem_all, e);
      }
    if (11 + 1 < ph1) gbar(sw, gb_cnt, gb_gen, gridDim.x, ++epoch);
  }
  if (ph0 <= 12 && 12 < ph1) {
    modulate_phase(sw, p, p.norm_mix_g + D, mod1, 0, 1, Hb, (const float*)(R2 + R_PART), mod0 + 4 * MODN + 5 * D);
    if (12 + 1 < ph1) gbar(sw, gb_cnt, gb_gen, gridDim.x, ++epoch);
  }
  if (ph0 <= 13 && 13 < ph1) {
    {
        EpiStore e{Zb, LDZ1, (float*)(R2 + R1_GATES), 6144};
        gemm256_phase<0>(sw, wmix + WM_IN, LDW, Hb, LDH, D, CD_INP / 256, smem_all, e);
      }
    if (13 + 1 < ph1) gbar(sw, gb_cnt, gb_gen, gridDim.x, ++epoch);
  }
  if (ph0 <= 14 && 14 < ph1) {
    if (lane_id() == 0 && (sw & 3) == 0) *(volatile unsigned*)(smem + VB_CTR_OFF) = 0u;
    __syncthreads();
    {
        const int nqk = NT * 2 / 4;
        for (int it = bid; it < 2176 + 2176 + nqk; it += G) {
          if (it < 2176) gla_pre(sw, p, it, smem);
          else if (it < 4352) {
            int t = it - 2176; int mc = t % NCH; int bh = t / NCH; int b = bh >> 3, h = bh & 7;
            transpose64x128(sw, Zb + (size_t)(b * TPB + mc * 64) * LDZ1 + 2048 + h * 128, LDZ1,
                            (bf16_t*)(R2 + R1_VT) + ((size_t)bh * 128) * TPS + mc * 64, smem);
          } else prep1_qk(sw, p, it - 4352);
        }
      }
    if (14 + 1 < ph1) gbar(sw, gb_cnt, gb_gen, gridDim.x, ++epoch);
  }
  if (ph0 <= 15 && 15 < ph1) {
    {
        int* ctr = (int*)(ws + OFF_CTR) + (ph0 == 15 ? 3 : 1);
        char* slot = smem_all + SMEM_BYTES - 16;
        while (true) {
          const int it = fetch_item(sw, ctr, slot);
          if (it >= 64 + 1024) break;
          if (it < 64) scan_chain<false>(sw, p, 2 * it + vb, smem);
          else {
            const int t = it - 64, qb = t & 15, bhm = t >> 4, b = bhm >> 4, hm = bhm & 15;
            const size_t r0 = (size_t)b * TPB + CTX + qb * 256;
            float gq = 0.f, gk = 0.f;
            for (int i = lane_id(); i < 128; i += 64) { gq = fmaxf(gq, fabsf(p.diff_q_norm[i])); gk = fmaxf(gk, fabsf(p.diff_k_norm[i])); }
#pragma unroll
            for (int o2 = 32; o2 > 0; o2 >>= 1) { gq = fmaxf(gq, __shfl_xor(gq, o2)); gk = fmaxf(gk, __shfl_xor(gk, o2)); }
            const float negB = -(0.125f * LOG2E * 64.f) * gq * gk;
            attn256_item<64>(sw, Zb + r0 * LDZ1 + hm * 64, LDZ1,
                             Zb + (size_t)b * TPB * LDZ1 + 1024 + hm * 64, LDZ1,
                             (const bf16_t*)(R2 + R1_VT) + ((size_t)(b * 8 + (hm >> 1)) * 128) * TPS,
                             Hb + r0 * LDH + hm * 128, LDH, TPB, negB, smem_all);
          }
        }
      }
    if (15 + 1 < ph1) gbar(sw, gb_cnt, gb_gen, gridDim.x, ++epoch);
  }
  if (ph0 <= 16 && 16 < ph1) {
    if (lane_id() == 0 && (sw & 3) == 0) *(volatile unsigned*)(smem + VB_CTR_OFF) = 0u;
    __syncthreads();
    {
        const int nf = NT / 4;
        for (int it = bid; it < CVT_FFN_ITEMS + nf; it += G) {
          if (it < CVT_FFN_ITEMS) cvt_ffn(sw, p, 1, it, (float*)smem);
          else fin1(sw, p, it - CVT_FFN_ITEMS);
        }
      }
    if (16 + 1 < ph1) gbar(sw, gb_cnt, gb_gen, gridDim.x, ++epoch);
  }
  if (ph0 <= 17 && 17 < ph1) {
    {
        EpiResid e{p.out, (float*)(ws + OFF_CTXRES), mod1 + 2 * D, nullptr};
        gemm256_phase<1>(sw, wmix + WM_OUT, LDW, MIXb, LDH, D, 8, smem_all, e);
      }
    if (17 + 1 < ph1) gbar(sw, gb_cnt, gb_gen, gridDim.x, ++epoch);
  }
  if (ph0 <= 18 && 18 < ph1) {
    modulate_phase(sw, p, p.norm_ffn_g + D, mod1, 3, 4, Hb);
    if (18 + 1 < ph1) gbar(sw, gb_cnt, gb_gen, gridDim.x, ++epoch);
  }
  if (ph0 <= 19 && 19 < ph1) {
    {
        EpiSwiglu e{Zb};
        gemm256_phase<1>(sw, (const bf16_t*)(R2 + RF_GU), LDW, Hb, LDH, D, 44, smem_all, e);
      }
    if (19 + 1 < ph1) gbar(sw, gb_cnt, gb_gen, gridDim.x, ++epoch);
  }
  if (ph0 <= 20 && 20 < ph1) {
    {
        EpiResid e{p.out, (float*)(ws + OFF_CTXRES), mod1 + 5 * D, nullptr};
        gemm256_phase<1>(sw, (const bf16_t*)(R2 + RF_D), LDWF, Zb, LDG, FFN, 8, smem_all, e);
      }
  }
  if (ph0 <= 21 && 21 < ph1) { for (int it = bid; it < 128; it += G) scan_chain<true>(sw, p, it, smem); }
  if (ph0 <= 23 && 23 < ph1) { for (int it = bid; it < 128; it += G) scan_chain<false>(sw, p, it, smem); }
}

extern "C" void kernel_launch(void* const* d_in, const int* in_sizes, int n_in, void* d_out, int out_size, void* d_ws, size_t ws_size, hipStream_t stream) {
  static int grid_blocks = 0;
  if (!grid_blocks) {
    int dev = 0, cus = 0, per_cu = 0;
    hipGetDevice(&dev);
    hipDeviceGetAttribute(&cus, hipDeviceAttributeMultiprocessorCount, dev);
    hipOccupancyMaxActiveBlocksPerMultiprocessor(&per_cu, mega, 512, 0);
    if (per_cu > 1) per_cu = 1;
    if (per_cu < 1) per_cu = 1;
    grid_blocks = cus * per_cu;
    grid_blocks -= grid_blocks % 8;
  }
  if (ws_size < WS_NEED) { fprintf(stderr, "workspace too small: %zu < %zu\n", ws_size, (size_t)WS_NEED); return; }
  P p{};
  const float** pp = (const float**)&p;
  for (int i = 0; i < 32; ++i) pp[i] = (const float*)d_in[i];
  p.out = (float*)d_out;
  p.ws = (char*)d_ws;
#ifndef PROBE_PHASE
  int ph0 = 0, ph1 = NPHASE;
  void* args[] = {&p, &ph0, &ph1};
  hipError_t e = hipLaunchCooperativeKernel((void*)mega, dim3(grid_blocks), dim3(512), args, 0, stream);
  if (e != hipSuccess) fprintf(stderr, "cooperative launch failed: %s (grid %d)\n", hipGetErrorString(e), grid_blocks);
#else
  int segs[3][2] = {{0, PROBE_AFTER + 1}, {PROBE_PHASE, PROBE_PHASE + 1}, {PROBE_AFTER + 1, NPHASE}};
  for (int s = 0; s < 3; ++s) {
    void* args[] = {&p, &segs[s][0], &segs[s][1]};
    hipError_t e = hipLaunchCooperativeKernel((void*)mega, dim3(grid_blocks), dim3(512), args, 0, stream);
    if (e != hipSuccess) fprintf(stderr, "cooperative launch failed: %s (grid %d)\n", hipGetErrorString(e), grid_blocks);
  }
#endif
}
```

```cpp
#include <hip/hip_runtime.h>
#include <hip/hip_cooperative_groups.h>
#include <cstdio>
#include <cstdint>
namespace cg = cooperative_groups;

#define DEVI __device__ __forceinline__
typedef unsigned short bf16_t;
typedef short bf16x8 __attribute__((ext_vector_type(8)));
typedef short bf16x4 __attribute__((ext_vector_type(4)));
typedef float f32x4 __attribute__((ext_vector_type(4)));
typedef float f32x2 __attribute__((ext_vector_type(2)));
typedef unsigned u32x4 __attribute__((ext_vector_type(4)));
typedef unsigned u32x2 __attribute__((ext_vector_type(2)));
typedef __bf16 bfv2 __attribute__((ext_vector_type(2)));

constexpr int D = 2048, NB = 4, SEQ = 4096, CTX = 256, TPB = SEQ + CTX  , NT = NB * TPB  ;
constexpr int NCH = TPB / 64;
constexpr int FFN = 5632;
constexpr int AB_IN = 5216, AB_INP = 5376, CD_IN = 6176, CD_INP = 6400;
constexpr int MODN = 6 * D;
constexpr int LDH = 2112, LDZ0 = 5440, LDZ1 = 6464, LDG = 5696, LDW = 2112, LDW5 = 576, LDWF = 5696, LDK = 1600, LDQA = 576, TPS = 4416;
constexpr float EPS = 1e-6f;
constexpr float LOG2E = 1.4426950408889634f;

constexpr size_t OFF_CTR = 0;
constexpr size_t OFF_MOD = 4096;
constexpr size_t OFF_CTXRES = OFF_MOD + (size_t)2 * 5 * MODN * 4;
constexpr size_t OFF_WMIX = OFF_CTXRES + (size_t)NB * CTX * D * 4;
constexpr size_t OFF_H = OFF_WMIX + (size_t)41943040;
constexpr size_t OFF_MIX = OFF_H + (size_t)NT * LDH * 2;
constexpr size_t OFF_Z = OFF_MIX + (size_t)NT * LDH * 2;
constexpr size_t OFF_R2 = OFF_Z + (size_t)NT * LDZ1 * 2;
constexpr size_t SZ_T = (size_t)4096 * TPS * 2;
constexpr size_t SZ_TOK1024 = (size_t)NT * 1024 * 2;
constexpr size_t WM_IN = 0;
constexpr size_t WM_OUT = (size_t)CD_INP * LDW;
constexpr size_t WM_UQ = WM_OUT + (size_t)D * LDW;
constexpr size_t WM_UKV = WM_UQ + (size_t)1536 * LDW5;
static_assert((WM_UKV + (size_t)2048 * LDW5) * 2 <= 41943040, "wmix");
constexpr size_t R_QUP = 0;
constexpr size_t R_K = R_QUP + (size_t)NT * 1536 * 2;
constexpr size_t R_VT = R_K + (size_t)NT * LDK * 2;
constexpr size_t R_GQ = R_VT + SZ_T;
constexpr size_t R_GK = R_GQ + SZ_TOK1024;
constexpr size_t R_GKT = R_GK + SZ_TOK1024;
constexpr size_t R_GVT = R_GKT + SZ_T;
constexpr size_t R_TM = R_GVT + SZ_T;
constexpr size_t R_QKM = R_TM + SZ_TOK1024;
constexpr size_t R_GC = R_QKM + SZ_TOK1024;
constexpr size_t R_BETA = R_GC + (size_t)NT * 16 * 4;
constexpr size_t R_GATES = R_BETA + (size_t)NT * 16 * 4;
constexpr size_t R_END0 = R_GATES + (size_t)NT * 32 * 4;
constexpr size_t R1_VT = 0;
constexpr size_t R1_QG = R1_VT + SZ_T;
constexpr size_t R1_KGT = R1_QG + SZ_TOK1024;
constexpr size_t R1_VTG = R1_KGT + SZ_T;
constexpr size_t R1_AM = R1_VTG + SZ_T;
constexpr size_t R1_EL = R1_AM + (size_t)2176 * 4096 * 2;
constexpr size_t R1_GATES = R1_EL + (size_t)2176 * 128 * 4;
constexpr size_t R1_REC = R1_GATES + (size_t)NT * 32 * 4;
constexpr size_t R1_END = R1_REC + 2 * SZ_TOK1024;
constexpr size_t RF_GU = 0;
constexpr size_t RF_D = RF_GU + (size_t)2 * FFN * LDW * 2;
static_assert(RF_D + (size_t)D * LDWF * 2 <= R1_KGT, "ffn overlay L1");
static_assert(RF_D + (size_t)D * LDWF * 2 <= R_VT, "ffn overlay L0");
static_assert(NT * (size_t)LDG * 2 <= NT * (size_t)LDZ1 * 2, "G fits Z");
constexpr size_t R_PART = (size_t)128 << 20;
constexpr size_t WS_NEED = OFF_R2 + (R_END0 > R1_END ? R_END0 : R1_END);
static_assert(WS_NEED <= (size_t)805306368, "ws");

struct P {
  const float *x, *c, *ctx, *c_ctx, *ada_w, *ada_b, *norm_mix_g, *norm_ffn_g, *ffn_w_gate, *ffn_w_up, *ffn_w_down;
  const float *ab_w_in, *mla_q_a_norm, *mla_w_uq, *mla_kv_a_norm, *mla_w_ukv, *mla_q_norm, *mla_k_norm;
  const float *gdn_conv_w, *gdn_a_log, *gdn_dt_bias, *gdn_out_norm, *ab_w_out;
  const float *cd_w_in, *diff_q_norm, *diff_k_norm, *diff_lambda, *diff_sub_norm, *gla_gate_w2, *gla_gate_b2, *gla_out_norm, *cd_w_out;
  float* out;
  char* ws;
};

DEVI unsigned pk2(float lo, float hi) { f32x2 v = {lo, hi}; bfv2 b = __builtin_convertvector(v, bfv2); return __builtin_bit_cast(unsigned, b); }
DEVI float bflo(unsigned u) { return __uint_as_float(u << 16); }
DEVI float bfhi(unsigned u) { return __uint_as_float(u & 0xffff0000u); }
DEVI float bf2f(bf16_t h) { return __uint_as_float(((unsigned)h) << 16); }
DEVI bf16_t f2bf(float f) { return (bf16_t)(pk2(f, 0.f) & 0xffffu); }
DEVI f32x4 mfma16(bf16x8 a, bf16x8 b, f32x4 c) { return __builtin_amdgcn_mfma_f32_16x16x32_bf16(a, b, c, 0, 0, 0); }
DEVI bf16x8 pack8(f32x4 a, f32x4 b) { u32x4 u = {pk2(a[0], a[1]), pk2(a[2], a[3]), pk2(b[0], b[1]), pk2(b[2], b[3])}; return __builtin_bit_cast(bf16x8, u); }
DEVI u32x2 pack4(f32x4 a) { u32x2 u = {pk2(a[0], a[1]), pk2(a[2], a[3])}; return u; }
DEVI bf16x8 cat8(u32x2 lo, u32x2 hi) { u32x4 u = {lo[0], lo[1], hi[0], hi[1]}; return __builtin_bit_cast(bf16x8, u); }
DEVI float wave_sum(float v) {
#pragma unroll
  for (int o = 32; o > 0; o >>= 1) v += __shfl_xor(v, o);
  return v;
}
DEVI float silu_f(float v) { return v * __builtin_amdgcn_rcpf(1.f + __expf(-v)); }
DEVI float* xrow(const P& p, int r) {
  int b = r / TPB, q = r - b * TPB;
  return q < CTX ? (float*)(p.ws + OFF_CTXRES) + (size_t)(b * CTX + q) * D : p.out + (size_t)(b * SEQ + q - CTX) * D;
}
DEVI int modidx(int r) { int b = r / TPB; return (r - b * TPB) < CTX ? 4 : b; }
DEVI bf16x8 ldsperm(const bf16_t* base, int row, int stride, int ks, int fq) {
  const bf16_t* p = base + row * stride + ks * 32 + fq * 4;
  u32x2 lo = *(const u32x2*)p, hi = *(const u32x2*)(p + 16);
  return cat8(lo, hi);
}

DEVI int lane_id() { int l; asm volatile("v_mbcnt_lo_u32_b32 %0, -1, 0\n\tv_mbcnt_hi_u32_b32 %0, -1, %0" : "=v"(l)); return l; }
#define VT ((((sw) & 3) << 6) | lane_id())
constexpr int VB_CTR_OFF = 75776 - 32;
DEVI void vbar(const void* vbase) {
  typedef __attribute__((address_space(3))) unsigned lds_u32;
  lds_u32* ctr = (lds_u32*)(size_t)(unsigned)(size_t)(__attribute__((address_space(3))) const char*)((const char*)vbase + VB_CTR_OFF);
  __builtin_amdgcn_fence(__ATOMIC_RELEASE, "workgroup");
  asm volatile("s_waitcnt vmcnt(0) lgkmcnt(0)" ::: "memory");
  unsigned old = 0;
  if (lane_id() == 0) old = __hip_atomic_fetch_add(ctr, 1u, __ATOMIC_RELAXED, __HIP_MEMORY_SCOPE_WORKGROUP);
  const unsigned gen = (unsigned)__builtin_amdgcn_readfirstlane((int)old) >> 2;
  while ((__hip_atomic_load(ctr, __ATOMIC_RELAXED, __HIP_MEMORY_SCOPE_WORKGROUP) >> 2) == gen) __builtin_amdgcn_s_sleep(1);
  __builtin_amdgcn_fence(__ATOMIC_ACQUIRE, "workgroup");
  asm volatile("" ::: "memory");
}
struct EpiStore {
  bf16_t* C; int ldc; float* side; int side_c0;
  DEVI void operator()(const f32x4 (&acc)[8][4], int nb, int mb, int fr, int fq, int pk) const {
#pragma unroll
    for (int ni = 0; ni < 4; ++ni) {
      const int m = mb + ni * 16 + fr;
#pragma unroll
      for (int mi = 0; mi < 8; ++mi) {
        const int n = nb + mi * 16 + fq * 4;
        *(u32x2*)(C + (size_t)m * ldc + n) = pack4(acc[mi][ni]);
        if (side && n >= side_c0 && n < side_c0 + 32) *(f32x4*)(side + (size_t)m * 32 + (n - side_c0)) = acc[mi][ni];
      }
      asm volatile("" ::: "memory");
    }
  }
};
struct EpiResid {
  float* out; float* ctxres; const float* gate; float* part;
  DEVI void operator()(const f32x4 (&acc)[8][4], int nb, int mb, int fr, int fq, int pk) const {
#pragma unroll
    for (int ni = 0; ni < 4; ++ni) {
      const int m = mb + ni * 16 + fr;
      int bb = m / TPB, qq = m - bb * TPB;
      float* xr = qq < CTX ? ctxres + (size_t)(bb * CTX + qq) * D : out + (size_t)(bb * SEQ + qq - CTX) * D;
      const float* g = gate + (size_t)(qq < CTX ? 4 : bb) * MODN;
#pragma unroll
      for (int mi = 0; mi < 8; ++mi) {
        const int n = nb + mi * 16 + fq * 4;
        const f32x4 gv = *(const f32x4*)(g + n);
        if (pk >= 0) {
          *(f32x4*)(part + ((size_t)(pk * (NB * CTX) + bb * CTX + qq)) * D + n) = acc[mi][ni];
        } else {
          f32x4 xv = *(f32x4*)(xr + n);
          xv += gv * acc[mi][ni];
          *(f32x4*)(xr + n) = xv;
        }
        if ((mi & 1) == 1) asm volatile("" ::: "memory");
      }
    }
  }
};
struct EpiProbe {
  float* dump; int flag;
  DEVI void operator()(const f32x4 (&acc)[8][4], int nb, int mb, int fr, int fq, int pk) const {
    if (flag) {
#pragma unroll
      for (int mi = 0; mi < 8; ++mi)
#pragma unroll
        for (int ni = 0; ni < 4; ++ni) *(f32x4*)(dump + (size_t)(mi * 4 + ni) * 4096 + (fr * 4 + fq) * 4) = acc[mi][ni];
    }
  }
};
struct EpiSwiglu {
  bf16_t* G;
  DEVI void operator()(const f32x4 (&acc)[8][4], int nb, int mb, int fr, int fq, int pk) const {
#pragma unroll
    for (int ni = 0; ni < 4; ++ni) {
      const int m = mb + ni * 16 + fr;
#pragma unroll
      for (int mi = 0; mi < 8; mi += 2) {
        const int R = nb + mi * 16;
        const int hc = (R >> 5) * 16 + fq * 4;
        f32x4 g = acc[mi][ni], u = acc[mi + 1][ni], o;
#pragma unroll
        for (int j = 0; j < 4; ++j) o[j] = silu_f(g[j]) * u[j];
        *(u32x2*)(G + (size_t)m * LDG + hc) = pack4(o);
      }
    }
  }
};
DEVI int lds_byte2(int r, int c) { int st = (r >> 4) * 2 + (c >> 5), ob = (r & 15) * 64 + (c & 31) * 2; return st * 1024 + (ob ^ (((ob >> 9) & 1) << 5)); }
DEVI void stage_rc2(int b, int& R, int& C) { int st = b >> 10, sb = b & 1023, swz = sb ^ (((sb >> 9) & 1) << 5); R = (st >> 1) * 16 + swz / 64; C = (st & 1) * 32 + (swz % 64) / 2; }

template <int MODE, class Epi>
DEVI void gemm256_phase(int sw, const bf16_t* __restrict__ W, int ldw, const bf16_t* __restrict__ X, int ldx, int K, int nN, char* shm, const Epi& epi) {
  constexpr int TILE_B = 256 * 64 * 2, STAGE_B = 2 * TILE_B;
  const int wid = sw, lane = lane_id(), wr = wid >> 2, wc = wid & 3, fr = lane & 15, fq = lane >> 4;
  const int lds_lo = (fr * 64 + fq * 16) ^ ((fr >> 3) << 5);
  unsigned offW[4], offX[4];
#pragma unroll
  for (int i = 0; i < 4; ++i) { int R, C; stage_rc2(wid * 1024 + i * 8192 + lane * 16, R, C); offW[i] = (unsigned)(R * ldw + C) * 2u; offX[i] = (unsigned)(R * ldx + C) * 2u; }
  const int ntf = K >> 6;
  const int nM = (MODE == 0 || MODE == 3) ? 68 : 64, nfull = nM * nN, nunits = MODE == 2 ? nfull + 256 : nfull;
  auto decode = [&](int L, int& n0, int& m0, int& kt0, int& ntk) {
    if (MODE == 2 && L >= nfull) {
      const int j = L - nfull, tile = j >> 3, ks = j & 7;
      n0 = (tile & 7) * 256; m0 = (tile >> 3) * 17 * 256; ntk = ntf >> 3; kt0 = ks * ntk;
    } else {
      int wgid = L;
      { const int q = nfull / 8, r = nfull % 8, xcd = wgid % 8, off = wgid / 8; wgid = (xcd < r ? xcd * (q + 1) : r * (q + 1) + (xcd - r) * q) + off; }
      constexpr int WGM = 4;
      const int nig = WGM * nN, gid = wgid / nig, fm = gid * WGM, gsz = (nM - fm) < WGM ? (nM - fm) : WGM;
      const int pm = fm + ((wgid % nig) % gsz), pn = (wgid % nig) / gsz;
      n0 = pn * 256; m0 = (MODE == 0 ? pm : (pm / 16) * 17 + 1 + (pm % 16)) * 256; kt0 = 0; ntk = ntf;
    }
    if (MODE == 3) { n0 = 0; m0 = 0; }
    n0 = __builtin_amdgcn_readfirstlane(n0); m0 = __builtin_amdgcn_readfirstlane(m0);
    kt0 = __builtin_amdgcn_readfirstlane(kt0); ntk = __builtin_amdgcn_readfirstlane(ntk);
  };
  auto stage = [&](int buf, int n0, int m0, int kt) {
    const char* wk = (const char*)(W + (size_t)n0 * ldw) + kt * 128;
    const char* xk = (const char*)(X + (size_t)m0 * ldx) + kt * 128;
#pragma unroll
    for (int i = 0; i < 4; ++i) {
      unsigned ow = offW[i], ox = offX[i];
      asm volatile("" : "+v"(ow), "+v"(ox));
      __builtin_amdgcn_global_load_lds((const unsigned*)(wk + ow), (unsigned*)(shm + buf * STAGE_B + wid * 1024 + i * 8192), 16, 0, 0);
      __builtin_amdgcn_global_load_lds((const unsigned*)(xk + ox), (unsigned*)(shm + buf * STAGE_B + TILE_B + wid * 1024 + i * 8192), 16, 0, 0);
    }
  };
  int L = blockIdx.x;
  if (L >= nunits) return;
  int n0, m0, kt0, ntk;
  decode(L, n0, m0, kt0, ntk);
  int b0 = 0;
  stage(0, n0, m0, kt0);
  asm volatile("s_waitcnt vmcnt(0)" ::: "memory");
  __syncthreads();
  while (true) {
    const int Ln = L + gridDim.x;
    const bool has_next = Ln < nunits;
    int n1 = 0, m1 = 0, kt1 = 0, ntk1 = 0;
    if (has_next) decode(Ln, n1, m1, kt1, ntk1);
    f32x4 acc[8][4];
#pragma unroll
    for (int i = 0; i < 8; ++i)
#pragma unroll
      for (int j = 0; j < 4; ++j) acc[i][j] = (f32x4){0.f, 0.f, 0.f, 0.f};
    for (int t = 0; t < ntk; ++t) {
      const int cur = (b0 + t) & 1;
      const bool st_own = t + 1 < ntk, st_next = !st_own && has_next;
      if (wid < 4) {
        if (st_own) stage(cur ^ 1, n0, m0, kt0 + t + 1);
        else if (st_next) stage(cur ^ 1, n1, m1, kt1);
      }
      const char* SAp = shm + cur * STAGE_B + wr * (16 * 1024) + lds_lo;
      const char* SBp = shm + cur * STAGE_B + TILE_B + wc * (8 * 1024) + lds_lo;
#pragma unroll
      for (int ks = 0; ks < 2; ++ks) {
        const int kx = (wid >> 2) ? (1 - 2 * ks) * 1024 : 0;
        bf16x8 At[8], Bf[4];
#pragma unroll
        for (int m = 0; m < 8; ++m) At[m] = *(const bf16x8*)(SAp + (2 * m + ks) * 1024 + kx);
#pragma unroll
        for (int n = 0; n < 4; ++n) Bf[n] = *(const bf16x8*)(SBp + (2 * n + ks) * 1024 + kx);
#pragma unroll
        for (int m = 0; m < 8; ++m)
#pragma unroll
          for (int n = 0; n < 4; ++n) acc[m][n] = mfma16(At[m], Bf[n], acc[m][n]);
        __builtin_amdgcn_sched_barrier(0);
        if (ks == 0 && wid >= 4) {
          if (st_own) stage(cur ^ 1, n0, m0, kt0 + t + 1);
          else if (st_next) stage(cur ^ 1, n1, m1, kt1);
        }
      }
      asm volatile("s_waitcnt vmcnt(0)" ::: "memory");
      __syncthreads();
    }
    epi(acc, n0 + wr * 128, m0 + wc * 64, fr, fq, (MODE == 2 && L >= nfull) ? ((L - nfull) & 7) : -1);
    if (!has_next) break;
    b0 = (b0 + ntk) & 1; L = Ln; n0 = n1; m0 = m1; kt0 = kt1; ntk = ntk1;
  }
}

DEVI void cvt_tile(int sw, const float* __restrict__ src, int ldn, int Nvalid, bf16_t* __restrict__ dst, int ldk, int kt, int nt, int rmul, int roff, float* sm) {
  const int tid = VT;
  const int k0 = kt * 64, n0 = nt * 64;
  vbar(sm);
  {
    const int n4 = (tid & 15) * 4, n = n0 + n4;
    f32x4 v[4];
#pragma unroll
    for (int i = 0; i < 4; ++i) {
      const int kk = (tid >> 4) + 16 * i;
      v[i] = (n < Nvalid) ? *(const f32x4*)(src + (size_t)(k0 + kk) * ldn + n) : (f32x4){0.f, 0.f, 0.f, 0.f};
    }
#pragma unroll
    for (int i = 0; i < 4; ++i) {
      const int kk = (tid >> 4) + 16 * i;
#pragma unroll
      for (int jj = 0; jj < 4; ++jj) sm[(n4 + jj) * 65 + kk] = v[i][jj];
    }
  }
  vbar(sm);
  {
    int nn = tid >> 2, kq = tid & 3, n = n0 + nn;
    int drow = (n >> 4) * rmul + roff + (n & 15);
    const float* s = sm + nn * 65 + kq * 16;
    u32x4 a = {pk2(s[0], s[1]), pk2(s[2], s[3]), pk2(s[4], s[5]), pk2(s[6], s[7])};
    u32x4 b = {pk2(s[8], s[9]), pk2(s[10], s[11]), pk2(s[12], s[13]), pk2(s[14], s[15])};
    bf16_t* d = dst + (size_t)drow * ldk + k0 + kq * 16;
    *(u32x4*)d = a; *(u32x4*)(d + 8) = b;
  }
}
DEVI bool cvt_try(int sw, int& idx, const float* src, int N, int Npad, bf16_t* dst, int K, int ldk, int rmul, int roff, float* sm) {
  int kts = K >> 6, n = kts * (Npad >> 6);
  if (idx < n) { cvt_tile(sw, src, N, N, dst, ldk, idx % kts, idx / kts, rmul, roff, sm); return true; }
  idx -= n; return false;
}
DEVI void cvt_ffn(int sw, const P& p, int layer, int idx, float* sm) {
  bf16_t* gu = (bf16_t*)(p.ws + OFF_R2 + RF_GU); bf16_t* dn = (bf16_t*)(p.ws + OFF_R2 + RF_D);
  if (cvt_try(sw, idx, p.ffn_w_gate + (size_t)layer * D * FFN, FFN, FFN, gu, D, LDW, 32, 0, sm)) return;
  if (cvt_try(sw, idx, p.ffn_w_up + (size_t)layer * D * FFN, FFN, FFN, gu, D, LDW, 32, 16, sm)) return;
  cvt_try(sw, idx, p.ffn_w_down + (size_t)layer * FFN * D, D, D, dn, FFN, LDWF, 16, 0, sm);
}
constexpr int CVT_FFN_ITEMS = 3 * (D / 64) * (FFN / 64);
constexpr int CVT_MIX0_ITEMS = 32 * 84 + 8 * 24 + 8 * 32 + 32 * 32;
constexpr int CVT_MIX1_ITEMS = 32 * 100 + 32 * 32;
DEVI void cvt_mix0(int sw, const P& p, int idx, float* sm) {
  bf16_t* w = (bf16_t*)(p.ws + OFF_WMIX);
  if (cvt_try(sw, idx, p.ab_w_in, AB_IN, AB_INP, w + WM_IN, D, LDW, 16, 0, sm)) return;
  if (cvt_try(sw, idx, p.mla_w_uq, 1536, 1536, w + WM_UQ, 512, LDW5, 16, 0, sm)) return;
  if (cvt_try(sw, idx, p.mla_w_ukv, 2048, 2048, w + WM_UKV, 512, LDW5, 16, 0, sm)) return;
  cvt_try(sw, idx, p.ab_w_out, D, D, w + WM_OUT, D, LDW, 16, 0, sm);
}
DEVI void cvt_mix1(int sw, const P& p, int idx, float* sm) {
  bf16_t* w = (bf16_t*)(p.ws + OFF_WMIX);
  if (cvt_try(sw, idx, p.cd_w_in, CD_IN, CD_INP, w + WM_IN, D, LDW, 16, 0, sm)) return;
  cvt_try(sw, idx, p.cd_w_out, D, D, w + WM_OUT, D, LDW, 16, 0, sm);
}

DEVI void ada_item(int sw, const P& p, int item, float* sm) {
  const int tid = VT;
  const int l = item / 192, cb = item % 192;
  float* sc = sm;
  float* red = sm + 5 * 2048;
  vbar(sm);
  for (int i = tid; i < 5 * 2048; i += 256) {
    int s5 = i >> 11, k = i & 2047;
    float v = s5 < 4 ? p.c[s5 * D + k] : p.c_ctx[k];
    sc[i] = silu_f(v);
  }
  vbar(sm);
  const int ct = tid & 15, kg = tid >> 4;
  const float* w = p.ada_w + ((size_t)l * D + kg * 128) * MODN + cb * 64 + ct * 4;
  f32x4 a0 = {0.f, 0.f, 0.f, 0.f}, a1 = a0, a2 = a0, a3 = a0, a4 = a0;
#pragma unroll 16
  for (int k = 0; k < 128; ++k) {
    const f32x4 wv = *(const f32x4*)(w + (size_t)k * MODN);
    const int kk = kg * 128 + k;
    a0 += sc[kk] * wv; a1 += sc[2048 + kk] * wv; a2 += sc[4096 + kk] * wv; a3 += sc[6144 + kk] * wv; a4 += sc[8192 + kk] * wv;
  }
  *(f32x4*)(red + (kg * 5 + 0) * 64 + ct * 4) = a0; *(f32x4*)(red + (kg * 5 + 1) * 64 + ct * 4) = a1; *(f32x4*)(red + (kg * 5 + 2) * 64 + ct * 4) = a2;
  *(f32x4*)(red + (kg * 5 + 3) * 64 + ct * 4) = a3; *(f32x4*)(red + (kg * 5 + 4) * 64 + ct * 4) = a4;
  vbar(sm);
  for (int i = tid; i < 5 * 64; i += 256) {
    int s5 = i >> 6, cc = i & 63;
    float v = 0.f;
#pragma unroll
    for (int g = 0; g < 16; ++g) v += red[(g * 5 + s5) * 64 + cc];
    int n = cb * 64 + cc;
    ((float*)(p.ws + OFF_MOD))[((size_t)l * 5 + s5) * MODN + n] = v + p.ada_b[(size_t)l * MODN + n];
  }
}

DEVI void modulate_phase(int sw, const P& p, const float* g, const float* modl, int shift_i, int scale_i, bf16_t* H, const float* part = nullptr, const float* gate_ctx = nullptr, bool from_input = false) {
  const int lane = VT & 63;
  const int gw = (blockIdx.x * 2 + (sw >> 2)) * 4 + (sw & 3), nw = gridDim.x * 8;
  for (int r = gw; r < NT; r += nw) {
    const float* xr = xrow(p, r);
    if (from_input) { const int bb = r / TPB, qq = r - bb * TPB; xr = qq < CTX ? p.ctx + (size_t)(bb * CTX + qq) * D : p.x + (size_t)(bb * SEQ + qq - CTX) * D; }
    const float* mb = modl + (size_t)modidx(r) * MODN;
    f32x4 v[8]; float ss = 0.f;
#pragma unroll
    for (int i = 0; i < 8; ++i) v[i] = *(const f32x4*)(xr + i * 256 + lane * 4);
    if (part && modidx(r) == 4) {
      const int cr = (r / TPB) * CTX + (r % TPB);
#pragma unroll
      for (int i = 0; i < 8; ++i) {
        f32x4 sacc = {0.f, 0.f, 0.f, 0.f};
#pragma unroll
        for (int ks = 0; ks < 8; ++ks) sacc += *(const f32x4*)(part + ((size_t)(ks * (NB * CTX) + cr)) * D + i * 256 + lane * 4);
        v[i] += *(const f32x4*)(gate_ctx + i * 256 + lane * 4) * sacc;
        *(f32x4*)(xrow(p, r) + i * 256 + lane * 4) = v[i];
      }
    }
    if (from_input) {
      float* xw = xrow(p, r);
#pragma unroll
      for (int i = 0; i < 8; ++i) *(f32x4*)(xw + i * 256 + lane * 4) = v[i];
    }
#pragma unroll
    for (int i = 0; i < 8; ++i) ss += v[i][0] * v[i][0] + v[i][1] * v[i][1] + v[i][2] * v[i][2] + v[i][3] * v[i][3];
    ss = wave_sum(ss);
    float rs = rsqrtf(ss * (1.f / D) + EPS);
#pragma unroll
    for (int i = 0; i < 8; ++i) {
      int cidx = i * 256 + lane * 4;
      f32x4 gg = *(const f32x4*)(g + cidx), sh = *(const f32x4*)(mb + shift_i * D + cidx), sc = *(const f32x4*)(mb + scale_i * D + cidx);
      f32x4 y;
#pragma unroll
      for (int j = 0; j < 4; ++j) y[j] = v[i][j] * rs * gg[j] * (1.f + sc[j]) + sh[j];
      *(u32x2*)(H + (size_t)r * LDH + cidx) = pack4(y);
    }
  }
}

template <int DQK>
DEVI void attn256_item(int sw, const bf16_t* __restrict__ Q, int ldq, const bf16_t* __restrict__ Kp, int ldk, const bf16_t* __restrict__ Vt,
                       bf16_t* __restrict__ O, int ldo, int nkeys, float negB, char* shm) {
  constexpr int KS = DQK / 32, KCH = DQK / 8, KBYTES = 64 * DQK * 2, STG = KBYTES + 16384, NKI = (64 * KCH) / 512;
  const int wid = sw, lane = lane_id(), fr = lane & 15, fq = lane >> 4, rsw = (fr >> 1) & 7;
  unsigned offK[NKI], offV[2];
#pragma unroll
  for (int i = 0; i < NKI; ++i) {
    const int q = (wid * NKI + i) * 64 + lane, row = q / KCH, cp = q - row * KCH;
    const int c = (cp & ~7) | ((cp & 7) ^ ((row >> 1) & 7));
    offK[i] = (unsigned)(row * ldk + c * 8) * 2u;
  }
#pragma unroll
  for (int i = 0; i < 2; ++i) {
    const int q = (wid * 2 + i) * 64 + lane, row = q >> 3, cp = q & 7;
    const int c = cp ^ ((row >> 1) & 7);
    offV[i] = (unsigned)(row * TPS + c * 8) * 2u;
  }
  auto stage = [&](int buf, int k0) {
    const char* kb = (const char*)(Kp + (size_t)k0 * ldk);
    const char* vb = (const char*)(Vt + k0);
#pragma unroll
    for (int i = 0; i < NKI; ++i) {
      unsigned o = offK[i]; asm volatile("" : "+v"(o));
      __builtin_amdgcn_global_load_lds((const unsigned*)(kb + o), (unsigned*)(shm + buf * STG + (wid * NKI + i) * 1024), 16, 0, 0);
    }
#pragma unroll
    for (int i = 0; i < 2; ++i) {
      unsigned o = offV[i]; asm volatile("" : "+v"(o));
      __builtin_amdgcn_global_load_lds((const unsigned*)(vb + o), (unsigned*)(shm + buf * STG + KBYTES + (wid * 2 + i) * 1024), 16, 0, 0);
    }
  };
  bf16x8 qf[2][KS];
#pragma unroll
  for (int nt = 0; nt < 2; ++nt)
#pragma unroll
    for (int ks = 0; ks < KS; ++ks) qf[nt][ks] = *(const bf16x8*)(Q + (size_t)(wid * 32 + nt * 16 + fr) * ldq + ks * 32 + fq * 8);
  f32x4 o[8][2];
#pragma unroll
  for (int i = 0; i < 8; ++i) { o[i][0] = (f32x4){0.f, 0.f, 0.f, 0.f}; o[i][1] = (f32x4){0.f, 0.f, 0.f, 0.f}; }
  float l_[2] = {0.f, 0.f};
  const int ntile = nkeys >> 6;
  __syncthreads();
  stage(0, 0);
  asm volatile("s_waitcnt vmcnt(0)" ::: "memory");
  __syncthreads();
  for (int t = 0; t < ntile; ++t) {
    const int cur = t & 1;
    if (wid < 4 && t + 1 < ntile) stage(cur ^ 1, (t + 1) * 64);
    const bf16_t* Ks = (const bf16_t*)(shm + cur * STG);
    const char* Vs = shm + cur * STG + KBYTES;
#pragma unroll
    for (int half = 0; half < 2; ++half) {
      f32x4 s[2][2];
#pragma unroll
      for (int i = 0; i < 2; ++i) { s[i][0] = (f32x4){negB, negB, negB, negB}; s[i][1] = (f32x4){negB, negB, negB, negB}; }
#pragma unroll
      for (int ks = 0; ks < KS; ++ks)
#pragma unroll
        for (int kt = 0; kt < 2; ++kt) {
          const int krow = half * 32 + 8 * (fr >> 2) + 4 * kt + (fr & 3);
          const int ksw = (krow >> 1) & 7;
          bf16x8 kf = *(const bf16x8*)(Ks + krow * DQK + ((((ks * 4 + fq) & ~7) | (((ks * 4 + fq) & 7) ^ ksw)) * 8));
          s[kt][0] = mfma16(kf, qf[0][ks], s[kt][0]);
          s[kt][1] = mfma16(kf, qf[1][ks], s[kt][1]);
        }
      bf16x8 pf[2];
#pragma unroll
      for (int nt = 0; nt < 2; ++nt) {
        float rs = 0.f;
#pragma unroll
        for (int kt = 0; kt < 2; ++kt)
#pragma unroll
          for (int j = 0; j < 4; ++j) { float pv = __builtin_amdgcn_exp2f(s[kt][nt][j]); s[kt][nt][j] = pv; rs += pv; }
        l_[nt] += rs;
        pf[nt] = pack8(s[0][nt], s[1][nt]);
      }
#pragma unroll
      for (int dt = 0; dt < 8; ++dt) {
        bf16x8 vf = *(const bf16x8*)(Vs + (dt * 16 + fr) * 128 + (((half * 4 + fq) ^ rsw) * 16));
        o[dt][0] = mfma16(vf, pf[0], o[dt][0]);
        o[dt][1] = mfma16(vf, pf[1], o[dt][1]);
      }
      if (half == 0 && wid >= 4 && t + 1 < ntile) stage(cur ^ 1, (t + 1) * 64);
    }
    asm volatile("s_waitcnt vmcnt(0)" ::: "memory");
    __syncthreads();
  }
#pragma unroll
  for (int nt = 0; nt < 2; ++nt) {
    float l = l_[nt];
    l += __shfl_xor(l, 16); l += __shfl_xor(l, 32);
    float inv = 1.f / l;
#pragma unroll
    for (int dt = 0; dt < 8; ++dt) {
      f32x4 v = o[dt][nt] * inv;
      *(u32x2*)(O + (size_t)(wid * 32 + nt * 16 + fr) * ldo + dt * 16 + fq * 4) = pack4(v);
    }
  }
}

DEVI void prep0_norm512(int sw, const P& p, int item) {
  const int lane = lane_id();
  const int w0 = (item * 4 + (sw & 3)) * 8;
  u32x4 u[8];
#pragma unroll
  for (int q = 0; q < 8; ++q) { int w = w0 + q, r = w >> 1, which = w & 1; u[q] = *(const u32x4*)((const bf16_t*)(p.ws + OFF_Z) + (size_t)r * LDZ0 + which * 512 + lane * 8); }
#pragma unroll
  for (int q = 0; q < 8; ++q) {
    int w = w0 + q, r = w >> 1, which = w & 1;
    float v[8] = {bflo(u[q][0]), bfhi(u[q][0]), bflo(u[q][1]), bfhi(u[q][1]), bflo(u[q][2]), bfhi(u[q][2]), bflo(u[q][3]), bfhi(u[q][3])};
    float ss = 0.f;
#pragma unroll
    for (int j = 0; j < 8; ++j) ss += v[j] * v[j];
    ss = wave_sum(ss);
    float rs = rsqrtf(ss * (1.f / 512.f) + EPS);
    const float* g = (which ? p.mla_kv_a_norm : p.mla_q_a_norm) + lane * 8;
    u32x4 o = {pk2(v[0] * rs * g[0], v[1] * rs * g[1]), pk2(v[2] * rs * g[2], v[3] * rs * g[3]), pk2(v[4] * rs * g[4], v[5] * rs * g[5]), pk2(v[6] * rs * g[6], v[7] * rs * g[7])};
    *(u32x4*)((bf16_t*)(p.ws + OFF_H) + (size_t)which * NT * LDQA + (size_t)r * LDQA + lane * 8) = o;
  }
}
DEVI void store_T(int sw, const bf16_t* T, bf16_t* __restrict__ dst) {
  const int tid = VT;
#pragma unroll
  for (int i = 0; i < 4; ++i) {
    const int c = tid + 256 * i, row = c >> 3, ch = c & 7;
    *(u32x4*)(dst + (size_t)row * TPS + ch * 8) = *(const u32x4*)(T + row * 72 + ch * 8);
  }
}
DEVI void put_T(bf16_t* T, int d, int half, const float (&y)[32]) {
#pragma unroll
  for (int i = 0; i < 4; ++i) {
    u32x4 u = {pk2(y[8 * i], y[8 * i + 1]), pk2(y[8 * i + 2], y[8 * i + 3]), pk2(y[8 * i + 4], y[8 * i + 5]), pk2(y[8 * i + 6], y[8 * i + 7])};
    *(u32x4*)(T + d * 72 + half * 32 + 8 * i) = u;
  }
}
DEVI void prep0_gdn(int sw, const P& p, int item, float* sm) {
  const int tid = VT;
  const int which = item & 3; int t = item >> 2;
  const int mc = t % NCH; t /= NCH;
  const int h = t & 7, b = t >> 3;
  const int p0 = mc * 64;
  const int bh = b * 8 + h;
  char* R2 = p.ws + OFF_R2;
  if (which == 3) {
    if (tid < 128) {
      const int dir = tid >> 6, ln = tid & 63;
      const int c = dir ? 63 - ln : ln;
      const float* gr = (const float*)(R2 + R_GATES) + (size_t)(b * TPB + p0 + c) * 32;
      const float A = __expf(p.gdn_a_log[dir * 8 + h]), dtb = p.gdn_dt_bias[dir * 8 + h];
      const float a = gr[dir * 8 + h] + dtb, bb = gr[16 + dir * 8 + h];
      const float sp = fmaxf(a, 0.f) + log1pf(__expf(-fabsf(a)));
      float v = -A * sp;
#pragma unroll
      for (int off = 1; off < 64; off <<= 1) { float t2 = __shfl_up(v, off); if (ln >= off) v += t2; }
      ((float*)(R2 + R_GC))[(size_t)(bh * 2 + dir) * TPB + p0 + c] = v;
      ((float*)(R2 + R_BETA))[(size_t)(bh * 2 + dir) * TPB + p0 + c] = 1.f / (1.f + __expf(-bb));
    }
    vbar(sm);
    return;
  }
  const int d = tid & 127, half = tid >> 7;
  const int col0 = 1088 + which * 1024 + h * 128;
  const int col = col0 + d;
  const int lo = p0 < CTX ? 0 : CTX, hi = p0 < CTX ? CTX : TPB;
  bf16_t* xin = (bf16_t*)sm;
  float* sq = (float*)(xin + 72 * 128);
  float* nrm = sq + 64 * 129;
  bf16_t* yb = (bf16_t*)(nrm + 64);
  vbar(sm);
  {
    const bf16_t* zb = (const bf16_t*)(p.ws + OFF_Z) + (size_t)(b * TPB) * LDZ0 + col0;
    for (int c = tid; c < 68 * 16; c += 256) {
      const int row = c >> 4, ch = c & 15, pp = p0 - 2 + row;
      u32x4 v = {0u, 0u, 0u, 0u};
      if (pp >= lo && pp < hi) v = *(const u32x4*)(zb + (size_t)pp * LDZ0 + ch * 8);
      *(u32x4*)(xin + row * 128 + ch * 8) = v;
    }
  }
  vbar(sm);
  const float w0 = p.gdn_conv_w[0 * 3072 + col - 1088], w1 = p.gdn_conv_w[1 * 3072 + col - 1088], w2 = p.gdn_conv_w[2 * 3072 + col - 1088],
              w3 = p.gdn_conv_w[3 * 3072 + col - 1088], w4 = p.gdn_conv_w[4 * 3072 + col - 1088];
  const int ps = p0 + half * 32;
  const bf16_t* xc = xin + (half * 32) * 128 + d;
  float xm2 = bf2f(xc[0]), xm1 = bf2f(xc[128]), x0 = bf2f(xc[256]), xp1 = bf2f(xc[384]);
  float y[32];
#pragma unroll
  for (int i = 0; i < 32; ++i) {
    float xp2 = bf2f(xc[(i + 4) * 128]);
    float a = w0 * xm2 + w1 * xm1 + w2 * x0 + w3 * xp1 + w4 * xp2;
    y[i] = silu_f(a);
    xm2 = xm1; xm1 = x0; x0 = xp1; xp1 = xp2;
  }
  if (which == 2) {
    vbar(sm);
    put_T(xin, d, half, y);
    vbar(sm);
    store_T(sw, xin, (bf16_t*)(R2 + R_GVT) + ((size_t)bh * 128) * TPS + p0);
    return;
  }
#pragma unroll
  for (int i = 0; i < 32; ++i) sq[(half * 32 + i) * 129 + d] = y[i] * y[i];
  vbar(sm);
  {
    int c = tid >> 2, part = tid & 3;
    float sacc = 0.f;
    for (int i = 0; i < 32; ++i) sacc += sq[c * 129 + part * 32 + i];
    sacc += __shfl_xor(sacc, 1); sacc += __shfl_xor(sacc, 2);
    if (part == 0) nrm[c] = rsqrtf(sacc + EPS) * (which == 0 ? 0.08838834764831845f : 1.f);
  }
  vbar(sm);
#pragma unroll
  for (int i = 0; i < 32; ++i) { y[i] *= nrm[half * 32 + i]; yb[(half * 32 + i) * 136 + d] = f2bf(y[i]); }
  if (which == 1) put_T(xin, d, half, y);
  vbar(sm);
  if (which == 1) store_T(sw, xin, (bf16_t*)(R2 + R_GKT) + ((size_t)bh * 128) * TPS + p0);
  {
    bf16_t* dq = (bf16_t*)(R2 + (which == 0 ? R_GQ : R_GK)) + ((size_t)bh * TPB + p0) * 128;
#pragma unroll
    for (int i = 0; i < 4; ++i) {
      const int c = tid + 256 * i, row = c >> 4, ch = c & 15;
      *(u32x4*)(dq + row * 128 + ch * 8) = *(const u32x4*)(yb + row * 136 + ch * 8);
    }
  }
}

DEVI float rope64(float val, int lane, int t) {
  int i = lane & 15, hf = (lane >> 4) & 1, axis = lane >> 5;
  float pos = (float)(axis ? (t & 63) : (t >> 6));
  float invf = exp2f(-(float)(2 * i) * (13.287712379549449f / 32.f));
  float ang = pos * invf;
  float cs = __cosf(ang), sn = __sinf(ang);
  float partner = __shfl_xor(val, 16);
  return hf ? (val * cs + partner * sn) : (val * cs - partner * sn);
}

DEVI void prep0_q(int sw, const P& p, int item) {
  const int lane = lane_id();
  const int w0 = (item * 4 + (sw & 3)) * 8;
  const int r = w0 >> 3;
  bf16_t* qb = (bf16_t*)(p.ws + OFF_R2 + R_QUP) + (size_t)r * 1536;
  float a[8], b[8], c[8];
#pragma unroll
  for (int h = 0; h < 8; ++h) { a[h] = bf2f(qb[h * 192 + lane]); b[h] = bf2f(qb[h * 192 + 64 + lane]); c[h] = bf2f(qb[h * 192 + 128 + lane]); }
  const float g0 = p.mla_q_norm[lane], g1 = p.mla_q_norm[64 + lane], g2 = p.mla_q_norm[128 + lane];
  const int pp = r % TPB;
  const float sc = 0.07216878364870322f * LOG2E;
#pragma unroll
  for (int h = 0; h < 8; ++h) {
    float ss = wave_sum(a[h] * a[h] + b[h] * b[h] + c[h] * c[h]);
    float rs = rsqrtf(ss * (1.f / 192.f) + EPS);
    float x = a[h] * rs * g0, y = b[h] * rs * g1, z = c[h] * rs * g2;
    if (pp >= CTX) z = rope64(z, lane, pp - CTX);
    qb[h * 192 + lane] = f2bf(x * sc); qb[h * 192 + 64 + lane] = f2bf(y * sc); qb[h * 192 + 128 + lane] = f2bf(z * sc);
  }
}
DEVI void prep0_k(int sw, const P& p, int item) {
  const int lane = lane_id();
  const int w0 = (item * 4 + (sw & 3)) * 8;
  const int r = w0 >> 3;
  const bf16_t* kv = (const bf16_t*)(p.ws + OFF_MIX) + (size_t)r * LDH;
  const float c0 = bf2f(((const bf16_t*)(p.ws + OFF_Z) + (size_t)r * LDZ0 + 1024)[lane]);
  float a[8], b[8];
#pragma unroll
  for (int h = 0; h < 8; ++h) { a[h] = bf2f(kv[h * 256 + lane]); b[h] = bf2f(kv[h * 256 + 64 + lane]); }
  const float g0 = p.mla_k_norm[lane], g1 = p.mla_k_norm[64 + lane], g2 = p.mla_k_norm[128 + lane];
  const int pp = r % TPB;
  bf16_t* k = (bf16_t*)(p.ws + OFF_R2 + R_K) + (size_t)r * LDK;
#pragma unroll
  for (int h = 0; h < 8; ++h) {
    float ss = wave_sum(a[h] * a[h] + b[h] * b[h] + c0 * c0);
    float rs = rsqrtf(ss * (1.f / 192.f) + EPS);
    float x = a[h] * rs * g0, y = b[h] * rs * g1, z = c0 * rs * g2;
    if (pp >= CTX) z = rope64(z, lane, pp - CTX);
    k[h * 192 + lane] = f2bf(x); k[h * 192 + 64 + lane] = f2bf(y); k[h * 192 + 128 + lane] = f2bf(z);
  }
}
DEVI void transpose64x128(int sw, const bf16_t* __restrict__ src, int ld, bf16_t* __restrict__ dst  , char* smb) {
  const int tid = VT, d = tid & 127, half = tid >> 7;
  float y[32];
#pragma unroll
  for (int i = 0; i < 32; ++i) y[i] = bf2f(src[(size_t)(half * 32 + i) * ld + d]);
  bf16_t* T = (bf16_t*)smb;
  vbar(smb);
  put_T(T, d, half, y);
  vbar(smb);
  store_T(sw, T, dst);
}
DEVI void gdn_pre(int sw, const P& p, int item, char* smraw) {
  const int tid = VT, lane = tid & 63, wid = tid >> 6, fr = lane & 15, fq = lane >> 4;
  const int mc = item % NCH; int t = item / NCH;
  const int dir = t & 1, bh = t >> 1;
  const int p0 = mc * 64;
  char* R2 = p.ws + OFF_R2;
  bf16_t* qs = (bf16_t*)smraw;
  bf16_t* ks = qs + 64 * 136;
  float* Ls = (float*)(ks + 64 * 136);
  float* gcs = Ls + 4096;
  float* bes = gcs + 64;
  vbar(smraw);
  {
    const bf16_t* gq = (const bf16_t*)(R2 + R_GQ) + ((size_t)bh * TPB + p0) * 128;
    const bf16_t* gk = (const bf16_t*)(R2 + R_GK) + ((size_t)bh * TPB + p0) * 128;
#pragma unroll
    for (int i = 0; i < 4; ++i) {
      int c = tid + 256 * i, row = c >> 4, kc = c & 15;
      *(u32x4*)(qs + row * 136 + kc * 8) = *(const u32x4*)(gq + row * 128 + kc * 8);
      *(u32x4*)(ks + row * 136 + kc * 8) = *(const u32x4*)(gk + row * 128 + kc * 8);
    }
    if (tid < 64) {
      gcs[tid] = ((const float*)(R2 + R_GC))[(size_t)(bh * 2 + dir) * TPB + p0 + tid];
      bes[tid] = ((const float*)(R2 + R_BETA))[(size_t)(bh * 2 + dir) * TPB + p0 + tid];
    }
  }
  vbar(smraw);
  {
    const int it = wid;
    const int i = it * 16 + fr;
    const float gi = gcs[i], bi = bes[i];
    bf16x8 bq[4], bk[4];
#pragma unroll
    for (int s = 0; s < 4; ++s) {
      bq[s] = *(const bf16x8*)(qs + i * 136 + s * 32 + fq * 8);
      bk[s] = *(const bf16x8*)(ks + i * 136 + s * 32 + fq * 8);
    }
    bf16_t* qkm = (bf16_t*)(R2 + R_QKM) + (size_t)item * 4096;
#pragma unroll
    for (int jt = 0; jt < 4; ++jt) {
      f32x4 akk = {0.f, 0.f, 0.f, 0.f}, aqk = {0.f, 0.f, 0.f, 0.f};
#pragma unroll
      for (int s = 0; s < 4; ++s) {
        bf16x8 a = *(const bf16x8*)(ks + (jt * 16 + fr) * 136 + s * 32 + fq * 8);
        akk = mfma16(a, bk[s], akk);
        aqk = mfma16(a, bq[s], aqk);
      }
      f32x4 qo;
#pragma unroll
      for (int jj = 0; jj < 4; ++jj) {
        int j = jt * 16 + fq * 4 + jj;
        float gj = gcs[j];
        bool before = dir ? (j > i) : (j < i);
        bool incl = before || (j == i);
        float e = incl ? __expf(gi - gj) : 0.f;
        qo[jj] = aqk[jj] * e;
        float lv = before ? bi * akk[jj] * e : 0.f;
        int ti = dir ? 63 - i : i, tj = dir ? 63 - j : j;
        Ls[tj * 64 + ti] = lv;
      }
      *(u32x2*)(qkm + i * 64 + jt * 16 + fq * 4) = pack4(qo);
    }
  }
  vbar(smraw);
  if (wid == 0) {
    const int j = lane;
    const int sj = dir ? 63 - j : j;
    float x[64];
#pragma unroll
    for (int t2 = 0; t2 < 64; ++t2) x[t2] = (t2 == sj) ? 1.f : 0.f;
    typedef __attribute__((address_space(3))) const f32x4 lds_f32x4;
    unsigned lofs = (unsigned)(size_t)(__attribute__((address_space(3))) const float*)Ls;
    asm volatile("" : "+v"(lofs));
    lds_f32x4* L4 = (lds_f32x4*)(size_t)lofs;
    f32x4 rowv[16];
#pragma unroll
    for (int g = 0; g < 16; ++g) rowv[g] = L4[g];
#pragma unroll
    for (int t2 = 0; t2 < 63; ++t2) {
      f32x4 nxt[16];
#pragma unroll
      for (int g = 0; g < 16; ++g) nxt[g] = (t2 + 1 < 63 && g >= (t2 + 2) / 4) ? L4[(t2 + 1) * 16 + g] : (f32x4){0.f, 0.f, 0.f, 0.f};
      const float xt = x[t2];
#pragma unroll
      for (int i = t2 + 1; i < 64; ++i) x[i] -= rowv[i >> 2][i & 3] * xt;
#pragma unroll
      for (int g = 0; g < 16; ++g) rowv[g] = nxt[g];
    }
    bf16_t* tm = (bf16_t*)(R2 + R_TM) + (size_t)item * 4096;
#pragma unroll
    for (int t2 = 0; t2 < 64; ++t2) {
      int i = dir ? 63 - t2 : t2;
      tm[i * 64 + j] = f2bf(x[t2]);
    }
  }
}

template <bool GDN>
DEVI void scan_chain(int sw, const P& p, int item, char* smraw) {
  const int tid = VT, lane = tid & 63, wid = tid >> 6, fr = lane & 15, fq = lane >> 4;
  int slice, dir, h, b, NH, DV;
  if (GDN) { slice = item & 1; dir = (item >> 1) & 1; h = (item >> 2) & 7; b = item >> 5; NH = 8; DV = 128; }
  else { slice = item & 3; dir = (item >> 2) & 1; h = (item >> 3) & 3; b = item >> 5; NH = 4; DV = 256; }
  const int bh = b * NH + h, bhd = bh * 2 + dir;
  char* R2 = p.ws + OFF_R2;
  bf16_t* kbg = (bf16_t*)smraw;
  bf16_t* qd = kbg + 64 * 136;
  bf16_t* kend = qd + 64 * 136;
  bf16_t* Tm = kend + 128 * 72;
  bf16_t* QK = Tm + 64 * 72;
  float* f_e = (float*)(QK + 64 * 72);
  float* f_b = f_e + 64;
  float* f_k = f_b + 64;
  float* el = f_k + 64;
  float* f_last = el + 128;
  const int e0 = slice * 64 + wid * 16;
  f32x4 S[8];
#pragma unroll
  for (int i = 0; i < 8; ++i) S[i] = (f32x4){0.f, 0.f, 0.f, 0.f};
  bf16_t* rec = (bf16_t*)(GDN ? (p.ws + OFF_H) : (R2 + R1_REC)) + (size_t)dir * NT * 1024;
  for (int n = 0; n < NCH; ++n) {
    const int mc = dir == 0 ? n : (n < 4 ? 3 - n : 71 - n);
    const int p0 = mc * 64;
    const int itc = bhd * NCH + mc;
    __syncthreads();
    if (GDN) {
      if (tid < 64) {
        const float* gc = (const float*)(R2 + R_GC) + (size_t)bhd * TPB + p0;
        float gcv = gc[tid], gl = gc[dir ? 0 : 63];
        f_e[tid] = __expf(gcv);
        f_b[tid] = ((const float*)(R2 + R_BETA))[(size_t)bhd * TPB + p0 + tid];
        f_k[tid] = __expf(gl - gcv);
        if (tid == 0) f_last[0] = __expf(gl);
      }
    } else {
      if (tid < 128) el[tid] = ((const float*)(R2 + R1_EL))[(size_t)itc * 128 + tid];
    }
    __syncthreads();
    if (GDN) {
      const bf16_t* gq = (const bf16_t*)(R2 + R_GQ) + ((size_t)bh * TPB + p0) * 128;
      const bf16_t* gk = (const bf16_t*)(R2 + R_GK) + ((size_t)bh * TPB + p0) * 128;
      const bf16_t* gkt = (const bf16_t*)(R2 + R_GKT) + ((size_t)bh * 128) * TPS + p0;
      const bf16_t* tm = (const bf16_t*)(R2 + R_TM) + (size_t)itc * 4096;
      const bf16_t* qkm = (const bf16_t*)(R2 + R_QKM) + (size_t)itc * 4096;
#pragma unroll
      for (int i = 0; i < 4; ++i) {
        int c = tid + 256 * i, row = c >> 4, kc = c & 15;
        u32x4 uq = *(const u32x4*)(gq + row * 128 + kc * 8), uk = *(const u32x4*)(gk + row * 128 + kc * 8);
        float fe = f_e[row], fk = f_b[row] * fe;
        u32x4 oq, ok;
#pragma unroll
        for (int j = 0; j < 4; ++j) { oq[j] = pk2(bflo(uq[j]) * fe, bfhi(uq[j]) * fe); ok[j] = pk2(bflo(uk[j]) * fk, bfhi(uk[j]) * fk); }
        *(u32x4*)(qd + row * 136 + kc * 8) = oq;
        *(u32x4*)(kbg + row * 136 + kc * 8) = ok;
      }
#pragma unroll
      for (int i = 0; i < 4; ++i) {
        int c = tid + 256 * i, row = c >> 3, cc = c & 7;
        u32x4 u = *(const u32x4*)(gkt + (size_t)row * TPS + cc * 8), o;
#pragma unroll
        for (int j = 0; j < 4; ++j) o[j] = pk2(bflo(u[j]) * f_k[cc * 8 + 2 * j], bfhi(u[j]) * f_k[cc * 8 + 2 * j + 1]);
        *(u32x4*)(kend + row * 72 + cc * 8) = o;
      }
#pragma unroll
      for (int i = 0; i < 2; ++i) {
        int c = tid + 256 * i, row = c >> 3, cc = c & 7;
        *(u32x4*)(Tm + row * 72 + cc * 8) = *(const u32x4*)(tm + row * 64 + cc * 8);
        *(u32x4*)(QK + row * 72 + cc * 8) = *(const u32x4*)(qkm + row * 64 + cc * 8);
      }
    } else {
      const bf16_t* gq = (const bf16_t*)(R2 + R1_QG) + ((size_t)bhd * TPB + p0) * 128;
      const bf16_t* gkt = (const bf16_t*)(R2 + R1_KGT) + ((size_t)bhd * 128) * TPS + p0;
      const bf16_t* am = (const bf16_t*)(R2 + R1_AM) + (size_t)itc * 4096;
#pragma unroll
      for (int i = 0; i < 4; ++i) {
        int c = tid + 256 * i, row = c >> 4, kc = c & 15;
        *(u32x4*)(qd + row * 136 + kc * 8) = *(const u32x4*)(gq + row * 128 + kc * 8);
      }
#pragma unroll
      for (int i = 0; i < 4; ++i) {
        int c = tid + 256 * i, row = c >> 3, cc = c & 7;
        *(u32x4*)(kend + row * 72 + cc * 8) = *(const u32x4*)(gkt + (size_t)row * TPS + cc * 8);
      }
#pragma unroll
      for (int i = 0; i < 2; ++i) {
        int c = tid + 256 * i, row = c >> 3, cc = c & 7;
        *(u32x4*)(QK + row * 72 + cc * 8) = *(const u32x4*)(am + row * 64 + cc * 8);
      }
    }
    __syncthreads();
    bf16x8 Sop[4];
#pragma unroll
    for (int ks = 0; ks < 4; ++ks) Sop[ks] = pack8(S[2 * ks], S[2 * ks + 1]);
    bf16x8 vop[2];
    if (GDN) {
      const bf16_t* gvt = (const bf16_t*)(R2 + R_GVT) + ((size_t)bh * 128 + e0 + fr) * TPS + p0;
      f32x4 X[4];
#pragma unroll
      for (int ct = 0; ct < 4; ++ct) {
        u32x2 u = *(const u32x2*)(gvt + ct * 16 + fq * 4);
        const float* fb = f_b + ct * 16 + fq * 4;
        f32x4 vb = {bflo(u[0]) * fb[0], bfhi(u[0]) * fb[1], bflo(u[1]) * fb[2], bfhi(u[1]) * fb[3]};
        f32x4 acc = {0.f, 0.f, 0.f, 0.f};
#pragma unroll
        for (int ks = 0; ks < 4; ++ks) acc = mfma16(ldsperm(kbg, ct * 16 + fr, 136, ks, fq), Sop[ks], acc);
        X[ct] = vb - acc;
      }
      bf16x8 Xop[2] = {pack8(X[0], X[1]), pack8(X[2], X[3])};
      f32x4 vn[4];
#pragma unroll
      for (int ct = 0; ct < 4; ++ct) {
        f32x4 acc = {0.f, 0.f, 0.f, 0.f};
#pragma unroll
        for (int kk = 0; kk < 2; ++kk) acc = mfma16(ldsperm(Tm, ct * 16 + fr, 72, kk, fq), Xop[kk], acc);
        vn[ct] = acc;
      }
      vop[0] = pack8(vn[0], vn[1]); vop[1] = pack8(vn[2], vn[3]);
    } else {
      const bf16_t* gvt = (const bf16_t*)(R2 + R1_VTG) + ((size_t)bh * 256 + e0 + fr) * TPS + p0;
#pragma unroll
      for (int kk = 0; kk < 2; ++kk) {
        u32x2 lo = *(const u32x2*)(gvt + kk * 32 + fq * 4), hi = *(const u32x2*)(gvt + kk * 32 + 16 + fq * 4);
        vop[kk] = cat8(lo, hi);
      }
    }
#pragma unroll
    for (int ct = 0; ct < 4; ++ct) {
      f32x4 acc = {0.f, 0.f, 0.f, 0.f};
#pragma unroll
      for (int ks = 0; ks < 4; ++ks) acc = mfma16(Sop[ks], ldsperm(qd, ct * 16 + fr, 136, ks, fq), acc);
#pragma unroll
      for (int kk = 0; kk < 2; ++kk) acc = mfma16(vop[kk], ldsperm(QK, ct * 16 + fr, 72, kk, fq), acc);
      *(u32x2*)(rec + (size_t)(b * TPB + p0 + ct * 16 + fr) * 1024 + h * DV + e0 + fq * 4) = pack4(acc);
    }
#pragma unroll
    for (int dt = 0; dt < 8; ++dt) {
      if (GDN) S[dt] *= f_last[0];
      else S[dt] *= *(const f32x4*)(el + dt * 16 + fq * 4);
#pragma unroll
      for (int kk = 0; kk < 2; ++kk) S[dt] = mfma16(ldsperm(kend, dt * 16 + fr, 72, kk, fq), vop[kk], S[dt]);
    }
  }
}

DEVI void fin0_rec(int sw, const P& p, int item) {
  const int lane = lane_id();
  const int w0 = (item * 4 + (sw & 3)) * 8;
  const int r = w0 >> 3;
  const bf16_t* r0 = (const bf16_t*)(p.ws + OFF_H) + (size_t)r * 1024 + lane * 2;
  const bf16_t* zz = (const bf16_t*)(p.ws + OFF_Z) + (size_t)r * LDZ0 + 4160 + lane * 2;
  unsigned u0[8], u1[8], uz[8];
#pragma unroll
  for (int h = 0; h < 8; ++h) { u0[h] = *(const unsigned*)(r0 + h * 128); u1[h] = *(const unsigned*)(r0 + (size_t)NT * 1024 + h * 128); uz[h] = *(const unsigned*)(zz + h * 128); }
  const float n0 = p.gdn_out_norm[lane * 2], n1 = p.gdn_out_norm[lane * 2 + 1];
#pragma unroll
  for (int h = 0; h < 8; ++h) {
    float a = bflo(u0[h]) + bflo(u1[h]), b = bfhi(u0[h]) + bfhi(u1[h]);
    float ss = wave_sum(a * a + b * b);
    float rs = rsqrtf(ss * (1.f / 128.f) + EPS);
    float oa = a * rs * n0 * silu_f(bflo(uz[h])), ob = b * rs * n1 * silu_f(bfhi(uz[h]));
    *(unsigned*)((bf16_t*)(p.ws + OFF_MIX) + (size_t)r * LDH + 1024 + h * 128 + lane * 2) = pk2(oa, ob);
  }
}

DEVI void prep1_qk(int sw, const P& p, int item) {
  const int lane = lane_id();
  const int w = item * 4 + (sw & 3);
  const int which = w & 1, r = w >> 1;
  bf16_t* q = (bf16_t*)(p.ws + OFF_Z) + (size_t)r * LDZ1 + which * 1024;
  float a[16];
#pragma unroll
  for (int hm = 0; hm < 16; ++hm) a[hm] = bf2f(q[hm * 64 + lane]);
  const float* gn = which ? p.diff_k_norm : p.diff_q_norm;
  const float g0 = gn[lane], g1 = gn[64 + lane];
  const int pp = r % TPB;
#pragma unroll
  for (int hm = 0; hm < 16; ++hm) {
    float ss = wave_sum(a[hm] * a[hm]);
    float rs = rsqrtf(ss * (1.f / 64.f) + EPS);
    float x = a[hm] * rs * ((hm & 1) ? g1 : g0);
    if (pp >= CTX) x = rope64(x, lane, pp - CTX);
    if (which == 0) x *= 0.125f * LOG2E;
    q[hm * 64 + lane] = f2bf(x);
  }
}
DEVI void gla_pre(int sw, const P& p, int item, char* smraw) {
  const int tid = VT, lane = tid & 63, wid = tid >> 6, fr = lane & 15, fq = lane >> 4;
  const int mc = item % NCH; int t = item / NCH;
  const int dir = t & 1, bh = t >> 1, h = bh & 3, b = bh >> 2;
  const int p0 = mc * 64;
  char* R2 = p.ws + OFF_R2;
  float* cum = (float*)smraw;
  float* lr = cum + 64 * 129;
  float* last = lr + 64 * 16;
  bf16_t* QS = (bf16_t*)(last + 128);
  bf16_t* KS = QS + 64 * 136;
  const bf16_t* z = (const bf16_t*)(p.ws + OFF_Z) + (size_t)(b * TPB + p0) * LDZ1;
  vbar(smraw);
#pragma unroll
  for (int i = tid; i < 64 * 16; i += 256) lr[i] = ((const float*)(R2 + R1_GATES))[(size_t)(b * TPB + p0 + (i >> 4)) * 32 + dir * 16 + (i & 15)];
  vbar(smraw);
  {
    const int d = tid & 127, half = tid >> 7;
    float w2[16];
#pragma unroll
    for (int rr = 0; rr < 16; ++rr) w2[rr] = p.gla_gate_w2[((size_t)dir * 16 + rr) * 512 + h * 128 + d];
    const float b2 = p.gla_gate_b2[dir * 512 + h * 128 + d];
#pragma unroll 4
    for (int i = 0; i < 32; ++i) {
      int c = half * 32 + i;
      float lg = b2;
#pragma unroll
      for (int rr = 0; rr < 16; ++rr) lg += lr[c * 16 + rr] * w2[rr];
      float ls = fminf(lg, 0.f) - __logf(1.f + __expf(-fabsf(lg)));
      cum[c * 129 + d] = ls * (1.f / 16.f);
    }
  }
  vbar(smraw);
  if (tid < 128) {
    float cv[64];
#pragma unroll
    for (int i = 0; i < 64; ++i) cv[i] = cum[(dir ? 63 - i : i) * 129 + tid];
    float run = 0.f;
#pragma unroll
    for (int i = 0; i < 64; ++i) { run += cv[i]; cum[(dir ? 63 - i : i) * 129 + tid] = run; }
    last[tid] = run;
    ((float*)(R2 + R1_EL))[(size_t)item * 128 + tid] = __expf(run);
  }
  vbar(smraw);
  {
    bf16_t* qg = (bf16_t*)(R2 + R1_QG) + ((size_t)(bh * 2 + dir) * TPB + p0) * 128;
#pragma unroll
    for (int i = tid; i < 64 * 64; i += 256) {
      int c = i >> 6, d = (i & 63) * 2;
      unsigned uq = *(const unsigned*)(z + (size_t)c * LDZ1 + 3072 + h * 128 + d);
      unsigned uk = *(const unsigned*)(z + (size_t)c * LDZ1 + 3584 + h * 128 + d);
      float c0 = cum[c * 129 + d], c1 = cum[c * 129 + d + 1];
      unsigned oq = pk2(bflo(uq) * 0.08838834764831845f * __expf(c0), bfhi(uq) * 0.08838834764831845f * __expf(c1));
      unsigned ok = pk2(bflo(uk) * __expf(-c0), bfhi(uk) * __expf(-c1));
      *(unsigned*)(QS + c * 136 + d) = oq;
      *(unsigned*)(KS + c * 136 + d) = ok;
      *(unsigned*)(qg + (size_t)c * 128 + d) = oq;
    }
    {
      const int d = tid >> 1, half = tid & 1;
      const float ld = last[d];
      float y[32];
#pragma unroll
      for (int i = 0; i < 32; ++i) {
        int c = half * 32 + i;
        y[i] = bf2f(z[(size_t)c * LDZ1 + 3584 + h * 128 + d]) * __expf(ld - cum[c * 129 + d]);
      }
      vbar(smraw);
      put_T((bf16_t*)smraw, d, half, y);
      vbar(smraw);
      store_T(sw, (const bf16_t*)smraw, (bf16_t*)(R2 + R1_KGT) + ((size_t)(bh * 2 + dir) * 128) * TPS + p0);
    }
  }
  {
    const int it = wid, i = it * 16 + fr;
    bf16x8 bq[4];
#pragma unroll
    for (int s = 0; s < 4; ++s) bq[s] = *(const bf16x8*)(QS + i * 136 + s * 32 + fq * 8);
    bf16_t* am = (bf16_t*)(R2 + R1_AM) + (size_t)item * 4096;
#pragma unroll
    for (int jt = 0; jt < 4; ++jt) {
      f32x4 a = {0.f, 0.f, 0.f, 0.f};
#pragma unroll
      for (int s = 0; s < 4; ++s) a = mfma16(*(const bf16x8*)(KS + (jt * 16 + fr) * 136 + s * 32 + fq * 8), bq[s], a);
#pragma unroll
      for (int jj = 0; jj < 4; ++jj) {
        int j = jt * 16 + fq * 4 + jj;
        bool incl = dir ? (j >= i) : (j <= i);
        a[jj] = incl ? a[jj] : 0.f;
      }
      *(u32x2*)(am + i * 64 + jt * 16 + fq * 4) = pack4(a);
    }
  }
  if (dir == 0) {
    const bf16_t* src = z + 4096 + h * 256;
    bf16_t* dst = (bf16_t*)(R2 + R1_VTG) + ((size_t)bh * 256) * TPS + p0;
    transpose64x128(sw, src, LDZ1, dst, smraw);
    transpose64x128(sw, src + 128, LDZ1, dst + (size_t)128 * TPS, smraw);
  }
}
constexpr float LAM_INIT = 0.35550906759096927f;
DEVI void fin1(int sw, const P& p, int item) {
  const int lane = lane_id();
  const int r = item * 4 + (sw & 3);
  bf16_t* mix = (bf16_t*)(p.ws + OFF_MIX) + (size_t)r * LDH;
  const bf16_t* o = (const bf16_t*)(p.ws + OFF_H) + (size_t)r * LDH + lane * 2;
  const bf16_t* r0 = (const bf16_t*)(p.ws + OFF_R2 + R1_REC) + (size_t)r * 1024 + lane * 4;
  const bf16_t* zg = (const bf16_t*)(p.ws + OFF_Z) + (size_t)r * LDZ1 + 5120 + lane * 4;
  unsigned u1[8], u2[8];
  u32x2 a0[4], a1[4], ag[4];
#pragma unroll
  for (int h = 0; h < 8; ++h) { u1[h] = *(const unsigned*)(o + h * 256); u2[h] = *(const unsigned*)(o + h * 256 + 128); }
#pragma unroll
  for (int h = 0; h < 4; ++h) { a0[h] = *(const u32x2*)(r0 + h * 256); a1[h] = *(const u32x2*)(r0 + (size_t)NT * 1024 + h * 256); ag[h] = *(const u32x2*)(zg + h * 256); }
  float l01 = wave_sum(p.diff_lambda[lane] * p.diff_lambda[64 + lane]);
  float l23 = wave_sum(p.diff_lambda[128 + lane] * p.diff_lambda[192 + lane]);
  const float lam = __expf(l01) - __expf(l23) + LAM_INIT;
  const float s0 = p.diff_sub_norm[lane * 2], s1 = p.diff_sub_norm[lane * 2 + 1];
#pragma unroll
  for (int h = 0; h < 8; ++h) {
    float a = bflo(u1[h]) - lam * bflo(u2[h]), b = bfhi(u1[h]) - lam * bfhi(u2[h]);
    float ss = wave_sum(a * a + b * b);
    float rs = rsqrtf(ss * (1.f / 128.f) + EPS) * (1.f - LAM_INIT);
    *(unsigned*)(mix + h * 128 + lane * 2) = pk2(a * rs * s0, b * rs * s1);
  }
  const f32x4 gn = *(const f32x4*)(p.gla_out_norm + lane * 4);
#pragma unroll
  for (int h = 0; h < 4; ++h) {
    float v[4] = {bflo(a0[h][0]) + bflo(a1[h][0]), bfhi(a0[h][0]) + bfhi(a1[h][0]), bflo(a0[h][1]) + bflo(a1[h][1]), bfhi(a0[h][1]) + bfhi(a1[h][1])};
    float ss = wave_sum(v[0] * v[0] + v[1] * v[1] + v[2] * v[2] + v[3] * v[3]);
    float rs = rsqrtf(ss * (1.f / 256.f) + EPS);
    float g[4] = {bflo(ag[h][0]), bfhi(ag[h][0]), bflo(ag[h][1]), bfhi(ag[h][1])};
    f32x4 ov;
#pragma unroll
    for (int q = 0; q < 4; ++q) ov[q] = v[q] * rs * gn[q] * silu_f(g[q]);
    *(u32x2*)(mix + 1024 + h * 256 + lane * 4) = pack4(ov);
  }
}

DEVI int fetch_item(int sw, int* ctr, char* slot) {
  __syncthreads();
  if (sw == 0 && lane_id() == 0) *(volatile int*)slot = atomicAdd(ctr, 1);
  __syncthreads();
  return __builtin_amdgcn_readfirstlane(*(volatile int*)slot);
}
DEVI void gbar(int sw, unsigned* cnt, unsigned* gen, unsigned nblk, unsigned epoch) {
  __syncthreads();
  if (sw == 0 && lane_id() == 0) {
    __builtin_amdgcn_fence(__ATOMIC_RELEASE, "agent");
    const unsigned prev = __hip_atomic_fetch_add(cnt, 1u, __ATOMIC_RELAXED, __HIP_MEMORY_SCOPE_AGENT);
    if (prev == epoch * nblk - 1u) __hip_atomic_store(gen, epoch, __ATOMIC_RELAXED, __HIP_MEMORY_SCOPE_AGENT);
    else while (__hip_atomic_load(gen, __ATOMIC_RELAXED, __HIP_MEMORY_SCOPE_AGENT) < epoch) __builtin_amdgcn_s_sleep(1);
    __builtin_amdgcn_fence(__ATOMIC_ACQUIRE, "agent");
  }
  __syncthreads();
}
constexpr int SMEM_HALF = 75776;
constexpr int SMEM_BYTES = 2 * SMEM_HALF;
constexpr int NPHASE = 21;

__global__ void __launch_bounds__(512, 2) mega(P p, int ph0, int ph1) {
  __shared__ __attribute__((aligned(1024))) char smem_all[SMEM_BYTES];
  cg::grid_group grid = cg::this_grid();
#ifdef PH_LO
  ph0 = PH_LO; ph1 = PH_HI;
#endif
  const int sw = __builtin_amdgcn_readfirstlane(threadIdx.x >> 6);
  const int vb = sw >> 2;
  const int G = gridDim.x * 2, bid = blockIdx.x * 2 + vb;
  char* smem = smem_all + vb * SMEM_HALF;
  unsigned* gb_cnt = (unsigned*)(p.ws + OFF_CTR) + 256;
  unsigned* gb_gen = (unsigned*)(p.ws + OFF_CTR) + 320;
  unsigned epoch = 0;
  char* ws = p.ws;
  char* R2 = ws + OFF_R2;
  bf16_t* wmix = (bf16_t*)(ws + OFF_WMIX);
  bf16_t* Hb = (bf16_t*)(ws + OFF_H);
  bf16_t* MIXb = (bf16_t*)(ws + OFF_MIX);
  bf16_t* Zb = (bf16_t*)(ws + OFF_Z);
  const float* mod0 = (const float*)(ws + OFF_MOD);
  const float* mod1 = mod0 + 5 * MODN;

  if (ph0 <= 0 && 0 < ph1) {
    if (lane_id() == 0 && (sw & 3) == 0) *(volatile unsigned*)(smem + VB_CTR_OFF) = 0u;
    __syncthreads();
    {
        for (int it = bid; it < 384 + CVT_MIX0_ITEMS; it += G) {
          if (it < 384) ada_item(sw, p, it, (float*)smem);
          else cvt_mix0(sw, p, it - 384, (float*)smem);
        }
        if (blockIdx.x == 0 && sw == 0 && lane_id() < 16) ((int*)(ws + OFF_CTR))[lane_id()] = 0;
        if (blockIdx.x == 0 && sw == 0 && lane_id() < 2) ((unsigned*)(ws + OFF_CTR))[256 + 64 * lane_id()] = 0u;
      }
    if (0 + 1 < ph1) grid.sync();
  }
  if (ph0 <= 1 && 1 < ph1) {
    modulate_phase(sw, p, p.norm_mix_g, mod0, 0, 1, Hb, nullptr, nullptr, true);
    if (1 + 1 < ph1) gbar(sw, gb_cnt, gb_gen, gridDim.x, ++epoch);
  }
  if (ph0 <= 2 && 2 < ph1) {
    {
        EpiStore e{Zb, LDZ0, (float*)(R2 + R_GATES), 5184};
        gemm256_phase<0>(sw, wmix + WM_IN, LDW, Hb, LDH, D, AB_INP / 256, smem_all, e);
      }
    if (2 + 1 < ph1) gbar(sw, gb_cnt, gb_gen, gridDim.x, ++epoch);
  }
  if (ph0 <= 3 && 3 < ph1) {
    if (lane_id() == 0 && (sw & 3) == 0) *(volatile unsigned*)(smem + VB_CTR_OFF) = 0u;
    __syncthreads();
    {
        for (int it = bid; it < 8704 + 1088; it += G) {
          if (it < 8704) prep0_gdn(sw, p, (it & ~3) | ((it + (it >> 9)) & 3), (float*)smem);
          else prep0_norm512(sw, p, it - 8704);
        }
      }
    if (3 + 1 < ph1) gbar(sw, gb_cnt, gb_gen, gridDim.x, ++epoch);
  }
  if (ph0 <= 4 && 4 < ph1) {
    {
        EpiStore eq{(bf16_t*)(R2 + R_QUP), 1536, nullptr, 0};
        gemm256_phase<0>(sw, wmix + WM_UQ, LDW5, Hb, LDQA, 512, 6, smem_all, eq);
        EpiStore ek{MIXb, LDH, nullptr, 0};
        gemm256_phase<0>(sw, wmix + WM_UKV, LDW5, Hb + (size_t)NT * LDQA, LDQA, 512, 8, smem_all, ek);
      }
    if (4 + 1 < ph1) gbar(sw, gb_cnt, gb_gen, gridDim.x, ++epoch);
  }
  if (ph0 <= 5 && 5 < ph1) {
    if (lane_id() == 0 && (sw & 3) == 0) *(volatile unsigned*)(smem + VB_CTR_OFF) = 0u;
    __syncthreads();
    {
        const int nq = NT * 8 / 4 / 8;
        for (int it = bid; it < 4352 + 2176 + 2 * nq; it += G) {
          if (it < 4352) gdn_pre(sw, p, it, smem);
          else if (it < 4352 + 2176) {
            int t = it - 4352; int mc = t % NCH; int bh = t / NCH; int b = bh >> 3, h = bh & 7;
            transpose64x128(sw, MIXb + (size_t)(b * TPB + mc * 64) * LDH + h * 256 + 128, LDH,
                            (bf16_t*)(R2 + R_VT) + ((size_t)bh * 128) * TPS + mc * 64, smem);
          } else if (it < 4352 + 2176 + nq) prep0_q(sw, p, it - 4352 - 2176);
          else prep0_k(sw, p, it - 4352 - 2176 - nq);
        }
      }
    if (5 + 1 < ph1) gbar(sw, gb_cnt, gb_gen, gridDim.x, ++epoch);
  }
  if (ph0 <= 6 && 6 < ph1) {
    {
        int* ctr = (int*)(ws + OFF_CTR) + (ph0 == 6 ? 2 : 0);
        char* slot = smem_all + SMEM_BYTES - 16;
        while (true) {
          const int it = fetch_item(sw, ctr, slot);
          if (it >= 608) break;
          if (it < 64) scan_chain<true>(sw, p, 2 * it + vb, smem);
          else {
            int bh, prow, nkeys;
            if (it < 576) { const int t = it - 64; bh = t >> 4; prow = CTX + (t & 15) * 256; nkeys = TPB; }
            else { bh = it - 576; prow = 0; nkeys = CTX; }
            const int b = bh >> 3, h = bh & 7;
            const size_t r0 = (size_t)b * TPB + prow;
            float gq = 0.f, gk = 0.f;
            for (int i = lane_id(); i < 192; i += 64) { gq = fmaxf(gq, fabsf(p.mla_q_norm[i])); gk = fmaxf(gk, fabsf(p.mla_k_norm[i])); }
#pragma unroll
            for (int o2 = 32; o2 > 0; o2 >>= 1) { gq = fmaxf(gq, __shfl_xor(gq, o2)); gk = fmaxf(gk, __shfl_xor(gk, o2)); }
            const float negB = -(0.07216878364870322f * LOG2E * 192.f) * gq * gk;
            attn256_item<192>(sw, (const bf16_t*)(R2 + R_QUP) + r0 * 1536 + h * 192, 1536,
                              (const bf16_t*)(R2 + R_K) + (size_t)b * TPB * LDK + h * 192, LDK,
                              (const bf16_t*)(R2 + R_VT) + ((size_t)bh * 128) * TPS,
                              MIXb + r0 * LDH + h * 128, LDH, nkeys, negB, smem_all);
          }
        }
      }
    if (6 + 1 < ph1) gbar(sw, gb_cnt, gb_gen, gridDim.x, ++epoch);
  }
  if (ph0 <= 7 && 7 < ph1) {
    if (lane_id() == 0 && (sw & 3) == 0) *(volatile unsigned*)(smem + VB_CTR_OFF) = 0u;
    __syncthreads();
    {
        const int nf = NT * 8 / 4 / 8;
        for (int it = bid; it < CVT_FFN_ITEMS + nf; it += G) {
          if (it < CVT_FFN_ITEMS) cvt_ffn(sw, p, 0, it, (float*)smem);
          else fin0_rec(sw, p, it - CVT_FFN_ITEMS);
        }
      }
    if (7 + 1 < ph1) gbar(sw, gb_cnt, gb_gen, gridDim.x, ++epoch);
  }
  if (ph0 <= 8 && 8 < ph1) {
    {
        EpiResid e{p.out, (float*)(ws + OFF_CTXRES), mod0 + 2 * D, (float*)(R2 + R_PART)};
        gemm256_phase<2>(sw, wmix + WM_OUT, LDW, MIXb, LDH, D, 8, smem_all, e);
      }
    if (8 + 1 < ph1) gbar(sw, gb_cnt, gb_gen, gridDim.x, ++epoch);
  }
  if (ph0 <= 9 && 9 < ph1) {
    if (lane_id() == 0 && (sw & 3) == 0) *(volatile unsigned*)(smem + VB_CTR_OFF) = 0u;
    __syncthreads();
    {
        modulate_phase(sw, p, p.norm_ffn_g, mod0, 3, 4, Hb, (const float*)(R2 + R_PART), mod0 + 4 * MODN + 2 * D);
        for (int it = bid; it < CVT_MIX1_ITEMS; it += G) cvt_mix1(sw, p, it, (float*)smem);
      }
    if (9 + 1 < ph1) gbar(sw, gb_cnt, gb_gen, gridDim.x, ++epoch);
  }
  if (ph0 <= 10 && 10 < ph1) {
    {
        EpiSwiglu e{Zb};
        gemm256_phase<0>(sw, (const bf16_t*)(R2 + RF_GU), LDW, Hb, LDH, D, 44, smem_all, e);
      }
    if (10 + 1 < ph1) gbar(sw, gb_cnt, gb_gen, gridDim.x, ++epoch);
  }
  if (ph0 <= 11 && 11 < ph1) {
    {
        EpiResid e{p.out, (float*)(ws + OFF_CTXRES), mod0 + 5 * D, (float*)(R2 + R_PART)};
        gemm256_phase<2>(sw, (const bf16_t*)(R2 + RF_D), LDWF, Zb, LDG, FFN, 8, smem_all, e);
      }
    if (11 + 1 < ph1) gbar(sw, gb_cnt, gb_gen, gridDim.x, ++epoch);
  }
  if (ph0 <= 12 && 12 < ph1) {
    modulate_phase(sw, p, p.norm_mix_g + D, mod1, 0, 1, Hb, (const float*)(R2 + R_PART), mod0 + 4 * MODN + 5 * D);
    if (12 + 1 < ph1) gbar(sw, gb_cnt, gb_gen, gridDim.x, ++epoch);
  }
  if (ph0 <= 13 && 13 < ph1) {
    {
        EpiStore e{Zb, LDZ1, (float*)(R2 + R1_GATES), 6144};
        gemm256_phase<0>(sw, wmix + WM_IN, LDW, Hb, LDH, D, CD_INP / 256, smem_all, e);
      }
    if (13 + 1 < ph1) gbar(sw, gb_cnt, gb_gen, gridDim.x, ++epoch);
  }
  if (ph0 <= 14 && 14 < ph1) {
    if (lane_id() == 0 && (sw & 3) == 0) *(volatile unsigned*)(smem + VB_CTR_OFF) = 0u;
    __syncthreads();
    {
        const int nqk = NT * 2 / 4;
        for (int it = bid; it < 2176 + 2176 + nqk; it += G) {
          if (it < 2176) gla_pre(sw, p, it, smem);
          else if (it < 4352) {
            int t = it - 2176; int mc = t % NCH; int bh = t / NCH; int b = bh >> 3, h = bh & 7;
            transpose64x128(sw, Zb + (size_t)(b * TPB + mc * 64) * LDZ1 + 2048 + h * 128, LDZ1,
                            (bf16_t*)(R2 + R1_VT) + ((size_t)bh * 128) * TPS + mc * 64, smem);
          } else prep1_qk(sw, p, it - 4352);
        }
      }
    if (14 + 1 < ph1) gbar(sw, gb_cnt, gb_gen, gridDim.x, ++epoch);
  }
  if (ph0 <= 15 && 15 < ph1) {
    {
        int* ctr = (int*)(ws + OFF_CTR) + (ph0 == 15 ? 3 : 1);
        char* slot = smem_all + SMEM_BYTES - 16;
        while (true) {
          const int it = fetch_item(sw, ctr, slot);
          if (it >= 64 + 1024) break;
          if (it < 64) scan_chain<false>(sw, p, 2 * it + vb, smem);
          else {
            const int t = it - 64, qb = t & 15, bhm = t >> 4, b = bhm >> 4, hm = bhm & 15;
            const size_t r0 = (size_t)b * TPB + CTX + qb * 256;
            float gq = 0.f, gk = 0.f;
            for (int i = lane_id(); i < 128; i += 64) { gq = fmaxf(gq, fabsf(p.diff_q_norm[i])); gk = fmaxf(gk, fabsf(p.diff_k_norm[i])); }
#pragma unroll
            for (int o2 = 32; o2 > 0; o2 >>= 1) { gq = fmaxf(gq, __shfl_xor(gq, o2)); gk = fmaxf(gk, __shfl_xor(gk, o2)); }
            const float negB = -(0.125f * LOG2E * 64.f) * gq * gk;
            attn256_item<64>(sw, Zb + r0 * LDZ1 + hm * 64, LDZ1,
                             Zb + (size_t)b * TPB * LDZ1 + 1024 + hm * 64, LDZ1,
                             (const bf16_t*)(R2 + R1_VT) + ((size_t)(b * 8 + (hm >> 1)) * 128) * TPS,
                             Hb + r0 * LDH + hm * 128, LDH, TPB, negB, smem_all);
          }
        }
      }
    if (15 + 1 < ph1) gbar(sw, gb_cnt, gb_gen, gridDim.x, ++epoch);
  }
  if (ph0 <= 16 && 16 < ph1) {
    if (lane_id() == 0 && (sw & 3) == 0) *(volatile unsigned*)(smem + VB_CTR_OFF) = 0u;
    __syncthreads();
    {
        const int nf = NT / 4;
        for (int it = bid; it < CVT_FFN_ITEMS + nf; it += G) {
          if (it < CVT_FFN_ITEMS) cvt_ffn(sw, p, 1, it, (float*)smem);
          else fin1(sw, p, it - CVT_FFN_ITEMS);
        }
      }
    if (16 + 1 < ph1) gbar(sw, gb_cnt, gb_gen, gridDim.x, ++epoch);
  }
  if (ph0 <= 17 && 17 < ph1) {
    {
        EpiResid e{p.out, (float*)(ws + OFF_CTXRES), mod1 + 2 * D, nullptr};
        gemm256_phase<1>(sw, wmix + WM_OUT, LDW, MIXb, LDH, D, 8, smem_all, e);
      }
    if (17 + 1 < ph1) gbar(sw, gb_cnt, gb_gen, gridDim.x, ++epoch);
  }
  if (ph0 <= 18 && 18 < ph1) {
    modulate_phase(sw, p, p.norm_ffn_g + D, mod1, 3, 4, Hb);
    if (18 + 1 < ph1) gbar(sw, gb_cnt, gb_gen, gridDim.x, ++epoch);
  }
  if (ph0 <= 19 && 19 < ph1) {
    {
        EpiSwiglu e{Zb};
        gemm256_phase<1>(sw, (const bf16_t*)(R2 + RF_GU), LDW, Hb, LDH, D, 44, smem_all, e);
      }
    if (19 + 1 < ph1) gbar(sw, gb_cnt, gb_gen, gridDim.x, ++epoch);
  }
  if (ph0 <= 20 && 20 < ph1) {
    {
        EpiResid e{p.out, (float*)(ws + OFF_CTXRES), mod1 + 5 * D, nullptr};
        gemm256_phase<1>(sw, (const bf16_t*)(R2 + RF_D), LDWF, Zb, LDG, FFN, 8, smem_all, e);
      }
  }
  if (ph0 <= 21 && 21 < ph1) { for (int it = bid; it < 128; it += G) scan_chain<true>(sw, p, it, smem); }
  if (ph0 <= 23 && 23 < ph1) { for (int it = bid; it < 128; it += G) scan_chain<false>(sw, p, it, smem); }
}

extern "C" void kernel_launch(void* const* d_in, const int* in_sizes, int n_in, void* d_out, int out_size, void* d_ws, size_t ws_size, hipStream_t stream) {
  static int grid_blocks = 0;
  if (!grid_blocks) {
    int dev = 0, cus = 0, per_cu = 0;
    hipGetDevice(&dev);
    hipDeviceGetAttribute(&cus, hipDeviceAttributeMultiprocessorCount, dev);
    hipOccupancyMaxActiveBlocksPerMultiprocessor(&per_cu, mega, 512, 0);
    if (per_cu > 1) per_cu = 1;
    if (per_cu < 1) per_cu = 1;
    grid_blocks = cus * per_cu;
    grid_blocks -= grid_blocks % 8;
  }
  if (ws_size < WS_NEED) { fprintf(stderr, "workspace too small: %zu < %zu\n", ws_size, (size_t)WS_NEED); return; }
  P p{};
  const float** pp = (const float**)&p;
  for (int i = 0; i < 32; ++i) pp[i] = (const float*)d_in[i];
  p.out = (float*)d_out;
  p.ws = (char*)d_ws;
#ifndef PROBE_PHASE
  int ph0 = 0, ph1 = NPHASE;
  void* args[] = {&p, &ph0, &ph1};
  hipError_t e = hipLaunchCooperativeKernel((void*)mega, dim3(grid_blocks), dim3(512), args, 0, stream);
  if (e != hipSuccess) fprintf(stderr, "cooperative launch failed: %s (grid %d)\n", hipGetErrorString(e), grid_blocks);
#else
  int segs[3][2] = {{0, PROBE_AFTER + 1}, {PROBE_PHASE, PROBE_PHASE + 1}, {PROBE_AFTER + 1, NPHASE}};
  for (int s = 0; s < 3; ++s) {
    void* args[] = {&p, &segs[s][0], &segs[s][1]};
    hipError_t e = hipLaunchCooperativeKernel((void*)mega, dim3(grid_blocks), dim3(512), args, 0, stream);
    if (e != hipSuccess) fprintf(stderr, "cooperative launch failed: %s (grid %d)\n", hipGetErrorString(e), grid_blocks);
  }
#endif
}
```

```cpp
#include <hip/hip_runtime.h>
#include <hip/hip_cooperative_groups.h>
#include <cstdio>
#include <cstdint>
namespace cg = cooperative_groups;

#define DEVI __device__ __forceinline__
typedef unsigned short bf16_t;
typedef short bf16x8 __attribute__((ext_vector_type(8)));
typedef short bf16x4 __attribute__((ext_vector_type(4)));
typedef float f32x4 __attribute__((ext_vector_type(4)));
typedef float f32x2 __attribute__((ext_vector_type(2)));
typedef unsigned u32x4 __attribute__((ext_vector_type(4)));
typedef unsigned u32x2 __attribute__((ext_vector_type(2)));
typedef __bf16 bfv2 __attribute__((ext_vector_type(2)));

constexpr int D = 2048, NB = 4, SEQ = 4096, CTX = 256, TPB = SEQ + CTX  , NT = NB * TPB  ;
constexpr int NCH = TPB / 64;
constexpr int FFN = 5632;
constexpr int AB_IN = 5216, AB_INP = 5376, CD_IN = 6176, CD_INP = 6400;
constexpr int MODN = 6 * D;
constexpr int LDH = 2112, LDZ0 = 5440, LDZ1 = 6464, LDG = 5696, LDW = 2112, LDW5 = 576, LDWF = 5696, LDK = 1600, LDQA = 576, TPS = 4416;
constexpr float EPS = 1e-6f;
constexpr float LOG2E = 1.4426950408889634f;

constexpr size_t OFF_CTR = 0;
constexpr size_t OFF_MOD = 4096;
constexpr size_t OFF_CTXRES = OFF_MOD + (size_t)2 * 5 * MODN * 4;
constexpr size_t OFF_WMIX = OFF_CTXRES + (size_t)NB * CTX * D * 4;
constexpr size_t OFF_H = OFF_WMIX + (size_t)41943040;
constexpr size_t OFF_MIX = OFF_H + (size_t)NT * LDH * 2;
constexpr size_t OFF_Z = OFF_MIX + (size_t)NT * LDH * 2;
constexpr size_t OFF_R2 = OFF_Z + (size_t)NT * LDZ1 * 2;
constexpr size_t SZ_T = (size_t)4096 * TPS * 2;
constexpr size_t SZ_TOK1024 = (size_t)NT * 1024 * 2;
constexpr size_t WM_IN = 0;
constexpr size_t WM_OUT = (size_t)CD_INP * LDW;
constexpr size_t WM_UQ = WM_OUT + (size_t)D * LDW;
constexpr size_t WM_UKV = WM_UQ + (size_t)1536 * LDW5;
static_assert((WM_UKV + (size_t)2048 * LDW5) * 2 <= 41943040, "wmix");
constexpr size_t R_QUP = 0;
constexpr size_t R_K = R_QUP + (size_t)NT * 1536 * 2;
constexpr size_t R_VT = R_K + (size_t)NT * LDK * 2;
constexpr size_t R_GQ = R_VT + SZ_T;
constexpr size_t R_GK = R_GQ + SZ_TOK1024;
constexpr size_t R_GKT = R_GK + SZ_TOK1024;
constexpr size_t R_GVT = R_GKT + SZ_T;
constexpr size_t R_TM = R_GVT + SZ_T;
constexpr size_t R_QKM = R_TM + SZ_TOK1024;
constexpr size_t R_GC = R_QKM + SZ_TOK1024;
constexpr size_t R_BETA = R_GC + (size_t)NT * 16 * 4;
constexpr size_t R_GATES = R_BETA + (size_t)NT * 16 * 4;
constexpr size_t R_END0 = R_GATES + (size_t)NT * 32 * 4;
constexpr size_t R1_VT = 0;
constexpr size_t R1_QG = R1_VT + SZ_T;
constexpr size_t R1_KGT = R1_QG + SZ_TOK1024;
constexpr size_t R1_VTG = R1_KGT + SZ_T;
constexpr size_t R1_AM = R1_VTG + SZ_T;
constexpr size_t R1_EL = R1_AM + (size_t)2176 * 4096 * 2;
constexpr size_t R1_GATES = R1_EL + (size_t)2176 * 128 * 4;
constexpr size_t R1_REC = R1_GATES + (size_t)NT * 32 * 4;
constexpr size_t R1_END = R1_REC + 2 * SZ_TOK1024;
constexpr size_t RF_GU = 0;
constexpr size_t RF_D = RF_GU + (size_t)2 * FFN * LDW * 2;
static_assert(RF_D + (size_t)D * LDWF * 2 <= R1_KGT, "ffn overlay L1");
static_assert(RF_D + (size_t)D * LDWF * 2 <= R_VT, "ffn overlay L0");
static_assert(NT * (size_t)LDG * 2 <= NT * (size_t)LDZ1 * 2, "G fits Z");
constexpr size_t R_PART = (size_t)128 << 20;
constexpr size_t WS_NEED = OFF_R2 + (R_END0 > R1_END ? R_END0 : R1_END);
static_assert(WS_NEED <= (size_t)805306368, "ws");

struct P {
  const float *x, *c, *ctx, *c_ctx, *ada_w, *ada_b, *norm_mix_g, *norm_ffn_g, *ffn_w_gate, *ffn_w_up, *ffn_w_down;
  const float *ab_w_in, *mla_q_a_norm, *mla_w_uq, *mla_kv_a_norm, *mla_w_ukv, *mla_q_norm, *mla_k_norm;
  const float *gdn_conv_w, *gdn_a_log, *gdn_dt_bias, *gdn_out_norm, *ab_w_out;
  const float *cd_w_in, *diff_q_norm, *diff_k_norm, *diff_lambda, *diff_sub_norm, *gla_gate_w2, *gla_gate_b2, *gla_out_norm, *cd_w_out;
  float* out;
  char* ws;
};

DEVI unsigned pk2(float lo, float hi) { f32x2 v = {lo, hi}; bfv2 b = __builtin_convertvector(v, bfv2); return __builtin_bit_cast(unsigned, b); }
DEVI float bflo(unsigned u) { return __uint_as_float(u << 16); }
DEVI float bfhi(unsigned u) { return __uint_as_float(u & 0xffff0000u); }
DEVI float bf2f(bf16_t h) { return __uint_as_float(((unsigned)h) << 16); }
DEVI bf16_t f2bf(float f) { return (bf16_t)(pk2(f, 0.f) & 0xffffu); }
DEVI f32x4 mfma16(bf16x8 a, bf16x8 b, f32x4 c) { return __builtin_amdgcn_mfma_f32_16x16x32_bf16(a, b, c, 0, 0, 0); }
DEVI bf16x8 pack8(f32x4 a, f32x4 b) { u32x4 u = {pk2(a[0], a[1]), pk2(a[2], a[3]), pk2(b[0], b[1]), pk2(b[2], b[3])}; return __builtin_bit_cast(bf16x8, u); }
DEVI u32x2 pack4(f32x4 a) { u32x2 u = {pk2(a[0], a[1]), pk2(a[2], a[3])}; return u; }
DEVI bf16x8 cat8(u32x2 lo, u32x2 hi) { u32x4 u = {lo[0], lo[1], hi[0], hi[1]}; return __builtin_bit_cast(bf16x8, u); }
DEVI float wave_sum(float v) {
#pragma unroll
  for (int o = 32; o > 0; o >>= 1) v += __shfl_xor(v, o);
  return v;
}
DEVI float silu_f(float v) { return v * __builtin_amdgcn_rcpf(1.f + __expf(-v)); }
DEVI float* xrow(const P& p, int r) {
  int b = r / TPB, q = r - b * TPB;
  return q < CTX ? (float*)(p.ws + OFF_CTXRES) + (size_t)(b * CTX + q) * D : p.out + (size_t)(b * SEQ + q - CTX) * D;
}
DEVI int modidx(int r) { int b = r / TPB; return (r - b * TPB) < CTX ? 4 : b; }
DEVI bf16x8 ldsperm(const bf16_t* base, int row, int stride, int ks, int fq) {
  const bf16_t* p = base + row * stride + ks * 32 + fq * 4;
  u32x2 lo = *(const u32x2*)p, hi = *(const u32x2*)(p + 16);
  return cat8(lo, hi);
}

DEVI int lane_id() { int l; asm volatile("v_mbcnt_lo_u32_b32 %0, -1, 0\n\tv_mbcnt_hi_u32_b32 %0, -1, %0" : "=v"(l)); return l; }
#define VT ((((sw) & 3) << 6) | lane_id())
constexpr int VB_CTR_OFF = 75776 - 32;
DEVI void vbar(const void* vbase) {
  typedef __attribute__((address_space(3))) unsigned lds_u32;
  lds_u32* ctr = (lds_u32*)(size_t)(unsigned)(size_t)(__attribute__((address_space(3))) const char*)((const char*)vbase + VB_CTR_OFF);
  __builtin_amdgcn_fence(__ATOMIC_RELEASE, "workgroup");
  asm volatile("s_waitcnt vmcnt(0) lgkmcnt(0)" ::: "memory");
  unsigned old = 0;
  if (lane_id() == 0) old = __hip_atomic_fetch_add(ctr, 1u, __ATOMIC_RELAXED, __HIP_MEMORY_SCOPE_WORKGROUP);
  const unsigned gen = (unsigned)__builtin_amdgcn_readfirstlane((int)old) >> 2;
  while ((__hip_atomic_load(ctr, __ATOMIC_RELAXED, __HIP_MEMORY_SCOPE_WORKGROUP) >> 2) == gen) __builtin_amdgcn_s_sleep(1);
  __builtin_amdgcn_fence(__ATOMIC_ACQUIRE, "workgroup");
  asm volatile("" ::: "memory");
}
struct EpiStore {
  bf16_t* C; int ldc; float* side; int side_c0;
  DEVI void operator()(const f32x4 (&acc)[8][4], int nb, int mb, int fr, int fq, int pk) const {
#pragma unroll
    for (int ni = 0; ni < 4; ++ni) {
      const int m = mb + ni * 16 + fr;
#pragma unroll
      for (int mi = 0; mi < 8; ++mi) {
        const int n = nb + mi * 16 + fq * 4;
        *(u32x2*)(C + (size_t)m * ldc + n) = pack4(acc[mi][ni]);
        if (side && n >= side_c0 && n < side_c0 + 32) *(f32x4*)(side + (size_t)m * 32 + (n - side_c0)) = acc[mi][ni];
      }
      asm volatile("" ::: "memory");
    }
  }
};
struct EpiResid {
  float* out; float* ctxres; const float* gate; float* part;
  DEVI void operator()(const f32x4 (&acc)[8][4], int nb, int mb, int fr, int fq, int pk) const {
#pragma unroll
    for (int ni = 0; ni < 4; ++ni) {
      const int m = mb + ni * 16 + fr;
      int bb = m / TPB, qq = m - bb * TPB;
      float* xr = qq < CTX ? ctxres + (size_t)(bb * CTX + qq) * D : out + (size_t)(bb * SEQ + qq - CTX) * D;
      const float* g = gate + (size_t)(qq < CTX ? 4 : bb) * MODN;
#pragma unroll
      for (int mi = 0; mi < 8; ++mi) {
        const int n = nb + mi * 16 + fq * 4;
        const f32x4 gv = *(const f32x4*)(g + n);
        if (pk >= 0) {
          *(f32x4*)(part + ((size_t)(pk * (NB * CTX) + bb * CTX + qq)) * D + n) = acc[mi][ni];
        } else {
          f32x4 xv = *(f32x4*)(xr + n);
          xv += gv * acc[mi][ni];
          *(f32x4*)(xr + n) = xv;
        }
        if ((mi & 1) == 1) asm volatile("" ::: "memory");
      }
    }
  }
};
struct EpiProbe {
  float* dump; int flag;
  DEVI void operator()(const f32x4 (&acc)[8][4], int nb, int mb, int fr, int fq, int pk) const {
    if (flag) {
#pragma unroll
      for (int mi = 0; mi < 8; ++mi)
#pragma unroll
        for (int ni = 0; ni < 4; ++ni) *(f32x4*)(dump + (size_t)(mi * 4 + ni) * 4096 + (fr * 4 + fq) * 4) = acc[mi][ni];
    }
  }
};
struct EpiSwiglu {
  bf16_t* G;
  DEVI void operator()(const f32x4 (&acc)[8][4], int nb, int mb, int fr, int fq, int pk) const {
#pragma unroll
    for (int ni = 0; ni < 4; ++ni) {
      const int m = mb + ni * 16 + fr;
#pragma unroll
      for (int mi = 0; mi < 8; mi += 2) {
        const int R = nb + mi * 16;
        const int hc = (R >> 5) * 16 + fq * 4;
        f32x4 g = acc[mi][ni], u = acc[mi + 1][ni], o;
#pragma unroll
        for (int j = 0; j < 4; ++j) o[j] = silu_f(g[j]) * u[j];
        *(u32x2*)(G + (size_t)m * LDG + hc) = pack4(o);
      }
    }
  }
};
DEVI int lds_byte2(int r, int c) { int st = (r >> 4) * 2 + (c >> 5), ob = (r & 15) * 64 + (c & 31) * 2; return st * 1024 + (ob ^ (((ob >> 9) & 1) << 5)); }
DEVI void stage_rc2(int b, int& R, int& C) { int st = b >> 10, sb = b & 1023, swz = sb ^ (((sb >> 9) & 1) << 5); R = (st >> 1) * 16 + swz / 64; C = (st & 1) * 32 + (swz % 64) / 2; }

template <int MODE, class Epi>
DEVI void gemm256_phase(int sw, const bf16_t* __restrict__ W, int ldw, const bf16_t* __restrict__ X, int ldx, int K, int nN, char* shm, const Epi& epi) {
  constexpr int TILE_B = 256 * 64 * 2, STAGE_B = 2 * TILE_B;
  const int wid = sw, lane = lane_id(), wr = wid >> 2, wc = wid & 3, fr = lane & 15, fq = lane >> 4;
  const int lds_lo = (fr * 64 + fq * 16) ^ ((fr >> 3) << 5);
  unsigned offW[4], offX[4];
#pragma unroll
  for (int i = 0; i < 4; ++i) { int R, C; stage_rc2(wid * 1024 + i * 8192 + lane * 16, R, C); offW[i] = (unsigned)(R * ldw + C) * 2u; offX[i] = (unsigned)(R * ldx + C) * 2u; }
  const int ntf = K >> 6;
  const int nM = (MODE == 0 || MODE == 3) ? 68 : 64, nfull = nM * nN, nunits = MODE == 2 ? nfull + 256 : nfull;
  auto decode = [&](int L, int& n0, int& m0, int& kt0, int& ntk) {
    if (MODE == 2 && L >= nfull) {
      const int j = L - nfull, tile = j >> 3, ks = j & 7;
      n0 = (tile & 7) * 256; m0 = (tile >> 3) * 17 * 256; ntk = ntf >> 3; kt0 = ks * ntk;
    } else {
      int wgid = L;
      { const int q = nfull / 8, r = nfull % 8, xcd = wgid % 8, off = wgid / 8; wgid = (xcd < r ? xcd * (q + 1) : r * (q + 1) + (xcd - r) * q) + off; }
      constexpr int WGM = 4;
      const int nig = WGM * nN, gid = wgid / nig, fm = gid * WGM, gsz = (nM - fm) < WGM ? (nM - fm) : WGM;
      const int pm = fm + ((wgid % nig) % gsz), pn = (wgid % nig) / gsz;
      n0 = pn * 256; m0 = (MODE == 0 ? pm : (pm / 16) * 17 + 1 + (pm % 16)) * 256; kt0 = 0; ntk = ntf;
    }
    if (MODE == 3) { n0 = 0; m0 = 0; }
    n0 = __builtin_amdgcn_readfirstlane(n0); m0 = __builtin_amdgcn_readfirstlane(m0);
    kt0 = __builtin_amdgcn_readfirstlane(kt0); ntk = __builtin_amdgcn_readfirstlane(ntk);
  };
  auto stage = [&](int buf, int n0, int m0, int kt) {
    const char* wk = (const char*)(W + (size_t)n0 * ldw) + kt * 128;
    const char* xk = (const char*)(X + (size_t)m0 * ldx) + kt * 128;
#pragma unroll
    for (int i = 0; i < 4; ++i) {
      unsigned ow = offW[i], ox = offX[i];
      asm volatile("" : "+v"(ow), "+v"(ox));
      __builtin_amdgcn_global_load_lds((const unsigned*)(wk + ow), (unsigned*)(shm + buf * STAGE_B + wid * 1024 + i * 8192), 16, 0, 0);
      __builtin_amdgcn_global_load_lds((const unsigned*)(xk + ox), (unsigned*)(shm + buf * STAGE_B + TILE_B + wid * 1024 + i * 8192), 16, 0, 0);
    }
  };
  int L = blockIdx.x;
  if (L >= nunits) return;
  int n0, m0, kt0, ntk;
  decode(L, n0, m0, kt0, ntk);
  int b0 = 0;
  stage(0, n0, m0, kt0);
  asm volatile("s_waitcnt vmcnt(0)" ::: "memory");
  __syncthreads();
  while (true) {
    const int Ln = L + gridDim.x;
    const bool has_next = Ln < nunits;
    int n1 = 0, m1 = 0, kt1 = 0, ntk1 = 0;
    if (has_next) decode(Ln, n1, m1, kt1, ntk1);
    f32x4 acc[8][4];
#pragma unroll
    for (int i = 0; i < 8; ++i)
#pragma unroll
      for (int j = 0; j < 4; ++j) acc[i][j] = (f32x4){0.f, 0.f, 0.f, 0.f};
    for (int t = 0; t < ntk; ++t) {
      const int cur = (b0 + t) & 1;
      const bool st_own = t + 1 < ntk, st_next = !st_own && has_next;
      if (wid < 4) {
        if (st_own) stage(cur ^ 1, n0, m0, kt0 + t + 1);
        else if (st_next) stage(cur ^ 1, n1, m1, kt1);
      }
      const char* SAp = shm + cur * STAGE_B + wr * (16 * 1024) + lds_lo;
      const char* SBp = shm + cur * STAGE_B + TILE_B + wc * (8 * 1024) + lds_lo;
#pragma unroll
      for (int ks = 0; ks < 2; ++ks) {
        const int kx = (wid >> 2) ? (1 - 2 * ks) * 1024 : 0;
        bf16x8 At[8], Bf[4];
#pragma unroll
        for (int m = 0; m < 8; ++m) At[m] = *(const bf16x8*)(SAp + (2 * m + ks) * 1024 + kx);
#pragma unroll
        for (int n = 0; n < 4; ++n) Bf[n] = *(const bf16x8*)(SBp + (2 * n + ks) * 1024 + kx);
#pragma unroll
        for (int m = 0; m < 8; ++m)
#pragma unroll
          for (int n = 0; n < 4; ++n) acc[m][n] = mfma16(At[m], Bf[n], acc[m][n]);
        __builtin_amdgcn_sched_barrier(0);
        if (ks == 0 && wid >= 4) {
          if (st_own) stage(cur ^ 1, n0, m0, kt0 + t + 1);
          else if (st_next) stage(cur ^ 1, n1, m1, kt1);
        }
      }
      asm volatile("s_waitcnt vmcnt(0)" ::: "memory");
      __syncthreads();
    }
    epi(acc, n0 + wr * 128, m0 + wc * 64, fr, fq, (MODE == 2 && L >= nfull) ? ((L - nfull) & 7) : -1);
    if (!has_next) break;
    b0 = (b0 + ntk) & 1; L = Ln; n0 = n1; m0 = m1; kt0 = kt1; ntk = ntk1;
  }
}

DEVI void cvt_tile(int sw, const float* __restrict__ src, int ldn, int Nvalid, bf16_t* __restrict__ dst, int ldk, int kt, int nt, int rmul, int roff, float* sm) {
  const int tid = VT;
  const int k0 = kt * 64, n0 = nt * 64;
  vbar(sm);
  {
    const int n4 = (tid & 15) * 4, n = n0 + n4;
    f32x4 v[4];
#pragma unroll
    for (int i = 0; i < 4; ++i) {
      const int kk = (tid >> 4) + 16 * i;
      v[i] = (n < Nvalid) ? *(const f32x4*)(src + (size_t)(k0 + kk) * ldn + n) : (f32x4){0.f, 0.f, 0.f, 0.f};
    }
#pragma unroll
    for (int i = 0; i < 4; ++i) {
      const int kk = (tid >> 4) + 16 * i;
#pragma unroll
      for (int jj = 0; jj < 4; ++jj) sm[(n4 + jj) * 65 + kk] = v[i][jj];
    }
  }
  vbar(sm);
  {
    int nn = tid >> 2, kq = tid & 3, n = n0 + nn;
    int drow = (n >> 4) * rmul + roff + (n & 15);
    const float* s = sm + nn * 65 + kq * 16;
    u32x4 a = {pk2(s[0], s[1]), pk2(s[2], s[3]), pk2(s[4], s[5]), pk2(s[6], s[7])};
    u32x4 b = {pk2(s[8], s[9]), pk2(s[10], s[11]), pk2(s[12], s[13]), pk2(s[14], s[15])};
    bf16_t* d = dst + (size_t)drow * ldk + k0 + kq * 16;
    *(u32x4*)d = a; *(u32x4*)(d + 8) = b;
  }
}
DEVI bool cvt_try(int sw, int& idx, const float* src, int N, int Npad, bf16_t* dst, int K, int ldk, int rmul, int roff, float* sm) {
  int kts = K >> 6, n = kts * (Npad >> 6);
  if (idx < n) { cvt_tile(sw, src, N, N, dst, ldk, idx % kts, idx / kts, rmul, roff, sm); return true; }
  idx -= n; return false;
}
DEVI void cvt_ffn(int sw, const P& p, int layer, int idx, float* sm) {
  bf16_t* gu = (bf16_t*)(p.ws + OFF_R2 + RF_GU); bf16_t* dn = (bf16_t*)(p.ws + OFF_R2 + RF_D);
  if (cvt_try(sw, idx, p.ffn_w_gate + (size_t)layer * D * FFN, FFN, FFN, gu, D, LDW, 32, 0, sm)) return;
  if (cvt_try(sw, idx, p.ffn_w_up + (size_t)layer * D * FFN, FFN, FFN, gu, D, LDW, 32, 16, sm)) return;
  cvt_try(sw, idx, p.ffn_w_down + (size_t)layer * FFN * D, D, D, dn, FFN, LDWF, 16, 0, sm);
}
constexpr int CVT_FFN_ITEMS = 3 * (D / 64) * (FFN / 64);
constexpr int CVT_MIX0_ITEMS = 32 * 84 + 8 * 24 + 8 * 32 + 32 * 32;
constexpr int CVT_MIX1_ITEMS = 32 * 100 + 32 * 32;
DEVI void cvt_mix0(int sw, const P& p, int idx, float* sm) {
  bf16_t* w = (bf16_t*)(p.ws + OFF_WMIX);
  if (cvt_try(sw, idx, p.ab_w_in, AB_IN, AB_INP, w + WM_IN, D, LDW, 16, 0, sm)) return;
  if (cvt_try(sw, idx, p.mla_w_uq, 1536, 1536, w + WM_UQ, 512, LDW5, 16, 0, sm)) return;
  if (cvt_try(sw, idx, p.mla_w_ukv, 2048, 2048, w + WM_UKV, 512, LDW5, 16, 0, sm)) return;
  cvt_try(sw, idx, p.ab_w_out, D, D, w + WM_OUT, D, LDW, 16, 0, sm);
}
DEVI void cvt_mix1(int sw, const P& p, int idx, float* sm) {
  bf16_t* w = (bf16_t*)(p.ws + OFF_WMIX);
  if (cvt_try(sw, idx, p.cd_w_in, CD_IN, CD_INP, w + WM_IN, D, LDW, 16, 0, sm)) return;
  cvt_try(sw, idx, p.cd_w_out, D, D, w + WM_OUT, D, LDW, 16, 0, sm);
}

DEVI void ada_item(int sw, const P& p, int item, float* sm) {
  const int tid = VT;
  const int l = item / 192, cb = item % 192;
  float* sc = sm;
  float* red = sm + 5 * 2048;
  vbar(sm);
  for (int i = tid; i < 5 * 2048; i += 256) {
    int s5 = i >> 11, k = i & 2047;
    float v = s5 < 4 ? p.c[s5 * D + k] : p.c_ctx[k];
    sc[i] = silu_f(v);
  }
  vbar(sm);
  const int ct = tid & 15, kg = tid >> 4;
  const float* w = p.ada_w + ((size_t)l * D + kg * 128) * MODN + cb * 64 + ct * 4;
  f32x4 a0 = {0.f, 0.f, 0.f, 0.f}, a1 = a0, a2 = a0, a3 = a0, a4 = a0;
#pragma unroll 16
  for (int k = 0; k < 128; ++k) {
    const f32x4 wv = *(const f32x4*)(w + (size_t)k * MODN);
    const int kk = kg * 128 + k;
    a0 += sc[kk] * wv; a1 += sc[2048 + kk] * wv; a2 += sc[4096 + kk] * wv; a3 += sc[6144 + kk] * wv; a4 += sc[8192 + kk] * wv;
  }
  *(f32x4*)(red + (kg * 5 + 0) * 64 + ct * 4) = a0; *(f32x4*)(red + (kg * 5 + 1) * 64 + ct * 4) = a1; *(f32x4*)(red + (kg * 5 + 2) * 64 + ct * 4) = a2;
  *(f32x4*)(red + (kg * 5 + 3) * 64 + ct * 4) = a3; *(f32x4*)(red + (kg * 5 + 4) * 64 + ct * 4) = a4;
  vbar(sm);
  for (int i = tid; i < 5 * 64; i += 256) {
    int s5 = i >> 6, cc = i & 63;
    float v = 0.f;
#pragma unroll
    for (int g = 0; g < 16; ++g) v += red[(g * 5 + s5) * 64 + cc];
    int n = cb * 64 + cc;
    ((float*)(p.ws + OFF_MOD))[((size_t)l * 5 + s5) * MODN + n] = v + p.ada_b[(size_t)l * MODN + n];
  }
}

DEVI void modulate_phase(int sw, const P& p, const float* g, const float* modl, int shift_i, int scale_i, bf16_t* H, const float* part = nullptr, const float* gate_ctx = nullptr, bool from_input = false) {
  const int lane = VT & 63;
  const int gw = (blockIdx.x * 2 + (sw >> 2)) * 4 + (sw & 3), nw = gridDim.x * 8;
  for (int r = gw; r < NT; r += nw) {
    const float* xr = xrow(p, r);
    if (from_input) { const int bb = r / TPB, qq = r - bb * TPB; xr = qq < CTX ? p.ctx + (size_t)(bb * CTX + qq) * D : p.x + (size_t)(bb * SEQ + qq - CTX) * D; }
    const float* mb = modl + (size_t)modidx(r) * MODN;
    f32x4 v[8]; float ss = 0.f;
#pragma unroll
    for (int i = 0; i < 8; ++i) v[i] = *(const f32x4*)(xr + i * 256 + lane * 4);
    if (part && modidx(r) == 4) {
      const int cr = (r / TPB) * CTX + (r % TPB);
#pragma unroll
      for (int i = 0; i < 8; ++i) {
        f32x4 sacc = {0.f, 0.f, 0.f, 0.f};
#pragma unroll
        for (int ks = 0; ks < 8; ++ks) sacc += *(const f32x4*)(part + ((size_t)(ks * (NB * CTX) + cr)) * D + i * 256 + lane * 4);
        v[i] += *(const f32x4*)(gate_ctx + i * 256 + lane * 4) * sacc;
        *(f32x4*)(xrow(p, r) + i * 256 + lane * 4) = v[i];
      }
    }
    if (from_input) {
      float* xw = xrow(p, r);
#pragma unroll
      for (int i = 0; i < 8; ++i) *(f32x4*)(xw + i * 256 + lane * 4) = v[i];
    }
#pragma unroll
    for (int i = 0; i < 8; ++i) ss += v[i][0] * v[i][0] + v[i][1] * v[i][1] + v[i][2] * v[i][2] + v[i][3] * v[i][3];
    ss = wave_sum(ss);
    float rs = rsqrtf(ss * (1.f / D) + EPS);
#pragma unroll
    for (int i = 0; i < 8; ++i) {
      int cidx = i * 256 + lane * 4;
      f32x4 gg = *(const f32x4*)(g + cidx), sh = *(const f32x4*)(mb + shift_i * D + cidx), sc = *(const f32x4*)(mb + scale_i * D + cidx);
      f32x4 y;
#pragma unroll
      for (int j = 0; j < 4; ++j) y[j] = v[i][j] * rs * gg[j] * (1.f + sc[j]) + sh[j];
      *(u32x2*)(H + (size_t)r * LDH + cidx) = pack4(y);
    }
  }
}

template <int DQK>
DEVI void attn256_item(int sw, const bf16_t* __restrict__ Q, int ldq, const bf16_t* __restrict__ Kp, int ldk, const bf16_t* __restrict__ Vt,
                       bf16_t* __restrict__ O, int ldo, int nkeys, float negB, char* shm) {
  constexpr int KS = DQK / 32, KCH = DQK / 8, KBYTES = 64 * DQK * 2, STG = KBYTES + 16384, NKI = (64 * KCH) / 512;
  const int wid = sw, lane = lane_id(), fr = lane & 15, fq = lane >> 4, rsw = (fr >> 1) & 7;
  unsigned offK[NKI], offV[2];
#pragma unroll
  for (int i = 0; i < NKI; ++i) {
    const int q = (wid * NKI + i) * 64 + lane, row = q / KCH, cp = q - row * KCH;
    const int c = (cp & ~7) | ((cp & 7) ^ ((row >> 1) & 7));
    offK[i] = (unsigned)(row * ldk + c * 8) * 2u;
  }
#pragma unroll
  for (int i = 0; i < 2; ++i) {
    const int q = (wid * 2 + i) * 64 + lane, row = q >> 3, cp = q & 7;
    const int c = cp ^ ((row >> 1) & 7);
    offV[i] = (unsigned)(row * TPS + c * 8) * 2u;
  }
  auto stage = [&](int buf, int k0) {
    const char* kb = (const char*)(Kp + (size_t)k0 * ldk);
    const char* vb = (const char*)(Vt + k0);
#pragma unroll
    for (int i = 0; i < NKI; ++i) {
      unsigned o = offK[i]; asm volatile("" : "+v"(o));
      __builtin_amdgcn_global_load_lds((const unsigned*)(kb + o), (unsigned*)(shm + buf * STG + (wid * NKI + i) * 1024), 16, 0, 0);
    }
#pragma unroll
    for (int i = 0; i < 2; ++i) {
      unsigned o = offV[i]; asm volatile("" : "+v"(o));
      __builtin_amdgcn_global_load_lds((const unsigned*)(vb + o), (unsigned*)(shm + buf * STG + KBYTES + (wid * 2 + i) * 1024), 16, 0, 0);
    }
  };
  bf16x8 qf[2][KS];
#pragma unroll
  for (int nt = 0; nt < 2; ++nt)
#pragma unroll
    for (int ks = 0; ks < KS; ++ks) qf[nt][ks] = *(const bf16x8*)(Q + (size_t)(wid * 32 + nt * 16 + fr) * ldq + ks * 32 + fq * 8);
  f32x4 o[8][2];
#pragma unroll
  for (int i = 0; i < 8; ++i) { o[i][0] = (f32x4){0.f, 0.f, 0.f, 0.f}; o[i][1] = (f32x4){0.f, 0.f, 0.f, 0.f}; }
  float l_[2] = {0.f, 0.f};
  const int ntile = nkeys >> 6;
  __syncthreads();
  stage(0, 0);
  asm volatile("s_waitcnt vmcnt(0)" ::: "memory");
  __syncthreads();
  for (int t = 0; t < ntile; ++t) {
    const int cur = t & 1;
    if (wid < 4 && t + 1 < ntile) stage(cur ^ 1, (t + 1) * 64);
    const bf16_t* Ks = (const bf16_t*)(shm + cur * STG);
    const char* Vs = shm + cur * STG + KBYTES;
#pragma unroll
    for (int half = 0; half < 2; ++half) {
      f32x4 s[2][2];
#pragma unroll
      for (int i = 0; i < 2; ++i) { s[i][0] = (f32x4){negB, negB, negB, negB}; s[i][1] = (f32x4){negB, negB, negB, negB}; }
#pragma unroll
      for (int ks = 0; ks < KS; ++ks)
#pragma unroll
        for (int kt = 0; kt < 2; ++kt) {
          const int krow = half * 32 + 8 * (fr >> 2) + 4 * kt + (fr & 3);
          const int ksw = (krow >> 1) & 7;
          bf16x8 kf = *(const bf16x8*)(Ks + krow * DQK + ((((ks * 4 + fq) & ~7) | (((ks * 4 + fq) & 7) ^ ksw)) * 8));
          s[kt][0] = mfma16(kf, qf[0][ks], s[kt][0]);
          s[kt][1] = mfma16(kf, qf[1][ks], s[kt][1]);
        }
      bf16x8 pf[2];
#pragma unroll
      for (int nt = 0; nt < 2; ++nt) {
        float rs = 0.f;
#pragma unroll
        for (int kt = 0; kt < 2; ++kt)
#pragma unroll
          for (int j = 0; j < 4; ++j) { float pv = __builtin_amdgcn_exp2f(s[kt][nt][j]); s[kt][nt][j] = pv; rs += pv; }
        l_[nt] += rs;
        pf[nt] = pack8(s[0][nt], s[1][nt]);
      }
#pragma unroll
      for (int dt = 0; dt < 8; ++dt) {
        bf16x8 vf = *(const bf16x8*)(Vs + (dt * 16 + fr) * 128 + (((half * 4 + fq) ^ rsw) * 16));
        o[dt][0] = mfma16(vf, pf[0], o[dt][0]);
        o[dt][1] = mfma16(vf, pf[1], o[dt][1]);
      }
      if (half == 0 && wid >= 4 && t + 1 < ntile) stage(cur ^ 1, (t + 1) * 64);
    }
    asm volatile("s_waitcnt vmcnt(0)" ::: "memory");
    __syncthreads();
  }
#pragma unroll
  for (int nt = 0; nt < 2; ++nt) {
    float l = l_[nt];
    l += __shfl_xor(l, 16); l += __shfl_xor(l, 32);
    float inv = 1.f / l;
#pragma unroll
    for (int dt = 0; dt < 8; ++dt) {
      f32x4 v = o[dt][nt] * inv;
      *(u32x2*)(O + (size_t)(wid * 32 + nt * 16 + fr) * ldo + dt * 16 + fq * 4) = pack4(v);
    }
  }
}

DEVI void prep0_norm512(int sw, const P& p, int item) {
  const int lane = lane_id();
  const int w0 = (item * 4 + (sw & 3)) * 8;
  u32x4 u[8];
#pragma unroll
  for (int q = 0; q < 8; ++q) { int w = w0 + q, r = w >> 1, which = w & 1; u[q] = *(const u32x4*)((const bf16_t*)(p.ws + OFF_Z) + (size_t)r * LDZ0 + which * 512 + lane * 8); }
#pragma unroll
  for (int q = 0; q < 8; ++q) {
    int w = w0 + q, r = w >> 1, which = w & 1;
    float v[8] = {bflo(u[q][0]), bfhi(u[q][0]), bflo(u[q][1]), bfhi(u[q][1]), bflo(u[q][2]), bfhi(u[q][2]), bflo(u[q][3]), bfhi(u[q][3])};
    float ss = 0.f;
#pragma unroll
    for (int j = 0; j < 8; ++j) ss += v[j] * v[j];
    ss = wave_sum(ss);
    float rs = rsqrtf(ss * (1.f / 512.f) + EPS);
    const float* g = (which ? p.mla_kv_a_norm : p.mla_q_a_norm) + lane * 8;
    u32x4 o = {pk2(v[0] * rs * g[0], v[1] * rs * g[1]), pk2(v[2] * rs * g[2], v[3] * rs * g[3]), pk2(v[4] * rs * g[4], v[5] * rs * g[5]), pk2(v[6] * rs * g[6], v[7] * rs * g[7])};
    *(u32x4*)((bf16_t*)(p.ws + OFF_H) + (size_t)which * NT * LDQA + (size_t)r * LDQA + lane * 8) = o;
  }
}
DEVI void store_T(int sw, const bf16_t* T, bf16_t* __restrict__ dst) {
  const int tid = VT;
#pragma unroll
  for (int i = 0; i < 4; ++i) {
    const int c = tid + 256 * i, row = c >> 3, ch = c & 7;
    *(u32x4*)(dst + (size_t)row * TPS + ch * 8) = *(const u32x4*)(T + row * 72 + ch * 8);
  }
}
DEVI void put_T(bf16_t* T, int d, int half, const float (&y)[32]) {
#pragma unroll
  for (int i = 0; i < 4; ++i) {
    u32x4 u = {pk2(y[8 * i], y[8 * i + 1]), pk2(y[8 * i + 2], y[8 * i + 3]), pk2(y[8 * i + 4], y[8 * i + 5]), pk2(y[8 * i + 6], y[8 * i + 7])};
    *(u32x4*)(T + d * 72 + half * 32 + 8 * i) = u;
  }
}
DEVI void prep0_gdn(int sw, const P& p, int item, float* sm) {
  const int tid = VT;
  const int which = item & 3; int t = item >> 2;
  const int mc = t % NCH; t /= NCH;
  const int h = t & 7, b = t >> 3;
  const int p0 = mc * 64;
  const int bh = b * 8 + h;
  char* R2 = p.ws + OFF_R2;
  if (which == 3) {
    if (tid < 128) {
      const int dir = tid >> 6, ln = tid & 63;
      const int c = dir ? 63 - ln : ln;
      const float* gr = (const float*)(R2 + R_GATES) + (size_t)(b * TPB + p0 + c) * 32;
      const float A = __expf(p.gdn_a_log[dir * 8 + h]), dtb = p.gdn_dt_bias[dir * 8 + h];
      const float a = gr[dir * 8 + h] + dtb, bb = gr[16 + dir * 8 + h];
      const float sp = fmaxf(a, 0.f) + log1pf(__expf(-fabsf(a)));
      float v = -A * sp;
#pragma unroll
      for (int off = 1; off < 64; off <<= 1) { float t2 = __shfl_up(v, off); if (ln >= off) v += t2; }
      ((float*)(R2 + R_GC))[(size_t)(bh * 2 + dir) * TPB + p0 + c] = v;
      ((float*)(R2 + R_BETA))[(size_t)(bh * 2 + dir) * TPB + p0 + c] = 1.f / (1.f + __expf(-bb));
    }
    vbar(sm);
    return;
  }
  const int d = tid & 127, half = tid >> 7;
  const int col0 = 1088 + which * 1024 + h * 128;
  const int col = col0 + d;
  const int lo = p0 < CTX ? 0 : CTX, hi = p0 < CTX ? CTX : TPB;
  bf16_t* xin = (bf16_t*)sm;
  float* sq = (float*)(xin + 72 * 128);
  float* nrm = sq + 64 * 129;
  bf16_t* yb = (bf16_t*)(nrm + 64);
  vbar(sm);
  {
    const bf16_t* zb = (const bf16_t*)(p.ws + OFF_Z) + (size_t)(b * TPB) * LDZ0 + col0;
    for (int c = tid; c < 68 * 16; c += 256) {
      const int row = c >> 4, ch = c & 15, pp = p0 - 2 + row;
      u32x4 v = {0u, 0u, 0u, 0u};
      if (pp >= lo && pp < hi) v = *(const u32x4*)(zb + (size_t)pp * LDZ0 + ch * 8);
      *(u32x4*)(xin + row * 128 + ch * 8) = v;
    }
  }
  vbar(sm);
  const float w0 = p.gdn_conv_w[0 * 3072 + col - 1088], w1 = p.gdn_conv_w[1 * 3072 + col - 1088], w2 = p.gdn_conv_w[2 * 3072 + col - 1088],
              w3 = p.gdn_conv_w[3 * 3072 + col - 1088], w4 = p.gdn_conv_w[4 * 3072 + col - 1088];
  const int ps = p0 + half * 32;
  const bf16_t* xc = xin + (half * 32) * 128 + d;
  float xm2 = bf2f(xc[0]), xm1 = bf2f(xc[128]), x0 = bf2f(xc[256]), xp1 = bf2f(xc[384]);
  float y[32];
#pragma unroll
  for (int i = 0; i < 32; ++i) {
    float xp2 = bf2f(xc[(i + 4) * 128]);
    float a = w0 * xm2 + w1 * xm1 + w2 * x0 + w3 * xp1 + w4 * xp2;
    y[i] = silu_f(a);
    xm2 = xm1; xm1 = x0; x0 = xp1; xp1 = xp2;
  }
  if (which == 2) {
    vbar(sm);
    put_T(xin, d, half, y);
    vbar(sm);
    store_T(sw, xin, (bf16_t*)(R2 + R_GVT) + ((size_t)bh * 128) * TPS + p0);
    return;
  }
#pragma unroll
  for (int i = 0; i < 32; ++i) sq[(half * 32 + i) * 129 + d] = y[i] * y[i];
  vbar(sm);
  {
    int c = tid >> 2, part = tid & 3;
    float sacc = 0.f;
    for (int i = 0; i < 32; ++i) sacc += sq[c * 129 + part * 32 + i];
    sacc += __shfl_xor(sacc, 1); sacc += __shfl_xor(sacc, 2);
    if (part == 0) nrm[c] = rsqrtf(sacc + EPS) * (which == 0 ? 0.08838834764831845f : 1.f);
  }
  vbar(sm);
#pragma unroll
  for (int i = 0; i < 32; ++i) { y[i] *= nrm[half * 32 + i]; yb[(half * 32 + i) * 136 + d] = f2bf(y[i]); }
  if (which == 1) put_T(xin, d, half, y);
  vbar(sm);
  if (which == 1) store_T(sw, xin, (bf16_t*)(R2 + R_GKT) + ((size_t)bh * 128) * TPS + p0);
  {
    bf16_t* dq = (bf16_t*)(R2 + (which == 0 ? R_GQ : R_GK)) + ((size_t)bh * TPB + p0) * 128;
#pragma unroll
    for (int i = 0; i < 4; ++i) {
      const int c = tid + 256 * i, row = c >> 4, ch = c & 15;
      *(u32x4*)(dq + row * 128 + ch * 8) = *(const u32x4*)(yb + row * 136 + ch * 8);
    }
  }
}

DEVI float rope64(float val, int lane, int t) {
  int i = lane & 15, hf = (lane >> 4) & 1, axis = lane >> 5;
  float pos = (float)(axis ? (t & 63) : (t >> 6));
  float invf = exp2f(-(float)(2 * i) * (13.287712379549449f / 32.f));
  float ang = pos * invf;
  float cs = __cosf(ang), sn = __sinf(ang);
  float partner = __shfl_xor(val, 16);
  return hf ? (val * cs + partner * sn) : (val * cs - partner * sn);
}

DEVI void prep0_q(int sw, const P& p, int item) {
  const int lane = lane_id();
  const int w0 = (item * 4 + (sw & 3)) * 8;
  const int r = w0 >> 3;
  bf16_t* qb = (bf16_t*)(p.ws + OFF_R2 + R_QUP) + (size_t)r * 1536;
  float a[8], b[8], c[8];
#pragma unroll
  for (int h = 0; h < 8; ++h) { a[h] = bf2f(qb[h * 192 + lane]); b[h] = bf2f(qb[h * 192 + 64 + lane]); c[h] = bf2f(qb[h * 192 + 128 + lane]); }
  const float g0 = p.mla_q_norm[lane], g1 = p.mla_q_norm[64 + lane], g2 = p.mla_q_norm[128 + lane];
  const int pp = r % TPB;
  const float sc = 0.07216878364870322f * LOG2E;
#pragma unroll
  for (int h = 0; h < 8; ++h) {
    float ss = wave_sum(a[h] * a[h] + b[h] * b[h] + c[h] * c[h]);
    float rs = rsqrtf(ss * (1.f / 192.f) + EPS);
    float x = a[h] * rs * g0, y = b[h] * rs * g1, z = c[h] * rs * g2;
    if (pp >= CTX) z = rope64(z, lane, pp - CTX);
    qb[h * 192 + lane] = f2bf(x * sc); qb[h * 192 + 64 + lane] = f2bf(y * sc); qb[h * 192 + 128 + lane] = f2bf(z * sc);
  }
}
DEVI void prep0_k(int sw, const P& p, int item) {
  const int lane = lane_id();
  const int w0 = (item * 4 + (sw & 3)) * 8;
  const int r = w0 >> 3;
  const bf16_t* kv = (const bf16_t*)(p.ws + OFF_MIX) + (size_t)r * LDH;
  const float c0 = bf2f(((const bf16_t*)(p.ws + OFF_Z) + (size_t)r * LDZ0 + 1024)[lane]);
  float a[8], b[8];
#pragma unroll
  for (int h = 0; h < 8; ++h) { a[h] = bf2f(kv[h * 256 + lane]); b[h] = bf2f(kv[h * 256 + 64 + lane]); }
  const float g0 = p.mla_k_norm[lane], g1 = p.mla_k_norm[64 + lane], g2 = p.mla_k_norm[128 + lane];
  const int pp = r % TPB;
  bf16_t* k = (bf16_t*)(p.ws + OFF_R2 + R_K) + (size_t)r * LDK;
#pragma unroll
  for (int h = 0; h < 8; ++h) {
    float ss = wave_sum(a[h] * a[h] + b[h] * b[h] + c0 * c0);
    float rs = rsqrtf(ss * (1.f / 192.f) + EPS);
    float x = a[h] * rs * g0, y = b[h] * rs * g1, z = c0 * rs * g2;
    if (pp >= CTX) z = rope64(z, lane, pp - CTX);
    k[h * 192 + lane] = f2bf(x); k[h * 192 + 64 + lane] = f2bf(y); k[h * 192 + 128 + lane] = f2bf(z);
  }
}
DEVI void transpose64x128(int sw, const bf16_t* __restrict__ src, int ld, bf16_t* __restrict__ dst  , char* smb) {
  const int tid = VT, d = tid & 127, half = tid >> 7;
  float y[32];
#pragma unroll
  for (int i = 0; i < 32; ++i) y[i] = bf2f(src[(size_t)(half * 32 + i) * ld + d]);
  bf16_t* T = (bf16_t*)smb;
  vbar(smb);
  put_T(T, d, half, y);
  vbar(smb);
  store_T(sw, T, dst);
}
DEVI void gdn_pre(int sw, const P& p, int item, char* smraw) {
  const int tid = VT, lane = tid & 63, wid = tid >> 6, fr = lane & 15, fq = lane >> 4;
  const int mc = item % NCH; int t = item / NCH;
  const int dir = t & 1, bh = t >> 1;
  const int p0 = mc * 64;
  char* R2 = p.ws + OFF_R2;
  bf16_t* qs = (bf16_t*)smraw;
  bf16_t* ks = qs + 64 * 136;
  float* Ls = (float*)(ks + 64 * 136);
  float* gcs = Ls + 4096;
  float* bes = gcs + 64;
  vbar(smraw);
  {
    const bf16_t* gq = (const bf16_t*)(R2 + R_GQ) + ((size_t)bh * TPB + p0) * 128;
    const bf16_t* gk = (const bf16_t*)(R2 + R_GK) + ((size_t)bh * TPB + p0) * 128;
#pragma unroll
    for (int i = 0; i < 4; ++i) {
      int c = tid + 256 * i, row = c >> 4, kc = c & 15;
      *(u32x4*)(qs + row * 136 + kc * 8) = *(const u32x4*)(gq + row * 128 + kc * 8);
      *(u32x4*)(ks + row * 136 + kc * 8) = *(const u32x4*)(gk + row * 128 + kc * 8);
    }
    if (tid < 64) {
      gcs[tid] = ((const float*)(R2 + R_GC))[(size_t)(bh * 2 + dir) * TPB + p0 + tid];
      bes[tid] = ((const float*)(R2 + R_BETA))[(size_t)(bh * 2 + dir) * TPB + p0 + tid];
    }
  }
  vbar(smraw);
  {
    const int it = wid;
    const int i = it * 16 + fr;
    const float gi = gcs[i], bi = bes[i];
    bf16x8 bq[4], bk[4];
#pragma unroll
    for (int s = 0; s < 4; ++s) {
      bq[s] = *(const bf16x8*)(qs + i * 136 + s * 32 + fq * 8);
      bk[s] = *(const bf16x8*)(ks + i * 136 + s * 32 + fq * 8);
    }
    bf16_t* qkm = (bf16_t*)(R2 + R_QKM) + (size_t)item * 4096;
#pragma unroll
    for (int jt = 0; jt < 4; ++jt) {
      f32x4 akk = {0.f, 0.f, 0.f, 0.f}, aqk = {0.f, 0.f, 0.f, 0.f};
#pragma unroll
      for (int s = 0; s < 4; ++s) {
        bf16x8 a = *(const bf16x8*)(ks + (jt * 16 + fr) * 136 + s * 32 + fq * 8);
        akk = mfma16(a, bk[s], akk);
        aqk = mfma16(a, bq[s], aqk);
      }
      f32x4 qo;
#pragma unroll
      for (int jj = 0; jj < 4; ++jj) {
        int j = jt * 16 + fq * 4 + jj;
        float gj = gcs[j];
        bool before = dir ? (j > i) : (j < i);
        bool incl = before || (j == i);
        float e = incl ? __expf(gi - gj) : 0.f;
        qo[jj] = aqk[jj] * e;
        float lv = before ? bi * akk[jj] * e : 0.f;
        int ti = dir ? 63 - i : i, tj = dir ? 63 - j : j;
        Ls[tj * 64 + ti] = lv;
      }
      *(u32x2*)(qkm + i * 64 + jt * 16 + fq * 4) = pack4(qo);
    }
  }
  vbar(smraw);
  if (wid == 0) {
    const int j = lane;
    const int sj = dir ? 63 - j : j;
    float x[64];
#pragma unroll
    for (int t2 = 0; t2 < 64; ++t2) x[t2] = (t2 == sj) ? 1.f : 0.f;
    typedef __attribute__((address_space(3))) const f32x4 lds_f32x4;
    unsigned lofs = (unsigned)(size_t)(__attribute__((address_space(3))) const float*)Ls;
    asm volatile("" : "+v"(lofs));
    lds_f32x4* L4 = (lds_f32x4*)(size_t)lofs;
    f32x4 rowv[16];
#pragma unroll
    for (int g = 0; g < 16; ++g) rowv[g] = L4[g];
#pragma unroll
    for (int t2 = 0; t2 < 63; ++t2) {
      f32x4 nxt[16];
#pragma unroll
      for (int g = 0; g < 16; ++g) nxt[g] = (t2 + 1 < 63 && g >= (t2 + 2) / 4) ? L4[(t2 + 1) * 16 + g] : (f32x4){0.f, 0.f, 0.f, 0.f};
      const float xt = x[t2];
#pragma unroll
      for (int i = t2 + 1; i < 64; ++i) x[i] -= rowv[i >> 2][i & 3] * xt;
#pragma unroll
      for (int g = 0; g < 16; ++g) rowv[g] = nxt[g];
    }
    bf16_t* tm = (bf16_t*)(R2 + R_TM) + (size_t)item * 4096;
#pragma unroll
    for (int t2 = 0; t2 < 64; ++t2) {
      int i = dir ? 63 - t2 : t2;
      tm[i * 64 + j] = f2bf(x[t2]);
    }
  }
}

template <bool GDN>
DEVI void scan_chain(int sw, const P& p, int item, char* smraw) {
  const int tid = VT, lane = tid & 63, wid = tid >> 6, fr = lane & 15, fq = lane >> 4;
  int slice, dir, h, b, NH, DV;
  if (GDN) { slice = item & 1; dir = (item >> 1) & 1; h = (item >> 2) & 7; b = item >> 5; NH = 8; DV = 128; }
  else { slice = item & 3; dir = (item >> 2) & 1; h = (item >> 3) & 3; b = item >> 5; NH = 4; DV = 256; }
  const int bh = b * NH + h, bhd = bh * 2 + dir;
  char* R2 = p.ws + OFF_R2;
  bf16_t* kbg = (bf16_t*)smraw;
  bf16_t* qd = kbg + 64 * 136;
  bf16_t* kend = qd + 64 * 136;
  bf16_t* Tm = kend + 128 * 72;
  bf16_t* QK = Tm + 64 * 72;
  float* f_e = (float*)(QK + 64 * 72);
  float* f_b = f_e + 64;
  float* f_k = f_b + 64;
  float* el = f_k + 64;
  float* f_last = el + 128;
  const int e0 = slice * 64 + wid * 16;
  f32x4 S[8];
#pragma unroll
  for (int i = 0; i < 8; ++i) S[i] = (f32x4){0.f, 0.f, 0.f, 0.f};
  bf16_t* rec = (bf16_t*)(GDN ? (p.ws + OFF_H) : (R2 + R1_REC)) + (size_t)dir * NT * 1024;
  for (int n = 0; n < NCH; ++n) {
    const int mc = dir == 0 ? n : (n < 4 ? 3 - n : 71 - n);
    const int p0 = mc * 64;
    const int itc = bhd * NCH + mc;
    __syncthreads();
    if (GDN) {
      if (tid < 64) {
        const float* gc = (const float*)(R2 + R_GC) + (size_t)bhd * TPB + p0;
        float gcv = gc[tid], gl = gc[dir ? 0 : 63];
        f_e[tid] = __expf(gcv);
        f_b[tid] = ((const float*)(R2 + R_BETA))[(size_t)bhd * TPB + p0 + tid];
        f_k[tid] = __expf(gl - gcv);
        if (tid == 0) f_last[0] = __expf(gl);
      }
    } else {
      if (tid < 128) el[tid] = ((const float*)(R2 + R1_EL))[(size_t)itc * 128 + tid];
    }
    __syncthreads();
    if (GDN) {
      const bf16_t* gq = (const bf16_t*)(R2 + R_GQ) + ((size_t)bh * TPB + p0) * 128;
      const bf16_t* gk = (const bf16_t*)(R2 + R_GK) + ((size_t)bh * TPB + p0) * 128;
      const bf16_t* gkt = (const bf16_t*)(R2 + R_GKT) + ((size_t)bh * 128) * TPS + p0;
      const bf16_t* tm = (const bf16_t*)(R2 + R_TM) + (size_t)itc * 4096;
      const bf16_t* qkm = (const bf16_t*)(R2 + R_QKM) + (size_t)itc * 4096;
#pragma unroll
      for (int i = 0; i < 4; ++i) {
        int c = tid + 256 * i, row = c >> 4, kc = c & 15;
        u32x4 uq = *(const u32x4*)(gq + row * 128 + kc * 8), uk = *(const u32x4*)(gk + row * 128 + kc * 8);
        float fe = f_e[row], fk = f_b[row] * fe;
        u32x4 oq, ok;
#pragma unroll
        for (int j = 0; j < 4; ++j) { oq[j] = pk2(bflo(uq[j]) * fe, bfhi(uq[j]) * fe); ok[j] = pk2(bflo(uk[j]) * fk, bfhi(uk[j]) * fk); }
        *(u32x4*)(qd + row * 136 + kc * 8) = oq;
        *(u32x4*)(kbg + row * 136 + kc * 8) = ok;
      }
#pragma unroll
      for (int i = 0; i < 4; ++i) {
        int c = tid + 256 * i, row = c >> 3, cc = c & 7;
        u32x4 u = *(const u32x4*)(gkt + (size_t)row * TPS + cc * 8), o;
#pragma unroll
        for (int j = 0; j < 4; ++j) o[j] = pk2(bflo(u[j]) * f_k[cc * 8 + 2 * j], bfhi(u[j]) * f_k[cc * 8 + 2 * j + 1]);
        *(u32x4*)(kend + row * 72 + cc * 8) = o;
      }
#pragma unroll
      for (int i = 0; i < 2; ++i) {
        int c = tid + 256 * i, row = c >> 3, cc = c & 7;
        *(u32x4*)(Tm + row * 72 + cc * 8) = *(const u32x4*)(tm + row * 64 + cc * 8);
        *(u32x4*)(QK + row * 72 + cc * 8) = *(const u32x4*)(qkm + row * 64 + cc * 8);
      }
    } else {
      const bf16_t* gq = (const bf16_t*)(R2 + R1_QG) + ((size_t)bhd * TPB + p0) * 128;
      const bf16_t* gkt = (const bf16_t*)(R2 + R1_KGT) + ((size_t)bhd * 128) * TPS + p0;
      const bf16_t* am = (const bf16_t*)(R2 + R1_AM) + (size_t)itc * 4096;
#pragma unroll
      for (int i = 0; i < 4; ++i) {
        int c = tid + 256 * i, row = c >> 4, kc = c & 15;
        *(u32x4*)(qd + row * 136 + kc * 8) = *(const u32x4*)(gq + row * 128 + kc * 8);
      }
#pragma unroll
      for (int i = 0; i < 4; ++i) {
        int c = tid + 256 * i, row = c >> 3, cc = c & 7;
        *(u32x4*)(kend + row * 72 + cc * 8) = *(const u32x4*)(gkt + (size_t)row * TPS + cc * 8);
      }
#pragma unroll
      for (int i = 0; i < 2; ++i) {
        int c = tid + 256 * i, row = c >> 3, cc = c & 7;
        *(u32x4*)(QK + row * 72 + cc * 8) = *(const u32x4*)(am + row * 64 + cc * 8);
      }
    }
    __syncthreads();
    bf16x8 Sop[4];
#pragma unroll
    for (int ks = 0; ks < 4; ++ks) Sop[ks] = pack8(S[2 * ks], S[2 * ks + 1]);
    bf16x8 vop[2];
    if (GDN) {
      const bf16_t* gvt = (const bf16_t*)(R2 + R_GVT) + ((size_t)bh * 128 + e0 + fr) * TPS + p0;
      f32x4 X[4];
#pragma unroll
      for (int ct = 0; ct < 4; ++ct) {
        u32x2 u = *(const u32x2*)(gvt + ct * 16 + fq * 4);
        const float* fb = f_b + ct * 16 + fq * 4;
        f32x4 vb = {bflo(u[0]) * fb[0], bfhi(u[0]) * fb[1], bflo(u[1]) * fb[2], bfhi(u[1]) * fb[3]};
        f32x4 acc = {0.f, 0.f, 0.f, 0.f};
#pragma unroll
        for (int ks = 0; ks < 4; ++ks) acc = mfma16(ldsperm(kbg, ct * 16 + fr, 136, ks, fq), Sop[ks], acc);
        X[ct] = vb - acc;
      }
      bf16x8 Xop[2] = {pack8(X[0], X[1]), pack8(X[2], X[3])};
      f32x4 vn[4];
#pragma unroll
      for (int ct = 0; ct < 4; ++ct) {
        f32x4 acc = {0.f, 0.f, 0.f, 0.f};
#pragma unroll
        for (int kk = 0; kk < 2; ++kk) acc = mfma16(ldsperm(Tm, ct * 16 + fr, 72, kk, fq), Xop[kk], acc);
        vn[ct] = acc;
      }
      vop[0] = pack8(vn[0], vn[1]); vop[1] = pack8(vn[2], vn[3]);
    } else {
      const bf16_t* gvt = (const bf16_t*)(R2 + R1_VTG) + ((size_t)bh * 256 + e0 + fr) * TPS + p0;
#pragma unroll
      for (int kk = 0; kk < 2; ++kk) {
        u32x2 lo = *(const u32x2*)(gvt + kk * 32 + fq * 4), hi = *(const u32x2*)(gvt + kk * 32 + 16 + fq * 4);
        vop[kk] = cat8(lo, hi);
      }
    }
#pragma unroll
    for (int ct = 0; ct < 4; ++ct) {
      f32x4 acc = {0.f, 0.f, 0.f, 0.f};
#pragma unroll
      for (int ks = 0; ks < 4; ++ks) acc = mfma16(Sop[ks], ldsperm(qd, ct * 16 + fr, 136, ks, fq), acc);
#pragma unroll
      for (int kk = 0; kk < 2; ++kk) acc = mfma16(vop[kk], ldsperm(QK, ct * 16 + fr, 72, kk, fq), acc);
      *(u32x2*)(rec + (size_t)(b * TPB + p0 + ct * 16 + fr) * 1024 + h * DV + e0 + fq * 4) = pack4(acc);
    }
#pragma unroll
    for (int dt = 0; dt < 8; ++dt) {
      if (GDN) S[dt] *= f_last[0];
      else S[dt] *= *(const f32x4*)(el + dt * 16 + fq * 4);
#pragma unroll
      for (int kk = 0; kk < 2; ++kk) S[dt] = mfma16(ldsperm(kend, dt * 16 + fr, 72, kk, fq), vop[kk], S[dt]);
    }
  }
}

DEVI void fin0_rec(int sw, const P& p, int item) {
  const int lane = lane_id();
  const int w0 = (item * 4 + (sw & 3)) * 8;
  const int r = w0 >> 3;
  const bf16_t* r0 = (const bf16_t*)(p.ws + OFF_H) + (size_t)r * 1024 + lane * 2;
  const bf16_t* zz = (const bf16_t*)(p.ws + OFF_Z) + (size_t)r * LDZ0 + 4160 + lane * 2;
  unsigned u0[8], u1[8], uz[8];
#pragma unroll
  for (int h = 0; h < 8; ++h) { u0[h] = *(const unsigned*)(r0 + h * 128); u1[h] = *(const unsigned*)(r0 + (size_t)NT * 1024 + h * 128); uz[h] = *(const unsigned*)(zz + h * 128); }
  const float n0 = p.gdn_out_norm[lane * 2], n1 = p.gdn_out_norm[lane * 2 + 1];
#pragma unroll
  for (int h = 0; h < 8; ++h) {
    float a = bflo(u0[h]) + bflo(u1[h]), b = bfhi(u0[h]) + bfhi(u1[h]);
    float ss = wave_sum(a * a + b * b);
    float rs = rsqrtf(ss * (1.f / 128.f) + EPS);
    float oa = a * rs * n0 * silu_f(bflo(uz[h])), ob = b * rs * n1 * silu_f(bfhi(uz[h]));
    *(unsigned*)((bf16_t*)(p.ws + OFF_MIX) + (size_t)r * LDH + 1024 + h * 128 + lane * 2) = pk2(oa, ob);
  }
}

DEVI void prep1_qk(int sw, const P& p, int item) {
  const int lane = lane_id();
  const int w = item * 4 + (sw & 3);
  const int which = w & 1, r = w >> 1;
  bf16_t* q = (bf16_t*)(p.ws + OFF_Z) + (size_t)r * LDZ1 + which * 1024;
  float a[16];
#pragma unroll
  for (int hm = 0; hm < 16; ++hm) a[hm] = bf2f(q[hm * 64 + lane]);
  const float* gn = which ? p.diff_k_norm : p.diff_q_norm;
  const float g0 = gn[lane], g1 = gn[64 + lane];
  const int pp = r % TPB;
#pragma unroll
  for (int hm = 0; hm < 16; ++hm) {
    float ss = wave_sum(a[hm] * a[hm]);
    float rs = rsqrtf(ss * (1.f / 64.f) + EPS);
    float x = a[hm] * rs * ((hm & 1) ? g1 : g0);
    if (pp >= CTX) x = rope64(x, lane, pp - CTX);
    if (which == 0) x *= 0.125f * LOG2E;
    q[hm * 64 + lane] = f2bf(x);
  }
}
DEVI void gla_pre(int sw, const P& p, int item, char* smraw) {
  const int tid = VT, lane = tid & 63, wid = tid >> 6, fr = lane & 15, fq = lane >> 4;
  const int mc = item % NCH; int t = item / NCH;
  const int dir = t & 1, bh = t >> 1, h = bh & 3, b = bh >> 2;
  const int p0 = mc * 64;
  char* R2 = p.ws + OFF_R2;
  float* cum = (float*)smraw;
  float* lr = cum + 64 * 129;
  float* last = lr + 64 * 16;
  bf16_t* QS = (bf16_t*)(last + 128);
  bf16_t* KS = QS + 64 * 136;
  const bf16_t* z = (const bf16_t*)(p.ws + OFF_Z) + (size_t)(b * TPB + p0) * LDZ1;
  vbar(smraw);
#pragma unroll
  for (int i = tid; i < 64 * 16; i += 256) lr[i] = ((const float*)(R2 + R1_GATES))[(size_t)(b * TPB + p0 + (i >> 4)) * 32 + dir * 16 + (i & 15)];
  vbar(smraw);
  {
    const int d = tid & 127, half = tid >> 7;
    float w2[16];
#pragma unroll
    for (int rr = 0; rr < 16; ++rr) w2[rr] = p.gla_gate_w2[((size_t)dir * 16 + rr) * 512 + h * 128 + d];
    const float b2 = p.gla_gate_b2[dir * 512 + h * 128 + d];
#pragma unroll 4
    for (int i = 0; i < 32; ++i) {
      int c = half * 32 + i;
      float lg = b2;
#pragma unroll
      for (int rr = 0; rr < 16; ++rr) lg += lr[c * 16 + rr] * w2[rr];
      float ls = fminf(lg, 0.f) - __logf(1.f + __expf(-fabsf(lg)));
      cum[c * 129 + d] = ls * (1.f / 16.f);
    }
  }
  vbar(smraw);
  if (tid < 128) {
    float cv[64];
#pragma unroll
    for (int i = 0; i < 64; ++i) cv[i] = cum[(dir ? 63 - i : i) * 129 + tid];
    float run = 0.f;
#pragma unroll
    for (int i = 0; i < 64; ++i) { run += cv[i]; cum[(dir ? 63 - i : i) * 129 + tid] = run; }
    last[tid] = run;
    ((float*)(R2 + R1_EL))[(size_t)item * 128 + tid] = __expf(run);
  }
  vbar(smraw);
  {
    bf16_t* qg = (bf16_t*)(R2 + R1_QG) + ((size_t)(bh * 2 + dir) * TPB + p0) * 128;
#pragma unroll
    for (int i = tid; i < 64 * 64; i += 256) {
      int c = i >> 6, d = (i & 63) * 2;
      unsigned uq = *(const unsigned*)(z + (size_t)c * LDZ1 + 3072 + h * 128 + d);
      unsigned uk = *(const unsigned*)(z + (size_t)c * LDZ1 + 3584 + h * 128 + d);
      float c0 = cum[c * 129 + d], c1 = cum[c * 129 + d + 1];
      unsigned oq = pk2(bflo(uq) * 0.08838834764831845f * __expf(c0), bfhi(uq) * 0.08838834764831845f * __expf(c1));
      unsigned ok = pk2(bflo(uk) * __expf(-c0), bfhi(uk) * __expf(-c1));
      *(unsigned*)(QS + c * 136 + d) = oq;
      *(unsigned*)(KS + c * 136 + d) = ok;
      *(unsigned*)(qg + (size_t)c * 128 + d) = oq;
    }
    {
      const int d = tid >> 1, half = tid & 1;
      const float ld = last[d];
      float y[32];
#pragma unroll
      for (int i = 0; i < 32; ++i) {
        int c = half * 32 + i;
        y[i] = bf2f(z[(size_t)c * LDZ1 + 3584 + h * 128 + d]) * __expf(ld - cum[c * 129 + d]);
      }
      vbar(smraw);
      put_T((bf16_t*)smraw, d, half, y);
      vbar(smraw);
      store_T(sw, (const bf16_t*)smraw, (bf16_t*)(R2 + R1_KGT) + ((size_t)(bh * 2 + dir) * 128) * TPS + p0);
    }
  }
  {
    const int it = wid, i = it * 16 + fr;
    bf16x8 bq[4];
#pragma unroll
    for (int s = 0; s < 4; ++s) bq[s] = *(const bf16x8*)(QS + i * 136 + s * 32 + fq * 8);
    bf16_t* am = (bf16_t*)(R2 + R1_AM) + (size_t)item * 4096;
#pragma unroll
    for (int jt = 0; jt < 4; ++jt) {
      f32x4 a = {0.f, 0.f, 0.f, 0.f};
#pragma unroll
      for (int s = 0; s < 4; ++s) a = mfma16(*(const bf16x8*)(KS + (jt * 16 + fr) * 136 + s * 32 + fq * 8), bq[s], a);
#pragma unroll
      for (int jj = 0; jj < 4; ++jj) {
        int j = jt * 16 + fq * 4 + jj;
        bool incl = dir ? (j >= i) : (j <= i);
        a[jj] = incl ? a[jj] : 0.f;
      }
      *(u32x2*)(am + i * 64 + jt * 16 + fq * 4) = pack4(a);
    }
  }
  if (dir == 0) {
    const bf16_t* src = z + 4096 + h * 256;
    bf16_t* dst = (bf16_t*)(R2 + R1_VTG) + ((size_t)bh * 256) * TPS + p0;
    transpose64x128(sw, src, LDZ1, dst, smraw);
    transpose64x128(sw, src + 128, LDZ1, dst + (size_t)128 * TPS, smraw);
  }
}
constexpr float LAM_INIT = 0.35550906759096927f;
DEVI void fin1(int sw, const P& p, int item) {
  const int lane = lane_id();
  const int r = item * 4 + (sw & 3);
  bf16_t* mix = (bf16_t*)(p.ws + OFF_MIX) + (size_t)r * LDH;
  const bf16_t* o = (const bf16_t*)(p.ws + OFF_H) + (size_t)r * LDH + lane * 2;
  const bf16_t* r0 = (const bf16_t*)(p.ws + OFF_R2 + R1_REC) + (size_t)r * 1024 + lane * 4;
  const bf16_t* zg = (const bf16_t*)(p.ws + OFF_Z) + (size_t)r * LDZ1 + 5120 + lane * 4;
  unsigned u1[8], u2[8];
  u32x2 a0[4], a1[4], ag[4];
#pragma unroll
  for (int h = 0; h < 8; ++h) { u1[h] = *(const unsigned*)(o + h * 256); u2[h] = *(const unsigned*)(o + h * 256 + 128); }
#pragma unroll
  for (int h = 0; h < 4; ++h) { a0[h] = *(const u32x2*)(r0 + h * 256); a1[h] = *(const u32x2*)(r0 + (size_t)NT * 1024 + h * 256); ag[h] = *(const u32x2*)(zg + h * 256); }
  float l01 = wave_sum(p.diff_lambda[lane] * p.diff_lambda[64 + lane]);
  float l23 = wave_sum(p.diff_lambda[128 + lane] * p.diff_lambda[192 + lane]);
  const float lam = __expf(l01) - __expf(l23) + LAM_INIT;
  const float s0 = p.diff_sub_norm[lane * 2], s1 = p.diff_sub_norm[lane * 2 + 1];
#pragma unroll
  for (int h = 0; h < 8; ++h) {
    float a = bflo(u1[h]) - lam * bflo(u2[h]), b = bfhi(u1[h]) - lam * bfhi(u2[h]);
    float ss = wave_sum(a * a + b * b);
    float rs = rsqrtf(ss * (1.f / 128.f) + EPS) * (1.f - LAM_INIT);
    *(unsigned*)(mix + h * 128 + lane * 2) = pk2(a * rs * s0, b * rs * s1);
  }
  const f32x4 gn = *(const f32x4*)(p.gla_out_norm + lane * 4);
#pragma unroll
  for (int h = 0; h < 4; ++h) {
    float v[4] = {bflo(a0[h][0]) + bflo(a1[h][0]), bfhi(a0[h][0]) + bfhi(a1[h][0]), bflo(a0[h][1]) + bflo(a1[h][1]), bfhi(a0[h][1]) + bfhi(a1[h][1])};
    float ss = wave_sum(v[0] * v[0] + v[1] * v[1] + v[2] * v[2] + v[3] * v[3]);
    float rs = rsqrtf(ss * (1.f / 256.f) + EPS);
    float g[4] = {bflo(ag[h][0]), bfhi(ag[h][0]), bflo(ag[h][1]), bfhi(ag[h][1])};
    f32x4 ov;
#pragma unroll
    for (int q = 0; q < 4; ++q) ov[q] = v[q] * rs * gn[q] * silu_f(g[q]);
    *(u32x2*)(mix + 1024 + h * 256 + lane * 4) = pack4(ov);
  }
}

DEVI int fetch_item(int sw, int* ctr, char* slot) {
  __syncthreads();
  if (sw == 0 && lane_id() == 0) *(volatile int*)slot = atomicAdd(ctr, 1);
  __syncthreads();
  return __builtin_amdgcn_readfirstlane(*(volatile int*)slot);
}
DEVI void gbar(int sw, unsigned* cnt, unsigned* gen, unsigned nblk, unsigned epoch) {
  __syncthreads();
  if (sw == 0 && lane_id() == 0) {
    __builtin_amdgcn_fence(__ATOMIC_RELEASE, "agent");
    const unsigned prev = __hip_atomic_fetch_add(cnt, 1u, __ATOMIC_RELAXED, __HIP_MEMORY_SCOPE_AGENT);
    if (prev == epoch * nblk - 1u) __hip_atomic_store(gen, epoch, __ATOMIC_RELAXED, __HIP_MEMORY_SCOPE_AGENT);
    else while (__hip_atomic_load(gen, __ATOMIC_RELAXED, __HIP_MEMORY_SCOPE_AGENT) < epoch) __builtin_amdgcn_s_sleep(1);
    __builtin_amdgcn_fence(__ATOMIC_ACQUIRE, "agent");
  }
  __syncthreads();
}
constexpr int SMEM_HALF = 75776;
constexpr int SMEM_BYTES = 2 * SMEM_HALF;
constexpr int NPHASE = 21;

__global__ void __launch_bounds__(512, 2) mega(P p, int ph0, int ph1) {
  __shared__ __attribute__((aligned(1024))) char smem_all[SMEM_BYTES];
  cg::grid_group grid = cg::this_grid();
#ifdef PH_LO
  ph0 = PH_LO; ph1 = PH_HI;
#endif
  const int sw = __builtin_amdgcn_readfirstlane(threadIdx.x >> 6);
  const int vb = sw >> 2;
  const int G = gridDim.x * 2, bid = blockIdx.x * 2 + vb;
  char* smem = smem_all + vb * SMEM_HALF;
  unsigned* gb_cnt = (unsigned*)(p.ws + OFF_CTR) + 256;
  unsigned* gb_gen = (unsigned*)(p.ws + OFF_CTR) + 320;
  unsigned epoch = 0;
  char* ws = p.ws;
  char* R2 = ws + OFF_R2;
  bf16_t* wmix = (bf16_t*)(ws + OFF_WMIX);
  bf16_t* Hb = (bf16_t*)(ws + OFF_H);
  bf16_t* MIXb = (bf16_t*)(ws + OFF_MIX);
  bf16_t* Zb = (bf16_t*)(ws + OFF_Z);
  const float* mod0 = (const float*)(ws + OFF_MOD);
  const float* mod1 = mod0 + 5 * MODN;

  if (ph0 <= 0 && 0 < ph1) {
    if (lane_id() == 0 && (sw & 3) == 0) *(volatile unsigned*)(smem + VB_CTR_OFF) = 0u;
    __syncthreads();
    {
        for (int it = bid; it < 384 + CVT_MIX0_ITEMS; it += G) {
          if (it < 384) ada_item(sw, p, it, (float*)smem);
          else cvt_mix0(sw, p, it - 384, (float*)smem);
        }
        if (blockIdx.x == 0 && sw == 0 && lane_id() < 16) ((int*)(ws + OFF_CTR))[lane_id()] = 0;
        if (blockIdx.x == 0 && sw == 0 && lane_id() < 2) ((unsigned*)(ws + OFF_CTR))[256 + 64 * lane_id()] = 0u;
      }
    if (0 + 1 < ph1) grid.sync();
  }
  if (ph0 <= 1 && 1 < ph1) {
    modulate_phase(sw, p, p.norm_mix_g, mod0, 0, 1, Hb, nullptr, nullptr, true);
    if (1 + 1 < ph1) gbar(sw, gb_cnt, gb_gen, gridDim.x, ++epoch);
  }
  if (ph0 <= 2 && 2 < ph1) {
    {
        EpiStore e{Zb, LDZ0, (float*)(R2 + R_GATES), 5184};
        gemm256_phase<0>(sw, wmix + WM_IN, LDW, Hb, LDH, D, AB_INP / 256, smem_all, e);
      }
    if (2 + 1 < ph1) gbar(sw, gb_cnt, gb_gen, gridDim.x, ++epoch);
  }
  if (ph0 <= 3 && 3 < ph1) {
    if (lane_id() == 0 && (sw & 3) == 0) *(volatile unsigned*)(smem + VB_CTR_OFF) = 0u;
    __syncthreads();
    {
        for (int it = bid; it < 8704 + 1088; it += G) {
          if (it < 8704) prep0_gdn(sw, p, (it & ~3) | ((it + (it >> 9)) & 3), (float*)smem);
          else prep0_norm512(sw, p, it - 8704);
        }
      }
    if (3 + 1 < ph1) gbar(sw, gb_cnt, gb_gen, gridDim.x, ++epoch);
  }
  if (ph0 <= 4 && 4 < ph1) {
    {
        EpiStore eq{(bf16_t*)(R2 + R_QUP), 1536, nullptr, 0};
        gemm256_phase<0>(sw, wmix + WM_UQ, LDW5, Hb, LDQA, 512, 6, smem_all, eq);
        EpiStore ek{MIXb, LDH, nullptr, 0};
        gemm256_phase<0>(sw, wmix + WM_UKV, LDW5, Hb + (size_t)NT * LDQA, LDQA, 512, 8, smem_all, ek);
      }
    if (4 + 1 < ph1) gbar(sw, gb_cnt, gb_gen, gridDim.x, ++epoch);
  }
  if (ph0 <= 5 && 5 < ph1) {
    if (lane_id() == 0 && (sw & 3) == 0) *(volatile unsigned*)(smem + VB_CTR_OFF) = 0u;
    __syncthreads();
    {
        const int nq = NT * 8 / 4 / 8;
        for (int it = bid; it < 4352 + 2176 + 2 * nq; it += G) {
          if (it < 4352) gdn_pre(sw, p, it, smem);
          else if (it < 4352 + 2176) {
            int t = it - 4352; int mc = t % NCH; int bh = t / NCH; int b = bh >> 3, h = bh & 7;
            transpose64x128(sw, MIXb + (size_t)(b * TPB + mc * 64) * LDH + h * 256 + 128, LDH,
                            (bf16_t*)(R2 + R_VT) + ((size_t)bh * 128) * TPS + mc * 64, smem);
          } else if (it < 4352 + 2176 + nq) prep0_q(sw, p, it - 4352 - 2176);
          else prep0_k(sw, p, it - 4352 - 2176 - nq);
        }
      }
    if (5 + 1 < ph1) gbar(sw, gb_cnt, gb_gen, gridDim.x, ++epoch);
  }
  if (ph0 <= 6 && 6 < ph1) {
    {
        const int xq = blockIdx.x & 7;
        int* ctr = (int*)(ws + OFF_CTR) + xq;
        char* slot = smem_all + SMEM_BYTES - 16;
        while (true) {
          const int it = fetch_item(sw, ctr, slot);
          if (it >= 76) break;
          if (it < 8) scan_chain<true>(sw, p, 2 * (xq * 8 + it) + vb, smem);
          else {
            int bh, prow, nkeys;
            if (it < 72) { const int t = it - 8; bh = (t >> 4) * 8 + xq; prow = CTX + (t & 15) * 256; nkeys = TPB; }
            else { bh = (it - 72) * 8 + xq; prow = 0; nkeys = CTX; }
            const int b = bh >> 3, h = bh & 7;
            const size_t r0 = (size_t)b * TPB + prow;
            float gq = 0.f, gk = 0.f;
            for (int i = lane_id(); i < 192; i += 64) { gq = fmaxf(gq, fabsf(p.mla_q_norm[i])); gk = fmaxf(gk, fabsf(p.mla_k_norm[i])); }
#pragma unroll
            for (int o2 = 32; o2 > 0; o2 >>= 1) { gq = fmaxf(gq, __shfl_xor(gq, o2)); gk = fmaxf(gk, __shfl_xor(gk, o2)); }
            const float negB = -(0.07216878364870322f * LOG2E * 192.f) * gq * gk;
            attn256_item<192>(sw, (const bf16_t*)(R2 + R_QUP) + r0 * 1536 + h * 192, 1536,
                              (const bf16_t*)(R2 + R_K) + (size_t)b * TPB * LDK + h * 192, LDK,
                              (const bf16_t*)(R2 + R_VT) + ((size_t)bh * 128) * TPS,
                              MIXb + r0 * LDH + h * 128, LDH, nkeys, negB, smem_all);
          }
        }
      }
    if (6 + 1 < ph1) gbar(sw, gb_cnt, gb_gen, gridDim.x, ++epoch);
  }
  if (ph0 <= 7 && 7 < ph1) {
    if (lane_id() == 0 && (sw & 3) == 0) *(volatile unsigned*)(smem + VB_CTR_OFF) = 0u;
    __syncthreads();
    {
        const int nf = NT * 8 / 4 / 8;
        for (int it = bid; it < CVT_FFN_ITEMS + nf; it += G) {
          if (it < CVT_FFN_ITEMS) cvt_ffn(sw, p, 0, it, (float*)smem);
          else fin0_rec(sw, p, it - CVT_FFN_ITEMS);
        }
      }
    if (7 + 1 < ph1) gbar(sw, gb_cnt, gb_gen, gridDim.x, ++epoch);
  }
  if (ph0 <= 8 && 8 < ph1) {
    {
        EpiResid e{p.out, (float*)(ws + OFF_CTXRES), mod0 + 2 * D, (float*)(R2 + R_PART)};
        gemm256_phase<2>(sw, wmix + WM_OUT, LDW, MIXb, LDH, D, 8, smem_all, e);
      }
    if (8 + 1 < ph1) gbar(sw, gb_cnt, gb_gen, gridDim.x, ++epoch);
  }
  if (ph0 <= 9 && 9 < ph1) {
    if (lane_id() == 0 && (sw & 3) == 0) *(volatile unsigned*)(smem + VB_CTR_OFF) = 0u;
    __syncthreads();
    {
        modulate_phase(sw, p, p.norm_ffn_g, mod0, 3, 4, Hb, (const float*)(R2 + R_PART), mod0 + 4 * MODN + 2 * D);
        for (int it = bid; it < CVT_MIX1_ITEMS; it += G) cvt_mix1(sw, p, it, (float*)smem);
      }
    if (9 + 1 < ph1) gbar(sw, gb_cnt, gb_gen, gridDim.x, ++epoch);
  }
  if (ph0 <= 10 && 10 < ph1) {
    {
        EpiSwiglu e{Zb};
        gemm256_phase<0>(sw, (const bf16_t*)(R2 + RF_GU), LDW, Hb, LDH, D, 44, smem_all, e);
      }
    if (10 + 1 < ph1) gbar(sw, gb_cnt, gb_gen, gridDim.x, ++epoch);
  }
  if (ph0 <= 11 && 11 < ph1) {
    {
        EpiResid e{p.out, (float*)(ws + OFF_CTXRES), mod0 + 5 * D, (float*)(R2 + R_PART)};
        gemm256_phase<2>(sw, (const bf16_t*)(R2 + RF_D), LDWF, Zb, LDG, FFN, 8, smem_all, e);
      }
    if (11 + 1 < ph1) gbar(sw, gb_cnt, gb_gen, gridDim.x, ++epoch);
  }
  if (ph0 <= 12 && 12 < ph1) {
    modulate_phase(sw, p, p.norm_mix_g + D, mod1, 0, 1, Hb, (const float*)(R2 + R_PART), mod0 + 4 * MODN + 5 * D);
    if (12 + 1 < ph1) gbar(sw, gb_cnt, gb_gen, gridDim.x, ++epoch);
  }
  if (ph0 <= 13 && 13 < ph1) {
    {
        EpiStore e{Zb, LDZ1, (float*)(R2 + R1_GATES), 6144};
        gemm256_phase<0>(sw, wmix + WM_IN, LDW, Hb, LDH, D, CD_INP / 256, smem_all, e);
      }
    if (13 + 1 < ph1) gbar(sw, gb_cnt, gb_gen, gridDim.x, ++epoch);
  }
  if (ph0 <= 14 && 14 < ph1) {
    if (lane_id() == 0 && (sw & 3) == 0) *(volatile unsigned*)(smem + VB_CTR_OFF) = 0u;
    __syncthreads();
    {
        const int nqk = NT * 2 / 4;
        for (int it = bid; it < 2176 + 2176 + nqk; it += G) {
          if (it < 2176) gla_pre(sw, p, it, smem);
          else if (it < 4352) {
            int t = it - 2176; int mc = t % NCH; int bh = t / NCH; int b = bh >> 3, h = bh & 7;
            transpose64x128(sw, Zb + (size_t)(b * TPB + mc * 64) * LDZ1 + 2048 + h * 128, LDZ1,
                            (bf16_t*)(R2 + R1_VT) + ((size_t)bh * 128) * TPS + mc * 64, smem);
          } else prep1_qk(sw, p, it - 4352);
        }
      }
    if (14 + 1 < ph1) gbar(sw, gb_cnt, gb_gen, gridDim.x, ++epoch);
  }
  if (ph0 <= 15 && 15 < ph1) {
    {
        const int xq = blockIdx.x & 7;
        int* ctr = (int*)(ws + OFF_CTR) + 8 + xq;
        char* slot = smem_all + SMEM_BYTES - 16;
        while (true) {
          const int it = fetch_item(sw, ctr, slot);
          if (it >= 8 + 128) break;
          if (it < 8) scan_chain<false>(sw, p, 2 * (xq * 8 + it) + vb, smem);
          else {
            const int t = it - 8, qb = t & 15, bhm = (t >> 4) * 8 + xq, b = bhm >> 4, hm = bhm & 15;
            const size_t r0 = (size_t)b * TPB + CTX + qb * 256;
            float gq = 0.f, gk = 0.f;
            for (int i = lane_id(); i < 128; i += 64) { gq = fmaxf(gq, fabsf(p.diff_q_norm[i])); gk = fmaxf(gk, fabsf(p.diff_k_norm[i])); }
#pragma unroll
            for (int o2 = 32; o2 > 0; o2 >>= 1) { gq = fmaxf(gq, __shfl_xor(gq, o2)); gk = fmaxf(gk, __shfl_xor(gk, o2)); }
            const float negB = -(0.125f * LOG2E * 64.f) * gq * gk;
            attn256_item<64>(sw, Zb + r0 * LDZ1 + hm * 64, LDZ1,
                             Zb + (size_t)b * TPB * LDZ1 + 1024 + hm * 64, LDZ1,
                             (const bf16_t*)(R2 + R1_VT) + ((size_t)(b * 8 + (hm >> 1)) * 128) * TPS,
                             Hb + r0 * LDH + hm * 128, LDH, TPB, negB, smem_all);
          }
        }
      }
    if (15 + 1 < ph1) gbar(sw, gb_cnt, gb_gen, gridDim.x, ++epoch);
  }
  if (ph0 <= 16 && 16 < ph1) {
    if (lane_id() == 0 && (sw & 3) == 0) *(volatile unsigned*)(smem + VB_CTR_OFF) = 0u;
    __syncthreads();
    {
        const int nf = NT / 4;
        for (int it = bid; it < CVT_FFN_ITEMS + nf; it += G) {
          if (it < CVT_FFN_ITEMS) cvt_ffn(sw, p, 1, it, (float*)smem);
          else fin1(sw, p, it - CVT_FFN_ITEMS);
        }
      }
    if (16 + 1 < ph1) gbar(sw, gb_cnt, gb_gen, gridDim.x, ++epoch);
  }
  if (ph0 <= 17 && 17 < ph1) {
    {
        EpiResid e{p.out, (float*)(ws + OFF_CTXRES), mod1 + 2 * D, nullptr};
        gemm256_phase<1>(sw, wmix + WM_OUT, LDW, MIXb, LDH, D, 8, smem_all, e);
      }
    if (17 + 1 < ph1) gbar(sw, gb_cnt, gb_gen, gridDim.x, ++epoch);
  }
  if (ph0 <= 18 && 18 < ph1) {
    modulate_phase(sw, p, p.norm_ffn_g + D, mod1, 3, 4, Hb);
    if (18 + 1 < ph1) gbar(sw, gb_cnt, gb_gen, gridDim.x, ++epoch);
  }
  if (ph0 <= 19 && 19 < ph1) {
    {
        EpiSwiglu e{Zb};
        gemm256_phase<1>(sw, (const bf16_t*)(R2 + RF_GU), LDW, Hb, LDH, D, 44, smem_all, e);
      }
    if (19 + 1 < ph1) gbar(sw, gb_cnt, gb_gen, gridDim.x, ++epoch);
  }
  if (ph0 <= 20 && 20 < ph1) {
    {
        EpiResid e{p.out, (float*)(ws + OFF_CTXRES), mod1 + 5 * D, nullptr};
        gemm256_phase<1>(sw, (const bf16_t*)(R2 + RF_D), LDWF, Zb, LDG, FFN, 8, smem_all, e);
      }
  }
  if (ph0 <= 21 && 21 < ph1) { for (int it = bid; it < 128; it += G) scan_chain<true>(sw, p, it, smem); }
  if (ph0 <= 23 && 23 < ph1) { for (int it = bid; it < 128; it += G) scan_chain<false>(sw, p, it, smem); }
}

extern "C" void kernel_launch(void* const* d_in, const int* in_sizes, int n_in, void* d_out, int out_size, void* d_ws, size_t ws_size, hipStream_t stream) {
  static int grid_blocks = 0;
  if (!grid_blocks) {
    int dev = 0, cus = 0, per_cu = 0;
    hipGetDevice(&dev);
    hipDeviceGetAttribute(&cus, hipDeviceAttributeMultiprocessorCount, dev);
    hipOccupancyMaxActiveBlocksPerMultiprocessor(&per_cu, mega, 512, 0);
    if (per_cu > 1) per_cu = 1;
    if (per_cu < 1) per_cu = 1;
    grid_blocks = cus * per_cu;
    grid_blocks -= grid_blocks % 8;
  }
  if (ws_size < WS_NEED) { fprintf(stderr, "workspace too small: %zu < %zu\n", ws_size, (size_t)WS_NEED); return; }
  P p{};
  const float** pp = (const float**)&p;
  for (int i = 0; i < 32; ++i) pp[i] = (const float*)d_in[i];
  p.out = (float*)d_out;
  p.ws = (char*)d_ws;
#ifndef PROBE_PHASE
  int ph0 = 0, ph1 = NPHASE;
  void* args[] = {&p, &ph0, &ph1};
  hipError_t e = hipLaunchCooperativeKernel((void*)mega, dim3(grid_blocks), dim3(512), args, 0, stream);
  if (e != hipSuccess) fprintf(stderr, "cooperative launch failed: %s (grid %d)\n", hipGetErrorString(e), grid_blocks);
#else
  int segs[3][2] = {{0, PROBE_AFTER + 1}, {PROBE_PHASE, PROBE_PHASE + 1}, {PROBE_AFTER + 1, NPHASE}};
  for (int s = 0; s < 3; ++s) {
    void* args[] = {&p, &segs[s][0], &segs[s][1]};
    hipError_t e = hipLaunchCooperativeKernel((void*)mega, dim3(grid_blocks), dim3(512), args, 0, stream);
    if (e != hipSuccess) fprintf(stderr, "cooperative launch failed: %s (grid %d)\n", hipGetErrorString(e), grid_blocks);
  }
#endif
}
```
